# Optimizing an MI355X kernel written in HIP

```python
import math
import jax, jax.numpy as jnp
from jax import lax
import numpy as np

D_MODEL = 1024
BATCH = 8
SEQ = 2048
DEPTH = 1
DEC_BATCH = 128
DEC_SEQ = 1
PAST_LEN = 16384
PAGE_SIZE = 128

D_MIX = 2 * D_MODEL
D_SSD = D_MIX // 2
D_SC = D_MIX - D_SSD
SSD_HEAD_DIM = 64
SSD_HEADS = D_SSD // SSD_HEAD_DIM
SSD_GROUPS = 2
SSD_STATE = 128
SSD_CONV = 4
SSD_CHUNK = 128
SSD_CONV_DIM = D_SSD + 2 * SSD_GROUPS * SSD_STATE
SC_GROUPS = 16
SC_CONV = 3
D_FF = ((8 * D_MODEL // 3 + 127) // 128) * 128
FFN_CONV = 3
EPS = 1e-5
SPLITS = [D_SSD, D_SSD + SSD_CONV_DIM, D_SSD + SSD_CONV_DIM + SSD_HEADS,
          D_SSD + SSD_CONV_DIM + SSD_HEADS + D_SC,
          D_SSD + SSD_CONV_DIM + SSD_HEADS + 2 * D_SC]
D_IN_PROJ = D_SSD + SSD_CONV_DIM + SSD_HEADS + 3 * D_SC

kernel_name = "hybrid_ssd_shortconv_convffn_step"


def rms_norm(x, w):
    xf = x.astype(jnp.float32)
    y = xf * lax.rsqrt(jnp.mean(xf * xf, axis=-1, keepdims=True) + EPS)
    return (y * w.astype(jnp.float32)).astype(x.dtype)


def causal_dwconv(x, buf, w, b=None):
    K = w.shape[0]
    L = x.shape[1]
    xp = jnp.concatenate([buf.astype(x.dtype), x], axis=1)
    y = xp[:, 0:L] * w[0]
    for k in range(1, K):
        y = y + xp[:, k:k + L] * w[k]
    if b is not None:
        y = y + b
    return y, xp[:, L:]


def ssd_scan(x, dt, a, b_in, c_in, h0):
    bsz, l, nh, p = x.shape
    g = b_in.shape[2]
    r = nh // g
    n = b_in.shape[-1]
    q = SSD_CHUNK if l % SSD_CHUNK == 0 else l
    nc = l // q
    xd = (x * dt[..., None]).reshape(bsz, nc, q, g, r, p)
    da = (dt * a).reshape(bsz, nc, q, g, r)
    bc = b_in.reshape(bsz, nc, q, g, n)
    cc = c_in.reshape(bsz, nc, q, g, n)
    a_cum = jnp.cumsum(da, axis=2)
    mask = jnp.tril(jnp.ones((q, q), dtype=bool))
    seg = a_cum[:, :, :, None] - a_cum[:, :, None, :]
    decay = jnp.exp(jnp.where(mask[:, :, None, None], seg, -jnp.inf))
    cb = jnp.einsum('bclgn,bcsgn->bclsg', cc, bc)
    y_diag = jnp.einsum('bclsg,bclsgr,bcsgrp->bclgrp', cb, decay, xd)
    decay_s = jnp.exp(a_cum[:, :, -1:] - a_cum)
    states = jnp.einsum('bcsgn,bcsgr,bcsgrp->bcgrpn', bc, decay_s, xd)
    chunk_decay = jnp.exp(a_cum[:, :, -1])

    def step(h, inp):
        st, dec = inp
        return dec[..., None, None] * h + st, h

    h_last, h_prev = lax.scan(step, h0.reshape(bsz, g, r, p, n),
                              (jnp.swapaxes(states, 0, 1), jnp.swapaxes(chunk_decay, 0, 1)))
    h_prev = jnp.swapaxes(h_prev, 0, 1)
    y_off = jnp.einsum('bclgn,bcgrpn,bclgr->bclgrp', cc, h_prev, jnp.exp(a_cum))
    y = (y_diag + y_off).reshape(bsz, l, nh, p)
    return y, h_last.reshape(bsz, nh, p, n)


def hybrid_mixer(u, st_ssm, st_ssd_conv, st_sc_conv, w_in, ssd_conv_w, ssd_conv_b,
                 ssd_dt_bias, ssd_a_log, ssd_d, ssd_norm_w, sc_conv_w, w_out):
    bsz, l, _ = u.shape
    proj = u @ w_in
    z, xbc, dt_raw, g_b, g_c, h = jnp.split(proj, SPLITS, axis=-1)
    xbc, new_ssd_conv = causal_dwconv(xbc, st_ssd_conv, ssd_conv_w, ssd_conv_b)
    xbc = jax.nn.silu(xbc).astype(jnp.float32)
    xs, bs, cs = jnp.split(xbc, [D_SSD, D_SSD + SSD_GROUPS * SSD_STATE], axis=-1)
    xs = xs.reshape(bsz, l, SSD_HEADS, SSD_HEAD_DIM)
    dt = jax.nn.softplus(dt_raw.astype(jnp.float32) + ssd_dt_bias.astype(jnp.float32))
    a = -jnp.exp(ssd_a_log.astype(jnp.float32))
    y, new_ssm = ssd_scan(xs, dt, a,
                          bs.reshape(bsz, l, SSD_GROUPS, SSD_STATE),
                          cs.reshape(bsz, l, SSD_GROUPS, SSD_STATE),
                          st_ssm.astype(jnp.float32))
    y = y + ssd_d.astype(jnp.float32)[:, None] * xs
    y = y.reshape(bsz, l, D_SSD) * jax.nn.silu(z.astype(jnp.float32))
    yg = y.reshape(bsz, l, SSD_GROUPS, D_SSD // SSD_GROUPS)
    yg = yg * lax.rsqrt(jnp.mean(yg * yg, axis=-1, keepdims=True) + EPS)
    y_ssd = (yg.reshape(bsz, l, D_SSD) * ssd_norm_w.astype(jnp.float32)).astype(u.dtype)
    sc, new_sc_conv = causal_dwconv(g_c * h, st_sc_conv, sc_conv_w)
    y_sc = g_b * sc
    out = jnp.concatenate([y_ssd, y_sc], axis=-1) @ w_out
    return out, new_ssm.astype(u.dtype), new_ssd_conv, new_sc_conv


def conv_ffn(u, st_ffn, w_ffn_in, ffn_conv_w, ffn_conv_b, w_down):
    gate, up = jnp.split(u @ w_ffn_in, [D_FF], axis=-1)
    gate, new_st = causal_dwconv(gate, st_ffn, ffn_conv_w, ffn_conv_b)
    return (jax.nn.silu(gate) * up) @ w_down, new_st


def run_trunk(x, st_ssm, st_ssd_conv, st_sc_conv, st_ffn, norm_mix_w, w_in, ssd_conv_w,
              ssd_conv_b, ssd_dt_bias, ssd_a_log, ssd_d, ssd_norm_w, sc_conv_w, w_out,
              norm_ffn_w, w_ffn_in, ffn_conv_w, ffn_conv_b, w_down, norm_final_w):
    n_ssm, n_ssd_conv, n_sc_conv, n_ffn = [], [], [], []
    for i in range(DEPTH):
        m, s1, s2, s3 = hybrid_mixer(rms_norm(x, norm_mix_w[i]), st_ssm[i], st_ssd_conv[i],
                                     st_sc_conv[i], w_in[i], ssd_conv_w[i], ssd_conv_b[i],
                                     ssd_dt_bias[i], ssd_a_log[i], ssd_d[i], ssd_norm_w[i],
                                     sc_conv_w[i], w_out[i])
        x = x + m
        f, s4 = conv_ffn(rms_norm(x, norm_ffn_w[i]), st_ffn[i], w_ffn_in[i],
                         ffn_conv_w[i], ffn_conv_b[i], w_down[i])
        x = x + f
        n_ssm.append(s1); n_ssd_conv.append(s2); n_sc_conv.append(s3); n_ffn.append(s4)
    y = rms_norm(x, norm_final_w)
    return (y, jnp.stack(n_ssm), jnp.stack(n_ssd_conv), jnp.stack(n_sc_conv), jnp.stack(n_ffn))


def setup_inputs(seed: int = 0) -> dict:
    key = jax.random.key(seed)
    ks = jax.random.split(key, 24)
    f32 = jnp.float32
    nrm = lambda k, shape, s: jax.random.normal(k, shape, f32) * s
    dt0 = jnp.exp(jax.random.uniform(ks[10], (DEPTH, SSD_HEADS), f32,
                                     math.log(1e-3), math.log(1e-1)))
    return {
        "x_prompt": nrm(ks[0], (BATCH, SEQ, D_MODEL), 1.0),
        "x_sample": nrm(ks[1], (DEC_BATCH, DEC_SEQ, D_MODEL), 1.0),
        "state_ssm": nrm(ks[2], (DEPTH, DEC_BATCH, SSD_HEADS, SSD_HEAD_DIM, SSD_STATE), 0.1),
        "state_ssd_conv": nrm(ks[3], (DEPTH, DEC_BATCH, SSD_CONV - 1, SSD_CONV_DIM), 1.0),
        "state_short_conv": nrm(ks[4], (DEPTH, DEC_BATCH, SC_CONV - 1, D_SC), 1.0),
        "state_ffn_conv": nrm(ks[5], (DEPTH, DEC_BATCH, FFN_CONV - 1, D_FF), 1.0),
        "norm_mix_w": 1.0 + nrm(ks[6], (DEPTH, D_MODEL), 0.02),
        "w_in": nrm(ks[7], (DEPTH, D_MODEL, D_IN_PROJ), D_MODEL ** -0.5),
        "ssd_conv_w": nrm(ks[8], (DEPTH, SSD_CONV, SSD_CONV_DIM), SSD_CONV ** -0.5),
        "ssd_conv_b": nrm(ks[9], (DEPTH, SSD_CONV_DIM), 0.02),
        "ssd_dt_bias": dt0 + jnp.log(-jnp.expm1(-dt0)),
        "ssd_a_log": jnp.log(jax.random.uniform(ks[11], (DEPTH, SSD_HEADS), f32, 1.0, 16.0)),
        "ssd_d": 1.0 + nrm(ks[12], (DEPTH, SSD_HEADS), 0.1),
        "ssd_norm_w": 1.0 + nrm(ks[13], (DEPTH, D_SSD), 0.02),
        "sc_conv_w": nrm(ks[14], (DEPTH, SC_CONV, D_SC), SC_CONV ** -0.5),
        "w_out": nrm(ks[15], (DEPTH, D_MIX, D_MODEL), D_MIX ** -0.5),
        "norm_ffn_w": 1.0 + nrm(ks[16], (DEPTH, D_MODEL), 0.02),
        "w_ffn_in": nrm(ks[17], (DEPTH, D_MODEL, 2 * D_FF), D_MODEL ** -0.5),
        "ffn_conv_w": nrm(ks[18], (DEPTH, FFN_CONV, D_FF), FFN_CONV ** -0.5),
        "ffn_conv_b": nrm(ks[19], (DEPTH, D_FF), 0.02),
        "w_down": nrm(ks[20], (DEPTH, D_FF, D_MODEL), D_FF ** -0.5),
        "norm_final_w": 1.0 + nrm(ks[21], (D_MODEL,), 0.02),
    }


def reference(x_prompt, x_sample, state_ssm, state_ssd_conv, state_short_conv, state_ffn_conv,
              norm_mix_w, w_in, ssd_conv_w, ssd_conv_b, ssd_dt_bias, ssd_a_log, ssd_d,
              ssd_norm_w, sc_conv_w, w_out, norm_ffn_w, w_ffn_in, ffn_conv_w, ffn_conv_b,
              w_down, norm_final_w):
    bp = x_prompt.shape[0]
    dtp = x_prompt.dtype
    z_ssm = jnp.zeros((DEPTH, bp, SSD_HEADS, SSD_HEAD_DIM, SSD_STATE), dtp)
    z_ssd_conv = jnp.zeros((DEPTH, bp, SSD_CONV - 1, SSD_CONV_DIM), dtp)
    z_sc_conv = jnp.zeros((DEPTH, bp, SC_CONV - 1, D_SC), dtp)
    z_ffn = jnp.zeros((DEPTH, bp, FFN_CONV - 1, D_FF), dtp)
    y_prompt, p_ssm, p_ssd_conv, p_sc_conv, p_ffn = run_trunk(
        x_prompt, z_ssm, z_ssd_conv, z_sc_conv, z_ffn, norm_mix_w, w_in, ssd_conv_w,
        ssd_conv_b, ssd_dt_bias, ssd_a_log, ssd_d, ssd_norm_w, sc_conv_w, w_out,
        norm_ffn_w, w_ffn_in, ffn_conv_w, ffn_conv_b, w_down, norm_final_w)
    y_sample, s_ssm, s_ssd_conv, s_sc_conv, s_ffn = run_trunk(
        x_sample, state_ssm, state_ssd_conv, state_short_conv, state_ffn_conv, norm_mix_w,
        w_in, ssd_conv_w, ssd_conv_b, ssd_dt_bias, ssd_a_log, ssd_d, ssd_norm_w, sc_conv_w,
        w_out, norm_ffn_w, w_ffn_in, ffn_conv_w, ffn_conv_b, w_down, norm_final_w)
    return (y_prompt, y_sample, p_ssm, p_ssd_conv, p_sc_conv, p_ffn,
            s_ssm, s_ssd_conv, s_sc_conv, s_ffn)
```

```cpp
#include <hip/hip_runtime.h>
#include <hip/hip_cooperative_groups.h>
#include <cstdio>
namespace cg = cooperative_groups;

#define LAS __attribute__((address_space(3)))
typedef unsigned short bf16_t;
typedef short bf16x8 __attribute__((ext_vector_type(8)));
typedef float f32x4 __attribute__((ext_vector_type(4)));
typedef unsigned u32x4 __attribute__((ext_vector_type(4)));
typedef unsigned u32x2 __attribute__((ext_vector_type(2)));

constexpr int TPR = 16384, TSM = 128, TT = 16512, TPAD = 16640;
constexpr int NIN = 5632, DINP = 5648, XBC = 1536, DFF = 2816;
constexpr float EPS = 1e-5f;
constexpr int LDS_BYTES = 131072;

constexpr size_t WS_WIN = 0;
constexpr size_t WS_WOUT = WS_WIN + (size_t)NIN * 1024 * 2;
constexpr size_t WS_WFFN = WS_WOUT + (size_t)1024 * 2048 * 2;
constexpr size_t WS_WDOWN = WS_WFFN + (size_t)NIN * 1024 * 2;
constexpr size_t WS_A1 = WS_WDOWN + (size_t)1024 * 2816 * 2;
constexpr size_t WS_DT = WS_A1 + (size_t)TPAD * 1024 * 2;
constexpr size_t WS_ACUM = WS_DT + (size_t)8 * 16 * 2048 * 4;
constexpr size_t WS_DTS = WS_ACUM + (size_t)8 * 16 * 2048 * 4;
constexpr size_t WS_BIG = WS_DTS + (size_t)128 * 16 * 4;
constexpr size_t WS_XBC = WS_BIG;
constexpr size_t WS_U = WS_XBC + (size_t)TPAD * 1536 * 2;
constexpr size_t WS_MIX = WS_U + (size_t)TPAD * 1024 * 2;
constexpr size_t WS_GATE = WS_BIG;
constexpr size_t WS_UP = WS_GATE + (size_t)TPAD * 2816 * 2;
constexpr size_t WS_END = WS_UP + (size_t)TPAD * 2816 * 2;
constexpr size_t OS_BN = 0;
constexpr size_t OS_BT = OS_BN + (size_t)8 * 2 * 2048 * 128 * 2;
constexpr size_t OS_CN = OS_BT + (size_t)8 * 2 * 2048 * 128 * 2;
constexpr size_t OS_ST = OS_CN + (size_t)8 * 2 * 2048 * 128 * 2;
constexpr size_t O_YS = 16777216, O_PSSM = 16908288, O_PSSDC = 17956864, O_PSC = 17993728, O_PFFN = 18010112;
constexpr size_t O_SSSM = 18055168, O_SSSDC = 34832384, O_SSC = 35422208, O_SFFN = 35684352;

__device__ __forceinline__ unsigned cvt_pk_bf16(float lo, float hi) { unsigned r; asm("v_cvt_pk_bf16_f32 %0, %1, %2" : "=v"(r) : "v"(lo), "v"(hi)); return r; }
__device__ __forceinline__ float bf_lo(unsigned u) { return __uint_as_float(u << 16); }
__device__ __forceinline__ float bf_hi(unsigned u) { return __uint_as_float(u & 0xffff0000u); }
__device__ __forceinline__ bf16_t f2bf(float f) { return (bf16_t)(cvt_pk_bf16(f, 0.f) & 0xffffu); }
__device__ __forceinline__ float bf2f(bf16_t b) { return __uint_as_float(((unsigned)b) << 16); }
__device__ __forceinline__ float silu_f(float v) { return v / (1.0f + __expf(-v)); }
__device__ __forceinline__ float softplus_f(float v) { return v > 20.f ? v : log1pf(__expf(v)); }
__device__ __forceinline__ void unpack8(const u32x4 u, float (&f)[8]) { f[0] = bf_lo(u.x); f[1] = bf_hi(u.x); f[2] = bf_lo(u.y); f[3] = bf_hi(u.y); f[4] = bf_lo(u.z); f[5] = bf_hi(u.z); f[6] = bf_lo(u.w); f[7] = bf_hi(u.w); }
__device__ __forceinline__ u32x4 pack8(const float (&f)[8]) { u32x4 u; u.x = cvt_pk_bf16(f[0], f[1]); u.y = cvt_pk_bf16(f[2], f[3]); u.z = cvt_pk_bf16(f[4], f[5]); u.w = cvt_pk_bf16(f[6], f[7]); return u; }
__device__ __forceinline__ void ld8f(const float* p, float (&f)[8]) { const f32x4 a = *(const f32x4*)p, b = *(const f32x4*)(p + 4); f[0] = a[0]; f[1] = a[1]; f[2] = a[2]; f[3] = a[3]; f[4] = b[0]; f[5] = b[1]; f[6] = b[2]; f[7] = b[3]; }
__device__ __forceinline__ void st8f(float* p, const float (&f)[8]) { *(f32x4*)p = (f32x4){f[0], f[1], f[2], f[3]}; *(f32x4*)(p + 4) = (f32x4){f[4], f[5], f[6], f[7]}; }

namespace pg8 {
constexpr int BM = 256, BK = 64, HALF = 128, HTB = HALF * BK * 2, NXCD = 8, WGM = 8;
__device__ __forceinline__ int lds_byte(int r, int c) { const int st = (r >> 4) * 2 + (c >> 5), rr = r & 15, cc = c & 31, ob = rr * 64 + cc * 2; return st * 1024 + (ob ^ (((ob >> 9) & 1) << 5)); }
__device__ __forceinline__ void stage_rc(int b, int& R, int& C) { const int st = b / 1024, sb = b % 1024, swz = sb ^ (((sb >> 9) & 1) << 5); R = (st >> 1) * 16 + swz / 64; C = (st & 1) * 32 + (swz % 64) / 2; }
__device__ __forceinline__ int perm32(int rho) { const int n = rho >> 4, i = rho & 15; return 8 * (i >> 2) + 4 * n + (i & 3); }
struct Unit { int pm, pn; };
struct Gemm { const bf16_t* A; const bf16_t* Bt; int M, N, K; };
struct StaticOrder {
    int nM, nN, nwg, G, c;
    __device__ void init(int M, int N, int G_, int c_) { nM = M / BM; nN = N / BM; nwg = nM * nN; G = G_; c = c_; }
    __device__ bool next(int i, Unit& u) const {
        const long L = (long)i * G + c; if (L >= nwg) return false;
        int wgid = (int)L; { const int q = nwg / NXCD, r = nwg % NXCD, xcd = wgid % NXCD, off = wgid / NXCD; wgid = (xcd < r ? xcd * (q + 1) : r * (q + 1) + (xcd - r) * q) + off; }
        const int nig = WGM * nN, gid = wgid / nig, fm = gid * WGM, gsz = (nM - fm) < WGM ? (nM - fm) : WGM;
        u.pm = fm + ((wgid % nig) % gsz); u.pn = (wgid % nig) / gsz; return true;
    }
};
template <class Epi>
__device__ __forceinline__ void gemm_phase(LAS unsigned char* lds, const Gemm g, const StaticOrder& S, const Epi& E) {
    const int tid = threadIdx.x, wid = __builtin_amdgcn_readfirstlane(tid >> 6), lane = tid & 63, wr = wid >> 2, wc = wid & 3, fr = lane & 15, fq = lane >> 4;
    const int K = g.K, nt = K / BK;
    unsigned voffA[2], voffB[2];
#pragma unroll
    for (int i = 0; i < 2; ++i) { int R, C; stage_rc(tid * 16 + i * 8192, R, C); const int Rb = Epi::PERM ? ((R & ~31) + perm32(R & 31)) : R;
        voffA[i] = (unsigned)(R * K + C) * 2u; voffB[i] = (unsigned)(Rb * K + C) * 2u; }
    const size_t kstep = (size_t)(BK * 2);
    const size_t hstep = (size_t)HALF * K * 2;
    const size_t tstep = 2 * hstep;
    const unsigned ldsw = (unsigned)wid * 1024u;
    const int aoff = lds_byte(wr * 64 + fr, fq * 8), boff = lds_byte(wc * 32 + fr, fq * 8);
#define PG8_SA(b, h) (((b) * 2 + (h)) * HTB)
#define PG8_SB(b, h) ((4 + (b) * 2 + (h)) * HTB)
#define PG8_STAGE(bufoff, gbase, voff) do { _Pragma("unroll") for (int _i = 0; _i < 2; ++_i) \
        __builtin_amdgcn_global_load_lds((const unsigned*)((const char*)(gbase) + (voff)[_i]), (LAS unsigned*)(lds + (bufoff) + ldsw + _i * 8192), 16, 0, 0); } while (0)
#define PG8_LDA(dst, b, h) do { _Pragma("unroll") for (int m = 0; m < 4; ++m) _Pragma("unroll") for (int k = 0; k < 2; ++k) dst[m][k] = *(const LAS bf16x8*)(lds + PG8_SA(b, h) + aoff + m * 2048 + k * 1024); } while (0)
#define PG8_LDB(dst, b, h) do { _Pragma("unroll") for (int n = 0; n < 2; ++n) _Pragma("unroll") for (int k = 0; k < 2; ++k) dst[n][k] = *(const LAS bf16x8*)(lds + PG8_SB(b, h) + boff + n * 2048 + k * 1024); } while (0)
#define PG8_MMA(ai, bj, At, Bt) do { __builtin_amdgcn_s_setprio(1); _Pragma("unroll") for (int m = 0; m < 4; ++m) _Pragma("unroll") for (int n = 0; n < 2; ++n) _Pragma("unroll") for (int k = 0; k < 2; ++k) \
        acc[ai][bj][m][n] = __builtin_amdgcn_mfma_f32_16x16x32_bf16(Bt[n][k], At[m][k], acc[ai][bj][m][n], 0, 0, 0); __builtin_amdgcn_s_setprio(0); } while (0)
#define PG8_WAIT_V(n) asm volatile("s_waitcnt vmcnt(" #n ")" ::: "memory")
#define PG8_WAIT_L(n) asm volatile("s_waitcnt lgkmcnt(" #n ")" ::: "memory")
#define PG8_BAR __builtin_amdgcn_s_barrier()
#define PG8_SCHED __builtin_amdgcn_sched_barrier(0)
    Unit cur, nxt; int ui = 0;
    if (!S.next(0, cur)) return;
    f32x4 acc[2][2][4][2];
#pragma unroll
    for (int a = 0; a < 2; ++a)
#pragma unroll
        for (int b = 0; b < 2; ++b)
#pragma unroll
            for (int m = 0; m < 4; ++m)
#pragma unroll
                for (int n = 0; n < 2; ++n) acc[a][b][m][n] = (f32x4){0.f, 0.f, 0.f, 0.f};
    bf16x8 At[4][2], B0[2][2], B1[2][2];
    const char* cA = (const char*)g.A + (size_t)cur.pm * tstep; const char* cB = (const char*)g.Bt + (size_t)cur.pn * tstep;
    PG8_STAGE(PG8_SB(0, 0), cB, voffB); PG8_STAGE(PG8_SA(0, 0), cA, voffA); PG8_STAGE(PG8_SB(0, 1), cB + hstep, voffB); PG8_STAGE(PG8_SA(0, 1), cA + hstep, voffA);
    if (wr == 1) PG8_BAR;
    PG8_WAIT_V(4); PG8_BAR;
    PG8_STAGE(PG8_SB(1, 0), cB + kstep, voffB); PG8_STAGE(PG8_SA(1, 0), cA + kstep, voffA); PG8_STAGE(PG8_SB(1, 1), cB + hstep + kstep, voffB);
    PG8_WAIT_V(6); PG8_BAR;
    for (;;) {
        const bool has_next = S.next(ui + 1, nxt);
        const char* nA = has_next ? (const char*)g.A + (size_t)nxt.pm * tstep : cA; const char* nB = has_next ? (const char*)g.Bt + (size_t)nxt.pn * tstep : cB;
        for (int t = 0; t < nt; t += 2) {
            const bool last = (t == nt - 2);
            const char* a1 = cA + (size_t)(t + 1) * kstep;
            const char* a2 = last ? nA : cA + (size_t)(t + 2) * kstep; const char* b2 = last ? nB : cB + (size_t)(t + 2) * kstep;
            const char* a3 = a2 + kstep; const char* b3 = b2 + kstep;
            PG8_LDB(B0, 0, 0); PG8_SCHED; PG8_LDA(At, 0, 0); PG8_STAGE(PG8_SA(1, 1), a1 + hstep, voffA);
            PG8_WAIT_L(8); PG8_BAR; PG8_WAIT_L(0); PG8_MMA(0, 0, At, B0); PG8_BAR; PG8_SCHED;
            PG8_LDB(B1, 0, 1); PG8_STAGE(PG8_SB(0, 0), b2, voffB);
            PG8_BAR; PG8_WAIT_L(0); PG8_MMA(0, 1, At, B1); PG8_BAR;
            PG8_LDA(At, 0, 1); PG8_STAGE(PG8_SA(0, 0), a2, voffA);
            PG8_BAR; PG8_WAIT_L(0); PG8_MMA(1, 0, At, B0); PG8_BAR; PG8_SCHED;
            PG8_STAGE(PG8_SB(0, 1), b2 + hstep, voffB);
            PG8_WAIT_V(6); PG8_BAR; PG8_MMA(1, 1, At, B1); PG8_BAR;
            PG8_LDB(B0, 1, 0); PG8_SCHED; PG8_LDA(At, 1, 0); PG8_STAGE(PG8_SA(0, 1), a2 + hstep, voffA);
            PG8_WAIT_L(8); PG8_BAR; PG8_WAIT_L(0); PG8_MMA(0, 0, At, B0); PG8_BAR; PG8_SCHED;
            PG8_LDB(B1, 1, 1); PG8_STAGE(PG8_SB(1, 0), b3, voffB);
            PG8_BAR; PG8_WAIT_L(0); PG8_MMA(0, 1, At, B1); PG8_BAR;
            PG8_LDA(At, 1, 1); PG8_STAGE(PG8_SA(1, 0), a3, voffA);
            PG8_BAR; PG8_WAIT_L(0); PG8_MMA(1, 0, At, B0); PG8_BAR; PG8_SCHED;
            PG8_STAGE(PG8_SB(1, 1), b3 + hstep, voffB);
            PG8_WAIT_V(6); PG8_BAR; PG8_MMA(1, 1, At, B1); PG8_BAR;
        }
        E(acc, cur, wr, wc, fr, fq);
        if (!has_next) break;
#pragma unroll
        for (int a = 0; a < 2; ++a)
#pragma unroll
            for (int b = 0; b < 2; ++b)
#pragma unroll
                for (int m = 0; m < 4; ++m)
#pragma unroll
                    for (int n = 0; n < 2; ++n) acc[a][b][m][n] = (f32x4){0.f, 0.f, 0.f, 0.f};
        cur = nxt; cA = nA; cB = nB; ++ui;
    }
    PG8_WAIT_V(0);
    if (wr == 0) PG8_BAR;
    PG8_BAR;
#undef PG8_SA
#undef PG8_SB
#undef PG8_STAGE
#undef PG8_LDA
#undef PG8_LDB
#undef PG8_MMA
#undef PG8_WAIT_V
#undef PG8_WAIT_L
#undef PG8_BAR
#undef PG8_SCHED
}
}

struct EpiIn {
    static constexpr bool PERM = true;
    bf16_t* mix; bf16_t* xbc; bf16_t* ub;
    __device__ __forceinline__ void operator()(const f32x4 (&acc)[2][2][4][2], const pg8::Unit& u, int wr, int wc, int fr, int fq) const {
        const int row0 = u.pm * 256 + wr * 64 + fr, cin = wc * 32 + 8 * fq;
        if (u.pn >= 14) {
            bf16_t* base = ub + (u.pn - 14) * 128 + cin;
#pragma unroll
            for (int ai = 0; ai < 2; ++ai)
#pragma unroll
                for (int m = 0; m < 4; ++m) { const f32x4 v0 = acc[ai][0][m][0] * acc[ai][1][m][0], v1 = acc[ai][0][m][1] * acc[ai][1][m][1];
                    u32x4 w; w.x = cvt_pk_bf16(v0[0], v0[1]); w.y = cvt_pk_bf16(v0[2], v0[3]); w.z = cvt_pk_bf16(v1[0], v1[1]); w.w = cvt_pk_bf16(v1[2], v1[3]);
                    *(u32x4*)(base + (size_t)(row0 + ai * 128 + m * 16) * 1024) = w; }
        } else {
            bf16_t* base; int ld;
            if (u.pn < 4) { base = mix + u.pn * 256; ld = 2048; } else if (u.pn < 10) { base = xbc + (u.pn - 4) * 256; ld = XBC; } else { base = mix + 1024 + (u.pn - 10) * 256; ld = 2048; }
            base += cin;
#pragma unroll
            for (int ai = 0; ai < 2; ++ai)
#pragma unroll
                for (int m = 0; m < 4; ++m) { bf16_t* rp = base + (size_t)(row0 + ai * 128 + m * 16) * ld;
#pragma unroll
                    for (int bj = 0; bj < 2; ++bj) { const f32x4 v0 = acc[ai][bj][m][0], v1 = acc[ai][bj][m][1];
                        u32x4 w; w.x = cvt_pk_bf16(v0[0], v0[1]); w.y = cvt_pk_bf16(v0[2], v0[3]); w.z = cvt_pk_bf16(v1[0], v1[1]); w.w = cvt_pk_bf16(v1[2], v1[3]);
                        *(u32x4*)(rp + bj * 128) = w; } }
        }
    }
};
struct EpiFfn {
    static constexpr bool PERM = true;
    bf16_t* gate; bf16_t* up;
    __device__ __forceinline__ void operator()(const f32x4 (&acc)[2][2][4][2], const pg8::Unit& u, int wr, int wc, int fr, int fq) const {
        const int row0 = u.pm * 256 + wr * 64 + fr, cin = wc * 32 + 8 * fq;
        bf16_t* base = (u.pn < 11 ? gate + u.pn * 256 : up + (u.pn - 11) * 256) + cin;
#pragma unroll
        for (int ai = 0; ai < 2; ++ai)
#pragma unroll
            for (int m = 0; m < 4; ++m) { bf16_t* rp = base + (size_t)(row0 + ai * 128 + m * 16) * DFF;
#pragma unroll
                for (int bj = 0; bj < 2; ++bj) { const f32x4 v0 = acc[ai][bj][m][0], v1 = acc[ai][bj][m][1];
                    u32x4 w; w.x = cvt_pk_bf16(v0[0], v0[1]); w.y = cvt_pk_bf16(v0[2], v0[3]); w.z = cvt_pk_bf16(v1[0], v1[1]); w.w = cvt_pk_bf16(v1[2], v1[3]);
                    *(u32x4*)(rp + bj * 128) = w; } }
    }
};
struct EpiRes {
    static constexpr bool PERM = false;
    const float* xp; const float* xs; float* out; int use_x;
    __device__ __forceinline__ void operator()(const f32x4 (&acc)[2][2][4][2], const pg8::Unit& u, int wr, int wc, int fr, int fq) const {
        const int row0 = u.pm * 256 + wr * 64 + fr, col0 = u.pn * 256 + wc * 32 + 4 * fq;
#pragma unroll
        for (int ai = 0; ai < 2; ++ai)
#pragma unroll
            for (int m = 0; m < 4; ++m) { const int row = row0 + ai * 128 + m * 16;
                if (row < TT) { float* o = out + (size_t)row * 1024 + col0;
                    const float* b = use_x ? (row < TPR ? xp + (size_t)row * 1024 : xs + (size_t)(row - TPR) * 1024) + col0 : o;
#pragma unroll
                    for (int bj = 0; bj < 2; ++bj)
#pragma unroll
                        for (int n = 0; n < 2; ++n) { const f32x4 bv = *(const f32x4*)(b + bj * 128 + n * 16); *(f32x4*)(o + bj * 128 + n * 16) = bv + acc[ai][bj][m][n]; } }
                asm volatile("" ::: "memory"); }
    }
};

struct Params {
    const float* x_prompt; const float* x_sample; const float* state_ssm; const float* state_ssd_conv; const float* state_sc; const float* state_ffn;
    const float* norm_mix_w; const float* w_in; const float* ssd_conv_w; const float* ssd_conv_b; const float* dt_bias; const float* a_log; const float* ssd_d; const float* ssd_norm_w;
    const float* sc_conv_w; const float* w_out; const float* norm_ffn_w; const float* w_ffn_in; const float* ffn_conv_w; const float* ffn_conv_b; const float* w_down; const float* norm_final_w;
    float* out; unsigned char* ws; int ph_lo, ph_hi;
};

__device__ __forceinline__ int map_in(int j0) {
    if (j0 < 2560) return j0;
    if (j0 < 3584) return 2576 + (j0 - 2560);
    const int k = (j0 - 3584) >> 8, w = (j0 - 3584) & 255;
    return w < 128 ? 3600 + k * 128 + w : 4624 + k * 128 + (w - 128);
}
__device__ __forceinline__ void p0_chunk(const Params& P, LAS unsigned char* lds, int ci) {
    const int tid = threadIdx.x, lane = tid & 63, wid = tid >> 6, r16 = lane & 15, q = lane >> 4;
    LAS bf16_t* wdt = (LAS bf16_t*)lds;
    LAS float* dts = (LAS float*)(lds + 33024);
    LAS float* segs = (LAS float*)(lds + 33024 + 8192);
#pragma unroll
    for (int i = 0; i < 8; ++i) { const int k = (tid >> 2) + 128 * i, c4 = (tid & 3) * 4; const f32x4 v = *(const f32x4*)(P.w_in + (size_t)k * DINP + 2560 + c4);
        wdt[(c4 + 0) * 1032 + k] = f2bf(v[0]); wdt[(c4 + 1) * 1032 + k] = f2bf(v[1]); wdt[(c4 + 2) * 1032 + k] = f2bf(v[2]); wdt[(c4 + 3) * 1032 + k] = f2bf(v[3]); }
    __syncthreads();
    const int row = ci * 128 + wid * 16 + r16;
    const float* src = (row < TPR ? P.x_prompt + (size_t)row * 1024 : P.x_sample + (size_t)(row - TPR) * 1024) + 8 * q;
    float ss = 0.f;
#pragma unroll 8
    for (int s = 0; s < 32; ++s) { const f32x4 a = *(const f32x4*)(src + 32 * s), b = *(const f32x4*)(src + 32 * s + 4);
        ss += a[0] * a[0] + a[1] * a[1] + a[2] * a[2] + a[3] * a[3] + b[0] * b[0] + b[1] * b[1] + b[2] * b[2] + b[3] * b[3]; }
    ss += __shfl_xor(ss, 16); ss += __shfl_xor(ss, 32);
    const float rstd = rsqrtf(ss * (1.0f / 1024.0f) + EPS);
    bf16_t* dst = (bf16_t*)(P.ws + WS_A1) + (size_t)row * 1024 + 8 * q;
    const float* nw = P.norm_mix_w + 8 * q;
    f32x4 acc = (f32x4){0.f, 0.f, 0.f, 0.f};
#pragma unroll 4
    for (int s = 0; s < 32; ++s) { float xv[8], wv[8]; ld8f(src + 32 * s, xv); ld8f(nw + 32 * s, wv);
#pragma unroll
        for (int j = 0; j < 8; ++j) xv[j] = xv[j] * rstd * wv[j];
        const u32x4 pk = pack8(xv); *(u32x4*)(dst + 32 * s) = pk;
        const bf16x8 bfr = *(const LAS bf16x8*)(wdt + r16 * 1032 + 32 * s + 8 * q);
        acc = __builtin_amdgcn_mfma_f32_16x16x32_bf16(__builtin_bit_cast(bf16x8, pk), bfr, acc, 0, 0, 0); }
    { const float bias = P.dt_bias[r16];
#pragma unroll
      for (int j = 0; j < 4; ++j) dts[(wid * 16 + 4 * q + j) * 16 + r16] = softplus_f(acc[j] + bias); }
    __syncthreads();
    if (ci < 128) {
        const int b = ci >> 4, c = ci & 15, h = tid & 15, seg = (tid >> 4) & 15;
        float d[8], cs[8];
        if (tid < 256) { const float a = -__expf(P.a_log[h]); float run = 0.f;
#pragma unroll
            for (int i = 0; i < 8; ++i) { d[i] = dts[(seg * 8 + i) * 16 + h]; run += d[i] * a; cs[i] = run; }
            segs[seg * 16 + h] = run; }
        __syncthreads();
        if (tid < 256) { float pre = 0.f;
#pragma unroll
            for (int s2 = 0; s2 < 16; ++s2) pre += (s2 < seg) ? segs[s2 * 16 + h] : 0.f;
#pragma unroll
            for (int i = 0; i < 8; ++i) cs[i] += pre;
            const size_t o = (size_t)(b * 16 + h) * 2048 + c * 128 + seg * 8;
            st8f((float*)(P.ws + WS_DT) + o, d); st8f((float*)(P.ws + WS_ACUM) + o, cs); }
    } else {
        float* dtsg = (float*)(P.ws + WS_DTS);
        for (int i = tid; i < 2048; i += 512) dtsg[i] = dts[i];
    }
    __syncthreads();
}
__device__ __forceinline__ void p0_tile(const Params& P, LAS unsigned char* lds, int t) {
    const int tid = threadIdx.x;
    const float* src; bf16_t* dst; int K, Ns, kt, nt, c0;
    if (t < 1408) { src = P.w_in; dst = (bf16_t*)(P.ws + WS_WIN); K = 1024; Ns = DINP; kt = t / 88; nt = t % 88; c0 = map_in(nt * 64); }
    else if (t < 1920) { t -= 1408; src = P.w_out; dst = (bf16_t*)(P.ws + WS_WOUT); K = 2048; Ns = 1024; kt = t >> 4; nt = t & 15; c0 = nt * 64; }
    else if (t < 3328) { t -= 1920; src = P.w_ffn_in; dst = (bf16_t*)(P.ws + WS_WFFN); K = 1024; Ns = NIN; kt = t / 88; nt = t % 88; c0 = nt * 64; }
    else { t -= 3328; src = P.w_down; dst = (bf16_t*)(P.ws + WS_WDOWN); K = 2816; Ns = 1024; kt = t >> 4; nt = t & 15; c0 = nt * 64; }
    LAS float* tl = (LAS float*)lds;
    const int k0 = kt * 64;
#pragma unroll
    for (int i = 0; i < 2; ++i) { const int kr = (tid >> 4) + 32 * i, c4 = (tid & 15) * 4; const f32x4 v = *(const f32x4*)(src + (size_t)(k0 + kr) * Ns + c0 + c4);
        tl[kr * 65 + c4 + 0] = v[0]; tl[kr * 65 + c4 + 1] = v[1]; tl[kr * 65 + c4 + 2] = v[2]; tl[kr * 65 + c4 + 3] = v[3]; }
    __syncthreads();
    { const int n = tid >> 3, k8 = (tid & 7) * 8; float f[8];
#pragma unroll
      for (int i = 0; i < 8; ++i) f[i] = tl[(k8 + i) * 65 + n];
      *(u32x4*)(dst + (size_t)(nt * 64 + n) * K + k0 + k8) = pack8(f); }
    __syncthreads();
}
__device__ __forceinline__ void phase0(const Params& P, LAS unsigned char* lds) {
    const int G = gridDim.x, bx = blockIdx.x, NCI = 129, NTL = 4032;
    for (int ci = bx; ci < NCI; ci += G) p0_chunk(P, lds, ci);
    if (G > NCI) { if (bx >= NCI) for (int t = bx - NCI; t < NTL; t += G - NCI) p0_tile(P, lds, t); }
    else for (int t = bx; t < NTL; t += G) p0_tile(P, lds, t);
}

__device__ __forceinline__ void p2_conv_item(const Params& P, LAS unsigned char* lds, int item) {
    const int tid = threadIdx.x;
    const int strip = item % 24, bc = item / 24, b = bc >> 4, c = bc & 15, t0 = c * 128;
    const int colg = strip < 16 ? strip * 64 : (strip < 20 ? 1024 + (strip - 16) * 64 : 1280 + (strip - 20) * 64);
    LAS bf16_t* raw = (LAS bf16_t*)lds;
    LAS bf16_t* outn = (LAS bf16_t*)(lds + 16768);
    const bf16_t* xbc = (const bf16_t*)(P.ws + WS_XBC);
    for (int i = tid; i < 131 * 8; i += 512) { const int rr = i >> 3, c8 = (i & 7) * 8; const int tl = t0 - 3 + rr;
        u32x4 v = (u32x4){0u, 0u, 0u, 0u};
        if (tl >= 0) v = *(const u32x4*)(xbc + (size_t)(b * 2048 + tl) * XBC + colg + c8);
        *(LAS u32x4*)(raw + rr * 64 + c8) = v; }
    __syncthreads();
    const int col = tid & 63, rg = tid >> 6;
    const float w0 = P.ssd_conv_w[colg + col], w1 = P.ssd_conv_w[XBC + colg + col], w2 = P.ssd_conv_w[2 * XBC + colg + col], w3 = P.ssd_conv_w[3 * XBC + colg + col], bs = P.ssd_conv_b[colg + col];
    float o[16];
    { float x0 = bf2f(raw[(rg * 16 + 0) * 64 + col]), x1 = bf2f(raw[(rg * 16 + 1) * 64 + col]), x2 = bf2f(raw[(rg * 16 + 2) * 64 + col]);
#pragma unroll
      for (int i = 0; i < 16; ++i) { const float x3 = bf2f(raw[(rg * 16 + i + 3) * 64 + col]); o[i] = silu_f(x0 * w0 + x1 * w1 + x2 * w2 + x3 * w3 + bs); x0 = x1; x1 = x2; x2 = x3; } }
    u32x4 pk0, pk1;
    pk0.x = cvt_pk_bf16(o[0], o[1]); pk0.y = cvt_pk_bf16(o[2], o[3]); pk0.z = cvt_pk_bf16(o[4], o[5]); pk0.w = cvt_pk_bf16(o[6], o[7]);
    pk1.x = cvt_pk_bf16(o[8], o[9]); pk1.y = cvt_pk_bf16(o[10], o[11]); pk1.z = cvt_pk_bf16(o[12], o[13]); pk1.w = cvt_pk_bf16(o[14], o[15]);
    if (strip < 16) {
        bf16_t* d = (bf16_t*)(P.ws + WS_A1) + ((size_t)(b * 16 + strip) * 64 + col) * 2048 + t0 + rg * 16;
        *(u32x4*)d = pk0; *(u32x4*)(d + 8) = pk1;
    } else {
        const int sb = (strip - 16) & 3, g = sb >> 1, n0 = (sb & 1) * 64;
        if (strip < 20) { bf16_t* d = (bf16_t*)((unsigned char*)P.out + OS_BT) + ((size_t)(b * 2 + g) * 128 + n0 + col) * 2048 + t0 + rg * 16; *(u32x4*)d = pk0; *(u32x4*)(d + 8) = pk1; }
#pragma unroll
        for (int i = 0; i < 16; ++i) outn[(rg * 16 + i) * 64 + col] = f2bf(o[i]);
        __syncthreads();
        bf16_t* nat = (bf16_t*)((unsigned char*)P.out + (strip < 20 ? OS_BN : OS_CN)) + ((size_t)(b * 2 + g) * 2048 + t0) * 128 + n0;
        for (int i = tid; i < 1024; i += 512) { const int rr = i >> 3, c8 = (i & 7) * 8; *(u32x4*)(nat + (size_t)rr * 128 + c8) = *(const LAS u32x4*)(outn + rr * 64 + c8); }
    }
    if (c == 15 && tid < 192) { const int rr = tid >> 6; P.out[O_PSSDC + (size_t)(b * 3 + rr) * XBC + colg + col] = bf2f(raw[(128 + rr) * 64 + col]); }
    __syncthreads();
}
__device__ __forceinline__ void p2_sample_item(const Params& P, LAS unsigned char* lds, int item) {
    const int tid = threadIdx.x, lane = tid & 63, wid = tid >> 6;
    const int bs = item >> 1, g = item & 1, row = TPR + bs;
    LAS float* sx = (LAS float*)lds;
    LAS float* ssqs = sx + 768;
    const bf16_t* xbc = (const bf16_t*)(P.ws + WS_XBC) + (size_t)row * XBC;
    bf16_t* mix = (bf16_t*)(P.ws + WS_MIX) + (size_t)row * 2048;
    for (int i = tid; i < 768; i += 512) {
        const int j = i < 512 ? g * 512 + i : (i < 640 ? 1024 + g * 128 + (i - 512) : 1280 + g * 128 + (i - 640));
        const float* st = P.state_ssd_conv + (size_t)bs * 3 * XBC + j;
        const float s0 = st[0], s1 = st[XBC], s2 = st[2 * XBC], xr = bf2f(xbc[j]);
        const float v = s0 * P.ssd_conv_w[j] + s1 * P.ssd_conv_w[XBC + j] + s2 * P.ssd_conv_w[2 * XBC + j] + xr * P.ssd_conv_w[3 * XBC + j] + P.ssd_conv_b[j];
        sx[i] = silu_f(v);
        float* so = P.out + O_SSSDC + (size_t)bs * 3 * XBC + j; so[0] = s1; so[XBC] = s2; so[2 * XBC] = xr;
    }
    {
        const int j = g * 512 + tid; const bf16_t* ub = (const bf16_t*)(P.ws + WS_U) + (size_t)row * 1024;
        const float* st = P.state_sc + (size_t)bs * 2 * 1024 + j; const float s0 = st[0], s1 = st[1024], uc = bf2f(ub[j]);
        const float cv = s0 * P.sc_conv_w[j] + s1 * P.sc_conv_w[1024 + j] + uc * P.sc_conv_w[2048 + j];
        const float gb = bf2f(mix[1024 + j]); mix[1024 + j] = f2bf(gb * cv);
        float* so = P.out + O_SSC + (size_t)bs * 2 * 1024 + j; so[0] = s1; so[1024] = uc;
    }
    __syncthreads();
    const int h = g * 8 + wid;
    const float dt = ((const float*)(P.ws + WS_DTS))[bs * 16 + h], a = -__expf(P.a_log[h]), dA = __expf(dt * a);
    const float B0 = sx[512 + 2 * lane], B1 = sx[512 + 2 * lane + 1], C0 = sx[640 + 2 * lane], C1 = sx[640 + 2 * lane + 1];
    const float* hin = P.state_ssm + ((size_t)(bs * 16 + h) * 64) * 128 + 2 * lane;
    float* hout = P.out + O_SSSM + ((size_t)(bs * 16 + h) * 64) * 128 + 2 * lane;
    float ymine = 0.f;
#pragma unroll 8
    for (int p = 0; p < 64; ++p) { const float2 h0 = *(const float2*)(hin + p * 128); const float xd = dt * sx[wid * 64 + p];
        float2 hn; hn.x = dA * h0.x + xd * B0; hn.y = dA * h0.y + xd * B1; *(float2*)(hout + p * 128) = hn;
        float part = hn.x * C0 + hn.y * C1;
        part += __shfl_xor(part, 1); part += __shfl_xor(part, 2); part += __shfl_xor(part, 4); part += __shfl_xor(part, 8); part += __shfl_xor(part, 16); part += __shfl_xor(part, 32);
        if (lane == p) ymine = part; }
    const float xsv = sx[wid * 64 + lane];
    float y = ymine + P.ssd_d[h] * xsv;
    y *= silu_f(bf2f(mix[h * 64 + lane]));
    float sq = y * y;
    sq += __shfl_xor(sq, 1); sq += __shfl_xor(sq, 2); sq += __shfl_xor(sq, 4); sq += __shfl_xor(sq, 8); sq += __shfl_xor(sq, 16); sq += __shfl_xor(sq, 32);
    if (lane == 0) ssqs[wid] = sq;
    __syncthreads();
    float tot = 0.f;
#pragma unroll
    for (int i = 0; i < 8; ++i) tot += ssqs[i];
    const float rstd = rsqrtf(tot * (1.0f / 512.0f) + EPS);
    mix[h * 64 + lane] = f2bf(y * rstd * P.ssd_norm_w[h * 64 + lane]);
    __syncthreads();
}

__device__ __forceinline__ void p3_item(const Params& P, LAS unsigned char* lds, int item) {
    const int tid = threadIdx.x, lane = tid & 63, wid = tid >> 6, r16 = lane & 15, q = lane >> 4;
    const int b = item >> 5, c = (item >> 1) & 15, g = item & 1, h = g * 8 + wid, t0 = c * 128;
    LAS float* wsc = (LAS float*)lds + wid * 128;
    const float* dtp = (const float*)(P.ws + WS_DT) + (size_t)(b * 16 + h) * 2048 + t0;
    const float* acp = (const float*)(P.ws + WS_ACUM) + (size_t)(b * 16 + h) * 2048 + t0;
    const float alast = acp[127];
    wsc[lane] = dtp[lane] * __expf(alast - acp[lane]); wsc[lane + 64] = dtp[lane + 64] * __expf(alast - acp[lane + 64]);
    __syncthreads();
    const bf16_t* BTp = (const bf16_t*)((const unsigned char*)P.out + OS_BT) + ((size_t)(b * 2 + g) * 128) * 2048 + t0;
    const bf16_t* xsT = (const bf16_t*)(P.ws + WS_A1) + ((size_t)(b * 16 + h) * 64) * 2048 + t0;
    f32x4 acc[8][4];
#pragma unroll
    for (int i = 0; i < 8; ++i)
#pragma unroll
        for (int j = 0; j < 4; ++j) acc[i][j] = (f32x4){0.f, 0.f, 0.f, 0.f};
#pragma unroll 1
    for (int kk = 0; kk < 4; ++kk) { const int s0 = 32 * kk + 8 * q;
        float sc[8]; { const f32x4 a = *(const LAS f32x4*)(wsc + s0), b2 = *(const LAS f32x4*)(wsc + s0 + 4); sc[0] = a[0]; sc[1] = a[1]; sc[2] = a[2]; sc[3] = a[3]; sc[4] = b2[0]; sc[5] = b2[1]; sc[6] = b2[2]; sc[7] = b2[3]; }
        bf16x8 bfr[4];
#pragma unroll
        for (int pt = 0; pt < 4; ++pt) { const u32x4 rawv = *(const u32x4*)(xsT + (size_t)(pt * 16 + r16) * 2048 + s0); float f[8]; unpack8(rawv, f);
#pragma unroll
            for (int j = 0; j < 8; ++j) f[j] *= sc[j];
            bfr[pt] = __builtin_bit_cast(bf16x8, pack8(f)); }
#pragma unroll
        for (int nt = 0; nt < 8; ++nt) { const bf16x8 afr = *(const bf16x8*)(BTp + (size_t)(nt * 16 + r16) * 2048 + s0);
#pragma unroll
            for (int pt = 0; pt < 4; ++pt) acc[nt][pt] = __builtin_amdgcn_mfma_f32_16x16x32_bf16(afr, bfr[pt], acc[nt][pt], 0, 0, 0); }
    }
    bf16_t* stp = (bf16_t*)((unsigned char*)P.out + OS_ST) + (((size_t)(b * 16 + c) * 16 + h) * 64) * 128;
#pragma unroll
    for (int nt = 0; nt < 8; ++nt)
#pragma unroll
        for (int pt = 0; pt < 4; ++pt) { u32x2 w; w.x = cvt_pk_bf16(acc[nt][pt][0], acc[nt][pt][1]); w.y = cvt_pk_bf16(acc[nt][pt][2], acc[nt][pt][3]);
            *(u32x2*)(stp + (size_t)(pt * 16 + r16) * 128 + nt * 16 + 4 * q) = w; }
    __syncthreads();
}

__device__ __forceinline__ void phase4(const Params& P) {
    const int tid = threadIdx.x, G = gridDim.x, bx = blockIdx.x;
    for (int idx = bx * 512 + tid; idx < 262144; idx += G * 512) {
        const int n4 = idx & 31, pp = (idx >> 5) & 63, h = (idx >> 11) & 15, b = idx >> 15;
        const float* acp = (const float*)(P.ws + WS_ACUM) + (size_t)(b * 16 + h) * 2048;
        f32x4 hs = (f32x4){0.f, 0.f, 0.f, 0.f};
#pragma unroll 4
        for (int c = 0; c < 16; ++c) { u32x2* ptr = (u32x2*)((bf16_t*)((unsigned char*)P.out + OS_ST) + ((((size_t)(b * 16 + c) * 16 + h) * 64 + pp) * 128 + n4 * 4));
            const u32x2 s = *ptr; u32x2 w; w.x = cvt_pk_bf16(hs[0], hs[1]); w.y = cvt_pk_bf16(hs[2], hs[3]); *ptr = w;
            const float dec = __expf(acp[c * 128 + 127]);
            hs[0] = dec * hs[0] + bf_lo(s.x); hs[1] = dec * hs[1] + bf_hi(s.x); hs[2] = dec * hs[2] + bf_lo(s.y); hs[3] = dec * hs[3] + bf_hi(s.y); }
        *(f32x4*)(P.out + O_PSSM + ((size_t)(b * 16 + h) * 64 + pp) * 128 + n4 * 4) = hs;
    }
    for (int it = bx; it < 256; it += G) {
        const int rowbase = it * 64, b = it >> 5, tl0 = (it & 31) * 64, cg8 = (tid & 127) * 8, r0 = (tid >> 7) * 16;
        const bf16_t* ub = (const bf16_t*)(P.ws + WS_U) + (size_t)(rowbase + r0) * 1024 + cg8;
        bf16_t* mix = (bf16_t*)(P.ws + WS_MIX) + (size_t)(rowbase + r0) * 2048 + 1024 + cg8;
        float w0[8], w1[8], w2[8], um2[8], um1[8];
        ld8f(P.sc_conv_w + cg8, w0); ld8f(P.sc_conv_w + 1024 + cg8, w1); ld8f(P.sc_conv_w + 2048 + cg8, w2);
        if (tl0 + r0 >= 2) { unpack8(*(const u32x4*)(ub - 2 * 1024), um2); unpack8(*(const u32x4*)(ub - 1024), um1); }
        else {
#pragma unroll
            for (int j = 0; j < 8; ++j) { um2[j] = 0.f; um1[j] = 0.f; } }
#pragma unroll 4
        for (int i = 0; i < 16; ++i) { float uc[8], gb[8]; unpack8(*(const u32x4*)(ub + (size_t)i * 1024), uc); unpack8(*(const u32x4*)(mix + (size_t)i * 2048), gb);
#pragma unroll
            for (int j = 0; j < 8; ++j) { gb[j] *= um2[j] * w0[j] + um1[j] * w1[j] + uc[j] * w2[j]; um2[j] = um1[j]; um1[j] = uc[j]; }
            *(u32x4*)(mix + (size_t)i * 2048) = pack8(gb); }
        if (tl0 + r0 + 16 == 2048) { st8f(P.out + O_PSC + (size_t)(b * 2) * 1024 + cg8, um2); st8f(P.out + O_PSC + (size_t)(b * 2 + 1) * 1024 + cg8, um1); }
    }
}

__device__ __forceinline__ void p5_item(const Params& P, int item) {
    const int tid = threadIdx.x, lane = tid & 63, w = __builtin_amdgcn_readfirstlane(tid >> 6), r16 = lane & 15, q = lane >> 4;
    const int b = item >> 5, c = (item >> 1) & 15, g = item & 1, t0 = c * 128, l0 = 16 * w;
    const bf16_t* Bn = (const bf16_t*)((const unsigned char*)P.out + OS_BN) + ((size_t)(b * 2 + g) * 2048 + t0) * 128;
    const bf16_t* Cn = (const bf16_t*)((const unsigned char*)P.out + OS_CN) + ((size_t)(b * 2 + g) * 2048 + t0) * 128;
    bf16x8 cfr[4];
#pragma unroll
    for (int kk = 0; kk < 4; ++kk) cfr[kk] = *(const bf16x8*)(Cn + (size_t)(l0 + r16) * 128 + 32 * kk + 8 * q);
    f32x4 GT[8];
#pragma unroll
    for (int j = 0; j < 8; ++j) { GT[j] = (f32x4){0.f, 0.f, 0.f, 0.f};
        if (j <= w) {
#pragma unroll
            for (int kk = 0; kk < 4; ++kk) { const bf16x8 afr = *(const bf16x8*)(Bn + (size_t)(16 * j + r16) * 128 + 32 * kk + 8 * q); GT[j] = __builtin_amdgcn_mfma_f32_16x16x32_bf16(afr, cfr[kk], GT[j], 0, 0, 0); } } }
    const int lidx = l0 + r16;
    bf16_t* mixrow = (bf16_t*)(P.ws + WS_MIX) + (size_t)(b * 2048 + t0 + lidx) * 2048;
    float ssq = 0.f;
#pragma unroll 1
    for (int r = 0; r < 8; ++r) {
        const int h = g * 8 + r;
        const float* acp = (const float*)(P.ws + WS_ACUM) + (size_t)(b * 16 + h) * 2048 + t0;
        const float* dtp = (const float*)(P.ws + WS_DT) + (size_t)(b * 16 + h) * 2048 + t0;
        const float acl = acp[lidx], Dh = P.ssd_d[h];
        const bf16_t* Hp = (const bf16_t*)((const unsigned char*)P.out + OS_ST) + (((size_t)(b * 16 + c) * 16 + h) * 64) * 128;
        const bf16_t* xsT = (const bf16_t*)(P.ws + WS_A1) + ((size_t)(b * 16 + h) * 64) * 2048 + t0;
        f32x4 acc[4];
#pragma unroll
        for (int pt = 0; pt < 4; ++pt) acc[pt] = (f32x4){0.f, 0.f, 0.f, 0.f};
#pragma unroll
        for (int kk = 0; kk < 4; ++kk)
#pragma unroll
            for (int pt = 0; pt < 4; ++pt) { const bf16x8 afr = *(const bf16x8*)(Hp + (size_t)(pt * 16 + r16) * 128 + 32 * kk + 8 * q); acc[pt] = __builtin_amdgcn_mfma_f32_16x16x32_bf16(afr, cfr[kk], acc[pt], 0, 0, 0); }
        { const float el = __expf(acl);
#pragma unroll
          for (int pt = 0; pt < 4; ++pt) acc[pt] *= el; }
#pragma unroll
        for (int kk = 0; kk < 4; ++kk) if (2 * kk <= w) {
            const f32x4 asa = *(const f32x4*)(acp + 32 * kk + 4 * q), dta = *(const f32x4*)(dtp + 32 * kk + 4 * q);
            const f32x4 asb = *(const f32x4*)(acp + 32 * kk + 16 + 4 * q), dtb = *(const f32x4*)(dtp + 32 * kk + 16 + 4 * q);
            float m[8];
#pragma unroll
            for (int j = 0; j < 4; ++j) { const int s = 32 * kk + 4 * q + j; float v = GT[2 * kk][j] * __expf(fminf(acl - asa[j], 0.f)) * dta[j]; v = s > lidx ? 0.f : v; v = s == lidx ? v + Dh : v; m[j] = v; }
#pragma unroll
            for (int j = 0; j < 4; ++j) { const int s = 32 * kk + 16 + 4 * q + j; float v = GT[2 * kk + 1][j] * __expf(fminf(acl - asb[j], 0.f)) * dtb[j]; v = s > lidx ? 0.f : v; v = s == lidx ? v + Dh : v; m[4 + j] = v; }
            const bf16x8 bfr = __builtin_bit_cast(bf16x8, pack8(m));
#pragma unroll
            for (int pt = 0; pt < 4; ++pt) { const bf16_t* xp = xsT + (size_t)(pt * 16 + r16) * 2048 + 32 * kk + 4 * q; const u32x2 lo = *(const u32x2*)xp, hi = *(const u32x2*)(xp + 16);
                u32x4 av; av.x = lo.x; av.y = lo.y; av.z = hi.x; av.w = hi.y;
                acc[pt] = __builtin_amdgcn_mfma_f32_16x16x32_bf16(__builtin_bit_cast(bf16x8, av), bfr, acc[pt], 0, 0, 0); }
        }
#pragma unroll
        for (int pt = 0; pt < 4; ++pt) { u32x2* zp = (u32x2*)(mixrow + h * 64 + pt * 16 + 4 * q); const u32x2 zz = *zp;
            const float y0 = acc[pt][0] * silu_f(bf_lo(zz.x)), y1 = acc[pt][1] * silu_f(bf_hi(zz.x)), y2 = acc[pt][2] * silu_f(bf_lo(zz.y)), y3 = acc[pt][3] * silu_f(bf_hi(zz.y));
            ssq += y0 * y0 + y1 * y1 + y2 * y2 + y3 * y3;
            u32x2 o; o.x = cvt_pk_bf16(y0, y1); o.y = cvt_pk_bf16(y2, y3); *zp = o; }
    }
    ssq += __shfl_xor(ssq, 16); ssq += __shfl_xor(ssq, 32);
    const float rstd = rsqrtf(ssq * (1.0f / 512.0f) + EPS);
    asm volatile("s_waitcnt vmcnt(0)" ::: "memory");
#pragma unroll 2
    for (int r = 0; r < 8; ++r)
#pragma unroll
        for (int pt = 0; pt < 4; ++pt) { const int cc = (g * 8 + r) * 64 + pt * 16 + 4 * q; u32x2* yp = (u32x2*)(mixrow + cc); const u32x2 yy = *yp; const f32x4 nw = *(const f32x4*)(P.ssd_norm_w + cc);
            u32x2 o; o.x = cvt_pk_bf16(bf_lo(yy.x) * rstd * nw[0], bf_hi(yy.x) * rstd * nw[1]); o.y = cvt_pk_bf16(bf_lo(yy.y) * rstd * nw[2], bf_hi(yy.y) * rstd * nw[3]); *yp = o; }
}

__device__ __forceinline__ void rmsnorm_rows(const float* src, const float* w, bf16_t* dstb, float* dstf) {
    const int tid = threadIdx.x, lane = tid & 63, wid = tid >> 6;
    for (int row = blockIdx.x * 8 + wid; row < TT; row += gridDim.x * 8) {
        const float* s = src + (size_t)row * 1024 + lane * 4;
        f32x4 v[4]; float ss = 0.f;
#pragma unroll
        for (int i = 0; i < 4; ++i) { v[i] = *(const f32x4*)(s + i * 256); ss += v[i][0] * v[i][0] + v[i][1] * v[i][1] + v[i][2] * v[i][2] + v[i][3] * v[i][3]; }
        ss += __shfl_xor(ss, 1); ss += __shfl_xor(ss, 2); ss += __shfl_xor(ss, 4); ss += __shfl_xor(ss, 8); ss += __shfl_xor(ss, 16); ss += __shfl_xor(ss, 32);
        const float rstd = rsqrtf(ss * (1.0f / 1024.0f) + EPS);
#pragma unroll
        for (int i = 0; i < 4; ++i) { const f32x4 wv = *(const f32x4*)(w + lane * 4 + i * 256); const f32x4 o = v[i] * rstd * wv;
            if (dstb) { u32x2 pk; pk.x = cvt_pk_bf16(o[0], o[1]); pk.y = cvt_pk_bf16(o[2], o[3]); *(u32x2*)(dstb + (size_t)row * 1024 + lane * 4 + i * 256) = pk; }
            else *(f32x4*)(dstf + (size_t)row * 1024 + lane * 4 + i * 256) = o; }
    }
}

__device__ __forceinline__ void phase9(const Params& P) {
    const int tid = threadIdx.x, G = gridDim.x, bx = blockIdx.x;
    const bf16_t* gate = (const bf16_t*)(P.ws + WS_GATE); bf16_t* up = (bf16_t*)(P.ws + WS_UP);
    const int NU = (TPR / 16) * 352;
    for (int uidx = bx * 512 + tid; uidx < NU; uidx += G * 512) {
        const int rb = uidx / 352, cg8 = (uidx % 352) * 8, row0 = rb * 16, b = row0 >> 11, tl0 = row0 & 2047;
        float w0[8], w1[8], w2[8], bb[8], gm2[8], gm1[8];
        ld8f(P.ffn_conv_w + cg8, w0); ld8f(P.ffn_conv_w + DFF + cg8, w1); ld8f(P.ffn_conv_w + 2 * DFF + cg8, w2); ld8f(P.ffn_conv_b + cg8, bb);
        const bf16_t* gp = gate + (size_t)row0 * DFF + cg8; bf16_t* upp = up + (size_t)row0 * DFF + cg8;
        if (tl0 >= 2) { unpack8(*(const u32x4*)(gp - 2 * DFF), gm2); unpack8(*(const u32x4*)(gp - DFF), gm1); }
        else {
#pragma unroll
            for (int j = 0; j < 8; ++j) { gm2[j] = 0.f; gm1[j] = 0.f; } }
#pragma unroll 4
        for (int i = 0; i < 16; ++i) { float gc[8], uv[8]; unpack8(*(const u32x4*)(gp + (size_t)i * DFF), gc); unpack8(*(const u32x4*)(upp + (size_t)i * DFF), uv);
#pragma unroll
            for (int j = 0; j < 8; ++j) { uv[j] *= silu_f(gm2[j] * w0[j] + gm1[j] * w1[j] + gc[j] * w2[j] + bb[j]); gm2[j] = gm1[j]; gm1[j] = gc[j]; }
            *(u32x4*)(upp + (size_t)i * DFF) = pack8(uv); }
        if (tl0 + 16 == 2048) { st8f(P.out + O_PFFN + (size_t)(b * 2) * DFF + cg8, gm2); st8f(P.out + O_PFFN + (size_t)(b * 2 + 1) * DFF + cg8, gm1); }
    }
    for (int uidx = bx * 512 + tid; uidx < TSM * 352; uidx += G * 512) {
        const int bs = uidx / 352, cg8 = (uidx % 352) * 8, row = TPR + bs;
        float w0[8], w1[8], w2[8], bb[8], s0[8], s1[8], gc[8], uv[8];
        ld8f(P.ffn_conv_w + cg8, w0); ld8f(P.ffn_conv_w + DFF + cg8, w1); ld8f(P.ffn_conv_w + 2 * DFF + cg8, w2); ld8f(P.ffn_conv_b + cg8, bb);
        ld8f(P.state_ffn + (size_t)(bs * 2) * DFF + cg8, s0); ld8f(P.state_ffn + (size_t)(bs * 2 + 1) * DFF + cg8, s1);
        unpack8(*(const u32x4*)(gate + (size_t)row * DFF + cg8), gc); unpack8(*(const u32x4*)(up + (size_t)row * DFF + cg8), uv);
#pragma unroll
        for (int j = 0; j < 8; ++j) uv[j] *= silu_f(s0[j] * w0[j] + s1[j] * w1[j] + gc[j] * w2[j] + bb[j]);
        *(u32x4*)(up + (size_t)row * DFF + cg8) = pack8(uv);
        st8f(P.out + O_SFFN + (size_t)(bs * 2) * DFF + cg8, s1); st8f(P.out + O_SFFN + (size_t)(bs * 2 + 1) * DFF + cg8, gc);
    }
}

constexpr int NPHASE = 12;
__global__ void __launch_bounds__(512, 2) fwd_megakernel(Params P) {
    extern __shared__ __attribute__((aligned(16))) unsigned char lds_raw[];
    LAS unsigned char* lds = (LAS unsigned char*)lds_raw;
    cg::grid_group grid = cg::this_grid();
    const int lo = P.ph_lo, hi = P.ph_hi, G = gridDim.x, bx = blockIdx.x;
#define IN(k) (lo <= (k) && (k) < hi)
#define SEAM(k) do { if (IN(k) && IN((k) + 1)) grid.sync(); } while (0)
    if (IN(0)) phase0(P, lds);
    SEAM(0);
    if (IN(1)) { pg8::Gemm g{(const bf16_t*)(P.ws + WS_A1), (const bf16_t*)(P.ws + WS_WIN), TPAD, NIN, 1024}; pg8::StaticOrder S; S.init(TPAD, NIN, G, bx);
        EpiIn E{(bf16_t*)(P.ws + WS_MIX), (bf16_t*)(P.ws + WS_XBC), (bf16_t*)(P.ws + WS_U)}; pg8::gemm_phase<EpiIn>(lds, g, S, E); }
    SEAM(1);
    if (IN(2)) { for (int it = bx; it < 3072; it += G) p2_conv_item(P, lds, it);
        for (int it = bx; it < 256; it += G) p2_sample_item(P, lds, it); }
    SEAM(2);
    if (IN(3)) { for (int it = bx; it < 256; it += G) p3_item(P, lds, it); }
    SEAM(3);
    if (IN(4)) phase4(P);
    SEAM(4);
    if (IN(5)) { for (int it = bx; it < 256; it += G) p5_item(P, it); }
    SEAM(5);
    if (IN(6)) { pg8::Gemm g{(const bf16_t*)(P.ws + WS_MIX), (const bf16_t*)(P.ws + WS_WOUT), TPAD, 1024, 2048}; pg8::StaticOrder S; S.init(TPAD, 1024, G, bx);
        EpiRes E{P.x_prompt, P.x_sample, P.out, 1}; pg8::gemm_phase<EpiRes>(lds, g, S, E); }
    SEAM(6);
    if (IN(7)) rmsnorm_rows(P.out, P.norm_ffn_w, (bf16_t*)(P.ws + WS_A1), nullptr);
    SEAM(7);
    if (IN(8)) { pg8::Gemm g{(const bf16_t*)(P.ws + WS_A1), (const bf16_t*)(P.ws + WS_WFFN), TPAD, NIN, 1024}; pg8::StaticOrder S; S.init(TPAD, NIN, G, bx);
        EpiFfn E{(bf16_t*)(P.ws + WS_GATE), (bf16_t*)(P.ws + WS_UP)}; pg8::gemm_phase<EpiFfn>(lds, g, S, E); }
    SEAM(8);
    if (IN(9)) phase9(P);
    SEAM(9);
    if (IN(10)) { pg8::Gemm g{(const bf16_t*)(P.ws + WS_UP), (const bf16_t*)(P.ws + WS_WDOWN), TPAD, 1024, DFF}; pg8::StaticOrder S; S.init(TPAD, 1024, G, bx);
        EpiRes E{P.x_prompt, P.x_sample, P.out, 0}; pg8::gemm_phase<EpiRes>(lds, g, S, E); }
    SEAM(10);
    if (IN(11)) rmsnorm_rows(P.out, P.norm_final_w, nullptr, P.out);
#undef IN
#undef SEAM
}

#ifndef N_LAUNCHES
#define N_LAUNCHES 1
#endif
extern "C" void kernel_launch(void* const* d_in, const int* in_sizes, int n_in, void* d_out, int out_size, void* d_ws, size_t ws_size, hipStream_t stream) {
    static int grid_blocks = 0;
    if (!grid_blocks) {
        int dev = 0, cus = 0, per_cu = 0;
        hipGetDevice(&dev);
        hipDeviceGetAttribute(&cus, hipDeviceAttributeMultiprocessorCount, dev);
        hipFuncSetAttribute((const void*)fwd_megakernel, hipFuncAttributeMaxDynamicSharedMemorySize, LDS_BYTES);
        hipOccupancyMaxActiveBlocksPerMultiprocessor(&per_cu, (const void*)fwd_megakernel, 512, LDS_BYTES);
        if (per_cu < 1) { fprintf(stderr, "occupancy query says %d blocks per CU\n", per_cu); per_cu = 1; }
        if (per_cu > 1) per_cu = 1;
        grid_blocks = cus * per_cu;
        if (ws_size < WS_END) fprintf(stderr, "workspace too small: %zu < %zu\n", ws_size, (size_t)WS_END);
    }
    Params p{};
    const float** pp = (const float**)&p;
    for (int i = 0; i < 22; ++i) pp[i] = (const float*)d_in[i];
    p.out = (float*)d_out; p.ws = (unsigned char*)d_ws;
    for (int li = 0; li < N_LAUNCHES; ++li) {
        p.ph_lo = (N_LAUNCHES == 1) ? 0 : li; p.ph_hi = (N_LAUNCHES == 1) ? NPHASE : li + 1;
        void* args[] = {&p};
        hipError_t e = hipLaunchCooperativeKernel((const void*)fwd_megakernel, dim3(grid_blocks), dim3(512), args, LDS_BYTES, stream);
        if (e != hipSuccess) fprintf(stderr, "cooperative launch failed: %s (grid %d)\n", hipGetErrorString(e), grid_blocks);
    }
}
```

```cpp
#include <hip/hip_runtime.h>
#include <cstdio>

#define LAS __attribute__((address_space(3)))
typedef unsigned short bf16_t;
typedef short bf16x8 __attribute__((ext_vector_type(8)));
typedef float f32x4 __attribute__((ext_vector_type(4)));
typedef unsigned u32x4 __attribute__((ext_vector_type(4)));
typedef unsigned u32x2 __attribute__((ext_vector_type(2)));

constexpr int TPR = 16384, TSM = 128, TT = 16512, TPAD = 16640;
constexpr int NIN = 5632, DINP = 5648, XBC = 1536, DFF = 2816;
constexpr float EPS = 1e-5f;
constexpr int LDS_BYTES = 131072 + 16;

constexpr size_t WS_WIN = 0;
constexpr size_t WS_WOUT = WS_WIN + (size_t)NIN * 1024 * 2;
constexpr size_t WS_WFFN = WS_WOUT + (size_t)1024 * 2048 * 2;
constexpr size_t WS_WDOWN = WS_WFFN + (size_t)NIN * 1024 * 2;
constexpr size_t WS_A1 = WS_WDOWN + (size_t)1024 * 2816 * 2;
constexpr size_t WS_DT = WS_A1 + (size_t)TPAD * 1024 * 2;
constexpr size_t WS_ACUM = WS_DT + (size_t)8 * 16 * 2048 * 4;
constexpr size_t WS_DTS = WS_ACUM + (size_t)8 * 16 * 2048 * 4;
constexpr size_t WS_BIG = WS_DTS + (size_t)128 * 16 * 4;
constexpr size_t WS_XBC = WS_BIG;
constexpr size_t WS_U = WS_XBC + (size_t)TPAD * 1536 * 2;
constexpr size_t WS_MIX = WS_U + (size_t)TPAD * 1024 * 2;
constexpr size_t WS_GATE = WS_BIG;
constexpr size_t WS_UP = WS_GATE + (size_t)TPAD * 2816 * 2;
constexpr size_t WS_BAR = WS_UP + (size_t)TPAD * 2816 * 2;
constexpr size_t WS_END = WS_BAR + 16384;
constexpr size_t OS_BN = 0;
constexpr size_t OS_BT = OS_BN + (size_t)8 * 2 * 2048 * 128 * 2;
constexpr size_t OS_CN = OS_BT + (size_t)8 * 2 * 2048 * 128 * 2;
constexpr size_t OS_ST = OS_CN + (size_t)8 * 2 * 2048 * 128 * 2;
constexpr size_t O_YS = 16777216, O_PSSM = 16908288, O_PSSDC = 17956864, O_PSC = 17993728, O_PFFN = 18010112;
constexpr size_t O_SSSM = 18055168, O_SSSDC = 34832384, O_SSC = 35422208, O_SFFN = 35684352;

__device__ __forceinline__ unsigned cvt_pk_bf16(float lo, float hi) { unsigned r; asm("v_cvt_pk_bf16_f32 %0, %1, %2" : "=v"(r) : "v"(lo), "v"(hi)); return r; }
__device__ __forceinline__ float bf_lo(unsigned u) { return __uint_as_float(u << 16); }
__device__ __forceinline__ float bf_hi(unsigned u) { return __uint_as_float(u & 0xffff0000u); }
__device__ __forceinline__ bf16_t f2bf(float f) { return (bf16_t)(cvt_pk_bf16(f, 0.f) & 0xffffu); }
__device__ __forceinline__ float bf2f(bf16_t b) { return __uint_as_float(((unsigned)b) << 16); }
__device__ __forceinline__ float silu_f(float v) { return v / (1.0f + __expf(-v)); }
__device__ __forceinline__ float softplus_f(float v) { return v > 20.f ? v : log1pf(__expf(v)); }
__device__ __forceinline__ void unpack8(const u32x4 u, float (&f)[8]) { f[0] = bf_lo(u.x); f[1] = bf_hi(u.x); f[2] = bf_lo(u.y); f[3] = bf_hi(u.y); f[4] = bf_lo(u.z); f[5] = bf_hi(u.z); f[6] = bf_lo(u.w); f[7] = bf_hi(u.w); }
__device__ __forceinline__ u32x4 pack8(const float (&f)[8]) { u32x4 u; u.x = cvt_pk_bf16(f[0], f[1]); u.y = cvt_pk_bf16(f[2], f[3]); u.z = cvt_pk_bf16(f[4], f[5]); u.w = cvt_pk_bf16(f[6], f[7]); return u; }
__device__ __forceinline__ void ld8f(const float* p, float (&f)[8]) { const f32x4 a = *(const f32x4*)p, b = *(const f32x4*)(p + 4); f[0] = a[0]; f[1] = a[1]; f[2] = a[2]; f[3] = a[3]; f[4] = b[0]; f[5] = b[1]; f[6] = b[2]; f[7] = b[3]; }
__device__ __forceinline__ void st8f(float* p, const float (&f)[8]) { *(f32x4*)p = (f32x4){f[0], f[1], f[2], f[3]}; *(f32x4*)(p + 4) = (f32x4){f[4], f[5], f[6], f[7]}; }


#define XB_TMO      128
#define XB_XCNT(j)  (256  + 64 * (j))
#define XB_XSUB(j)  (1280 + 64 * (j))
#define XB_XGEN(j)  (2304 + 64 * (j))
#define XB_TOP      3328
#define XB_TOPGEN   3392
#define XCD_BAR_WORDS 3456
#define XB_SPIN_CAP (1u << 18)
__device__ __forceinline__ unsigned xb_ld(unsigned* p)              { return __hip_atomic_load(p, __ATOMIC_RELAXED, __HIP_MEMORY_SCOPE_AGENT); }
__device__ __forceinline__ unsigned xb_add(unsigned* p, unsigned v) { return __hip_atomic_fetch_add(p, v, __ATOMIC_RELAXED, __HIP_MEMORY_SCOPE_AGENT); }
__device__ __forceinline__ unsigned xb_xcc_id() { return (unsigned)__builtin_amdgcn_s_getreg((3 << 11) | 20) & 0xFu; }
#define XB_SPIN(cond, bar) do { unsigned _sp = 0; while (cond) { __builtin_amdgcn_s_sleep(1); \
    if ((++_sp & 255u) == 0u) { if (xb_ld(&(bar)[XB_TMO])) break; if (_sp > XB_SPIN_CAP) { atomicAdd(&(bar)[XB_TMO], 1u); break; } } } } while (0)
struct XcdBarrier { unsigned* bar; unsigned x; volatile LAS unsigned* st; };
__device__ __forceinline__ XcdBarrier xcd_barrier_post(unsigned* bar, volatile LAS unsigned* st) {
    XcdBarrier b; b.bar = bar; b.x = xb_xcc_id(); b.st = st;
    if (threadIdx.x == 0) (void)xb_add(&bar[XB_XCNT(b.x)], 1u);
    return b;
}
__device__ __forceinline__ void xcd_barrier_complete(unsigned* bar, unsigned x, unsigned& nloc, unsigned& nx) {
    const unsigned G = gridDim.x * gridDim.y * gridDim.z;
    unsigned sum, cnt, mine, sp = 0u;
    for (;;) {
        sum = 0u; cnt = 0u; mine = 0u;
#pragma unroll
        for (unsigned j = 0; j < 16; ++j) { const unsigned c = xb_ld(&bar[XB_XCNT(j)]); sum += c; cnt += (c > 0u) ? 1u : 0u; mine = (j == x) ? c : mine; }
        if (sum == G) break;
        __builtin_amdgcn_s_sleep(1);
        if ((++sp & 255u) == 0u) { if (xb_ld(&bar[XB_TMO])) break; if (sp > XB_SPIN_CAP) { atomicAdd(&bar[XB_TMO], 1u); break; } }
    }
    nloc = mine > 0u ? mine : 1u; nx = cnt > 0u ? cnt : 1u;
}
__device__ __forceinline__ void xcd_barrier(const XcdBarrier& b) {
    asm volatile("s_waitcnt vmcnt(0)" ::: "memory");
    __syncthreads();
    if (threadIdx.x == 0) {
        unsigned* bar = b.bar;
        __builtin_amdgcn_s_waitcnt(0);
        unsigned nloc = b.st[0], nx = b.st[1];
        if (nloc == 0u) { xcd_barrier_complete(bar, b.x, nloc, nx); b.st[0] = nloc; b.st[1] = nx; }
        const unsigned old = xb_add(&bar[XB_XSUB(b.x)], 1u);
        const unsigned gen = old / nloc;
        if (old + 1u == (gen + 1u) * nloc) {
            __builtin_amdgcn_fence(__ATOMIC_RELEASE, "agent");
            asm volatile("s_waitcnt vmcnt(0)" ::: "memory");
            const unsigned og = xb_add(&bar[XB_TOP], 1u);
            const unsigned tg = og / nx;
            if (og + 1u == (tg + 1u) * nx) xb_add(&bar[XB_TOPGEN], 1u);
            else XB_SPIN(xb_ld(&bar[XB_TOPGEN]) == tg, bar);
            __builtin_amdgcn_fence(__ATOMIC_ACQUIRE, "agent");
            xb_add(&bar[XB_XGEN(b.x)], 1u);
            asm volatile("s_waitcnt vmcnt(0)" ::: "memory");
        } else {
            XB_SPIN(xb_ld(&bar[XB_XGEN(b.x)]) == gen, bar);
            __builtin_amdgcn_fence(__ATOMIC_ACQUIRE, "agent");
            asm volatile("s_waitcnt vmcnt(0)" ::: "memory");
        }
    }
    __syncthreads();
}

namespace pg8 {
constexpr int BM = 256, BK = 64, HALF = 128, HTB = HALF * BK * 2, NXCD = 8, WGM = 8;
__device__ __forceinline__ int lds_byte(int r, int c) { const int st = (r >> 4) * 2 + (c >> 5), rr = r & 15, cc = c & 31, ob = rr * 64 + cc * 2; return st * 1024 + (ob ^ (((ob >> 9) & 1) << 5)); }
__device__ __forceinline__ void stage_rc(int b, int& R, int& C) { const int st = b / 1024, sb = b % 1024, swz = sb ^ (((sb >> 9) & 1) << 5); R = (st >> 1) * 16 + swz / 64; C = (st & 1) * 32 + (swz % 64) / 2; }
__device__ __forceinline__ int perm32(int rho) { const int n = rho >> 4, i = rho & 15; return 8 * (i >> 2) + 4 * n + (i & 3); }
struct Unit { int pm, pn; };
struct Gemm { const bf16_t* A; const bf16_t* Bt; int M, N, K; };
struct StaticOrder {
    int nM, nN, nwg, G, c;
    __device__ void init(int M, int N, int G_, int c_) { nM = M / BM; nN = N / BM; nwg = nM * nN; G = G_; c = c_; }
    __device__ bool next(int i, Unit& u) const {
        const long L = (long)i * G + c; if (L >= nwg) return false;
        int wgid = (int)L; { const int q = nwg / NXCD, r = nwg % NXCD, xcd = wgid % NXCD, off = wgid / NXCD; wgid = (xcd < r ? xcd * (q + 1) : r * (q + 1) + (xcd - r) * q) + off; }
        const int nig = WGM * nN, gid = wgid / nig, fm = gid * WGM, gsz = (nM - fm) < WGM ? (nM - fm) : WGM;
        u.pm = fm + ((wgid % nig) % gsz); u.pn = (wgid % nig) / gsz; return true;
    }
};
template <class Epi>
__device__ __forceinline__ void gemm_phase(LAS unsigned char* lds, const Gemm g, const StaticOrder& S, const Epi& E) {
    const int tid = threadIdx.x, wid = __builtin_amdgcn_readfirstlane(tid >> 6), lane = tid & 63, wr = wid >> 2, wc = wid & 3, fr = lane & 15, fq = lane >> 4;
    const int K = g.K, nt = K / BK;
    unsigned voffA[2], voffB[2];
#pragma unroll
    for (int i = 0; i < 2; ++i) { int R, C; stage_rc(tid * 16 + i * 8192, R, C); const int Rb = Epi::PERM ? ((R & ~31) + perm32(R & 31)) : R;
        voffA[i] = (unsigned)(R * K + C) * 2u; voffB[i] = (unsigned)(Rb * K + C) * 2u; }
    const size_t kstep = (size_t)(BK * 2);
    const size_t hstep = (size_t)HALF * K * 2;
    const size_t tstep = 2 * hstep;
    const unsigned ldsw = (unsigned)wid * 1024u;
    const int aoff = lds_byte(wr * 64 + fr, fq * 8), boff = lds_byte(wc * 32 + fr, fq * 8);
#define PG8_SA(b, h) (((b) * 2 + (h)) * HTB)
#define PG8_SB(b, h) ((4 + (b) * 2 + (h)) * HTB)
#define PG8_STAGE(bufoff, gbase, voff) do { _Pragma("unroll") for (int _i = 0; _i < 2; ++_i) \
        __builtin_amdgcn_global_load_lds((const unsigned*)((const char*)(gbase) + (voff)[_i]), (LAS unsigned*)(lds + (bufoff) + ldsw + _i * 8192), 16, 0, 0); } while (0)
#define PG8_LDA(dst, b, h) do { _Pragma("unroll") for (int m = 0; m < 4; ++m) _Pragma("unroll") for (int k = 0; k < 2; ++k) dst[m][k] = *(const LAS bf16x8*)(lds + PG8_SA(b, h) + aoff + m * 2048 + k * 1024); } while (0)
#define PG8_LDB(dst, b, h) do { _Pragma("unroll") for (int n = 0; n < 2; ++n) _Pragma("unroll") for (int k = 0; k < 2; ++k) dst[n][k] = *(const LAS bf16x8*)(lds + PG8_SB(b, h) + boff + n * 2048 + k * 1024); } while (0)
#define PG8_MMA(ai, bj, At, Bt) do { __builtin_amdgcn_s_setprio(1); _Pragma("unroll") for (int m = 0; m < 4; ++m) _Pragma("unroll") for (int n = 0; n < 2; ++n) _Pragma("unroll") for (int k = 0; k < 2; ++k) \
        acc[ai][bj][m][n] = __builtin_amdgcn_mfma_f32_16x16x32_bf16(Bt[n][k], At[m][k], acc[ai][bj][m][n], 0, 0, 0); __builtin_amdgcn_s_setprio(0); } while (0)
#define PG8_WAIT_V(n) asm volatile("s_waitcnt vmcnt(" #n ")" ::: "memory")
#define PG8_WAIT_L(n) asm volatile("s_waitcnt lgkmcnt(" #n ")" ::: "memory")
#define PG8_BAR __builtin_amdgcn_s_barrier()
#define PG8_SCHED __builtin_amdgcn_sched_barrier(0)
    Unit cur, nxt; int ui = 0;
    if (!S.next(0, cur)) return;
    f32x4 acc[2][2][4][2];
#pragma unroll
    for (int a = 0; a < 2; ++a)
#pragma unroll
        for (int b = 0; b < 2; ++b)
#pragma unroll
            for (int m = 0; m < 4; ++m)
#pragma unroll
                for (int n = 0; n < 2; ++n) acc[a][b][m][n] = (f32x4){0.f, 0.f, 0.f, 0.f};
    bf16x8 At[4][2], B0[2][2], B1[2][2];
    const char* cA = (const char*)g.A + (size_t)cur.pm * tstep; const char* cB = (const char*)g.Bt + (size_t)cur.pn * tstep;
    PG8_STAGE(PG8_SB(0, 0), cB, voffB); PG8_STAGE(PG8_SA(0, 0), cA, voffA); PG8_STAGE(PG8_SB(0, 1), cB + hstep, voffB); PG8_STAGE(PG8_SA(0, 1), cA + hstep, voffA);
    if (wr == 1) PG8_BAR;
    PG8_WAIT_V(4); PG8_BAR;
    PG8_STAGE(PG8_SB(1, 0), cB + kstep, voffB); PG8_STAGE(PG8_SA(1, 0), cA + kstep, voffA); PG8_STAGE(PG8_SB(1, 1), cB + hstep + kstep, voffB);
    PG8_WAIT_V(6); PG8_BAR;
    for (;;) {
        const bool has_next = S.next(ui + 1, nxt);
        const char* nA = has_next ? (const char*)g.A + (size_t)nxt.pm * tstep : cA; const char* nB = has_next ? (const char*)g.Bt + (size_t)nxt.pn * tstep : cB;
        for (int t = 0; t < nt; t += 2) {
            const bool last = (t == nt - 2);
            const char* a1 = cA + (size_t)(t + 1) * kstep;
            const char* a2 = last ? nA : cA + (size_t)(t + 2) * kstep; const char* b2 = last ? nB : cB + (size_t)(t + 2) * kstep;
            const char* a3 = a2 + kstep; const char* b3 = b2 + kstep;
            PG8_LDB(B0, 0, 0); PG8_SCHED; PG8_LDA(At, 0, 0); PG8_STAGE(PG8_SA(1, 1), a1 + hstep, voffA);
            PG8_WAIT_L(8); PG8_BAR; PG8_WAIT_L(0); PG8_MMA(0, 0, At, B0); PG8_BAR; PG8_SCHED;
            PG8_LDB(B1, 0, 1); PG8_STAGE(PG8_SB(0, 0), b2, voffB);
            PG8_BAR; PG8_WAIT_L(0); PG8_MMA(0, 1, At, B1); PG8_BAR;
            PG8_LDA(At, 0, 1); PG8_STAGE(PG8_SA(0, 0), a2, voffA);
            PG8_BAR; PG8_WAIT_L(0); PG8_MMA(1, 0, At, B0); PG8_BAR; PG8_SCHED;
            PG8_STAGE(PG8_SB(0, 1), b2 + hstep, voffB);
            PG8_WAIT_V(6); PG8_BAR; PG8_MMA(1, 1, At, B1); PG8_BAR;
            PG8_LDB(B0, 1, 0); PG8_SCHED; PG8_LDA(At, 1, 0); PG8_STAGE(PG8_SA(0, 1), a2 + hstep, voffA);
            PG8_WAIT_L(8); PG8_BAR; PG8_WAIT_L(0); PG8_MMA(0, 0, At, B0); PG8_BAR; PG8_SCHED;
            PG8_LDB(B1, 1, 1); PG8_STAGE(PG8_SB(1, 0), b3, voffB);
            PG8_BAR; PG8_WAIT_L(0); PG8_MMA(0, 1, At, B1); PG8_BAR;
            PG8_LDA(At, 1, 1); PG8_STAGE(PG8_SA(1, 0), a3, voffA);
            PG8_BAR; PG8_WAIT_L(0); PG8_MMA(1, 0, At, B0); PG8_BAR; PG8_SCHED;
            PG8_STAGE(PG8_SB(1, 1), b3 + hstep, voffB);
            PG8_WAIT_V(6); PG8_BAR; PG8_MMA(1, 1, At, B1); PG8_BAR;
        }
        E(acc, cur, wr, wc, fr, fq);
        if (!has_next) break;
#pragma unroll
        for (int a = 0; a < 2; ++a)
#pragma unroll
            for (int b = 0; b < 2; ++b)
#pragma unroll
                for (int m = 0; m < 4; ++m)
#pragma unroll
                    for (int n = 0; n < 2; ++n) acc[a][b][m][n] = (f32x4){0.f, 0.f, 0.f, 0.f};
        cur = nxt; cA = nA; cB = nB; ++ui;
    }
    PG8_WAIT_V(0);
    if (wr == 0) PG8_BAR;
    PG8_BAR;
#undef PG8_SA
#undef PG8_SB
#undef PG8_STAGE
#undef PG8_LDA
#undef PG8_LDB
#undef PG8_MMA
#undef PG8_WAIT_V
#undef PG8_WAIT_L
#undef PG8_BAR
#undef PG8_SCHED
}
}

struct EpiIn {
    static constexpr bool PERM = true;
    bf16_t* mix; bf16_t* xbc; bf16_t* ub;
    __device__ __forceinline__ void operator()(const f32x4 (&acc)[2][2][4][2], const pg8::Unit& u, int wr, int wc, int fr, int fq) const {
        const int row0 = u.pm * 256 + wr * 64 + fr, cin = wc * 32 + 8 * fq;
        if (u.pn >= 14) {
            bf16_t* base = ub + (u.pn - 14) * 128 + cin;
#pragma unroll
            for (int ai = 0; ai < 2; ++ai)
#pragma unroll
                for (int m = 0; m < 4; ++m) { const f32x4 v0 = acc[ai][0][m][0] * acc[ai][1][m][0], v1 = acc[ai][0][m][1] * acc[ai][1][m][1];
                    u32x4 w; w.x = cvt_pk_bf16(v0[0], v0[1]); w.y = cvt_pk_bf16(v0[2], v0[3]); w.z = cvt_pk_bf16(v1[0], v1[1]); w.w = cvt_pk_bf16(v1[2], v1[3]);
                    *(u32x4*)(base + (size_t)(row0 + ai * 128 + m * 16) * 1024) = w; }
        } else {
            bf16_t* base; int ld;
            if (u.pn < 4) { base = mix + u.pn * 256; ld = 2048; } else if (u.pn < 10) { base = xbc + (u.pn - 4) * 256; ld = XBC; } else { base = mix + 1024 + (u.pn - 10) * 256; ld = 2048; }
            base += cin;
#pragma unroll
            for (int ai = 0; ai < 2; ++ai)
#pragma unroll
                for (int m = 0; m < 4; ++m) { bf16_t* rp = base + (size_t)(row0 + ai * 128 + m * 16) * ld;
#pragma unroll
                    for (int bj = 0; bj < 2; ++bj) { const f32x4 v0 = acc[ai][bj][m][0], v1 = acc[ai][bj][m][1];
                        u32x4 w; w.x = cvt_pk_bf16(v0[0], v0[1]); w.y = cvt_pk_bf16(v0[2], v0[3]); w.z = cvt_pk_bf16(v1[0], v1[1]); w.w = cvt_pk_bf16(v1[2], v1[3]);
                        *(u32x4*)(rp + bj * 128) = w; } }
        }
    }
};
struct EpiFfn {
    static constexpr bool PERM = true;
    bf16_t* gate; bf16_t* up;
    __device__ __forceinline__ void operator()(const f32x4 (&acc)[2][2][4][2], const pg8::Unit& u, int wr, int wc, int fr, int fq) const {
        const int row0 = u.pm * 256 + wr * 64 + fr, cin = wc * 32 + 8 * fq;
        bf16_t* base = (u.pn < 11 ? gate + u.pn * 256 : up + (u.pn - 11) * 256) + cin;
#pragma unroll
        for (int ai = 0; ai < 2; ++ai)
#pragma unroll
            for (int m = 0; m < 4; ++m) { bf16_t* rp = base + (size_t)(row0 + ai * 128 + m * 16) * DFF;
#pragma unroll
                for (int bj = 0; bj < 2; ++bj) { const f32x4 v0 = acc[ai][bj][m][0], v1 = acc[ai][bj][m][1];
                    u32x4 w; w.x = cvt_pk_bf16(v0[0], v0[1]); w.y = cvt_pk_bf16(v0[2], v0[3]); w.z = cvt_pk_bf16(v1[0], v1[1]); w.w = cvt_pk_bf16(v1[2], v1[3]);
                    *(u32x4*)(rp + bj * 128) = w; } }
    }
};
struct EpiRes {
    static constexpr bool PERM = false;
    const float* xp; const float* xs; float* out; int use_x;
    __device__ __forceinline__ void operator()(const f32x4 (&acc)[2][2][4][2], const pg8::Unit& u, int wr, int wc, int fr, int fq) const {
        const int row0 = u.pm * 256 + wr * 64 + fr, col0 = u.pn * 256 + wc * 32 + 4 * fq;
#pragma unroll
        for (int ai = 0; ai < 2; ++ai)
#pragma unroll
            for (int m = 0; m < 4; ++m) { const int row = row0 + ai * 128 + m * 16;
                if (row < TT) { float* o = out + (size_t)row * 1024 + col0;
                    const float* b = use_x ? (row < TPR ? xp + (size_t)row * 1024 : xs + (size_t)(row - TPR) * 1024) + col0 : o;
#pragma unroll
                    for (int bj = 0; bj < 2; ++bj)
#pragma unroll
                        for (int n = 0; n < 2; ++n) { const f32x4 bv = *(const f32x4*)(b + bj * 128 + n * 16); *(f32x4*)(o + bj * 128 + n * 16) = bv + acc[ai][bj][m][n]; } }
                asm volatile("" ::: "memory"); }
    }
};

struct Params {
    const float* x_prompt; const float* x_sample; const float* state_ssm; const float* state_ssd_conv; const float* state_sc; const float* state_ffn;
    const float* norm_mix_w; const float* w_in; const float* ssd_conv_w; const float* ssd_conv_b; const float* dt_bias; const float* a_log; const float* ssd_d; const float* ssd_norm_w;
    const float* sc_conv_w; const float* w_out; const float* norm_ffn_w; const float* w_ffn_in; const float* ffn_conv_w; const float* ffn_conv_b; const float* w_down; const float* norm_final_w;
    float* out; unsigned char* ws; int ph_lo, ph_hi;
};

__device__ __forceinline__ int map_in(int j0) {
    if (j0 < 2560) return j0;
    if (j0 < 3584) return 2576 + (j0 - 2560);
    const int k = (j0 - 3584) >> 8, w = (j0 - 3584) & 255;
    return w < 128 ? 3600 + k * 128 + w : 4624 + k * 128 + (w - 128);
}
__device__ __forceinline__ void p0_chunk(const Params& P, LAS unsigned char* lds, int ci) {
    const int tid = threadIdx.x, lane = tid & 63, wid = tid >> 6, r16 = lane & 15, q = lane >> 4;
    LAS bf16_t* wdt = (LAS bf16_t*)lds;
    LAS float* dts = (LAS float*)(lds + 33024);
    LAS float* segs = (LAS float*)(lds + 33024 + 8192);
#pragma unroll
    for (int i = 0; i < 8; ++i) { const int k = (tid >> 2) + 128 * i, c4 = (tid & 3) * 4; const f32x4 v = *(const f32x4*)(P.w_in + (size_t)k * DINP + 2560 + c4);
        wdt[(c4 + 0) * 1032 + k] = f2bf(v[0]); wdt[(c4 + 1) * 1032 + k] = f2bf(v[1]); wdt[(c4 + 2) * 1032 + k] = f2bf(v[2]); wdt[(c4 + 3) * 1032 + k] = f2bf(v[3]); }
    __syncthreads();
    const int row = ci * 128 + wid * 16 + r16;
    const float* src = (row < TPR ? P.x_prompt + (size_t)row * 1024 : P.x_sample + (size_t)(row - TPR) * 1024) + 8 * q;
    float ss = 0.f;
#pragma unroll 8
    for (int s = 0; s < 32; ++s) { const f32x4 a = *(const f32x4*)(src + 32 * s), b = *(const f32x4*)(src + 32 * s + 4);
        ss += a[0] * a[0] + a[1] * a[1] + a[2] * a[2] + a[3] * a[3] + b[0] * b[0] + b[1] * b[1] + b[2] * b[2] + b[3] * b[3]; }
    ss += __shfl_xor(ss, 16); ss += __shfl_xor(ss, 32);
    const float rstd = rsqrtf(ss * (1.0f / 1024.0f) + EPS);
    bf16_t* dst = (bf16_t*)(P.ws + WS_A1) + (size_t)row * 1024 + 8 * q;
    const float* nw = P.norm_mix_w + 8 * q;
    f32x4 acc = (f32x4){0.f, 0.f, 0.f, 0.f};
#pragma unroll 4
    for (int s = 0; s < 32; ++s) { float xv[8], wv[8]; ld8f(src + 32 * s, xv); ld8f(nw + 32 * s, wv);
#pragma unroll
        for (int j = 0; j < 8; ++j) xv[j] = xv[j] * rstd * wv[j];
        const u32x4 pk = pack8(xv); *(u32x4*)(dst + 32 * s) = pk;
        const bf16x8 bfr = *(const LAS bf16x8*)(wdt + r16 * 1032 + 32 * s + 8 * q);
        acc = __builtin_amdgcn_mfma_f32_16x16x32_bf16(__builtin_bit_cast(bf16x8, pk), bfr, acc, 0, 0, 0); }
    { const float bias = P.dt_bias[r16];
#pragma unroll
      for (int j = 0; j < 4; ++j) dts[(wid * 16 + 4 * q + j) * 16 + r16] = softplus_f(acc[j] + bias); }
    __syncthreads();
    if (ci < 128) {
        const int b = ci >> 4, c = ci & 15, h = tid & 15, seg = (tid >> 4) & 15;
        float d[8], cs[8];
        if (tid < 256) { const float a = -__expf(P.a_log[h]); float run = 0.f;
#pragma unroll
            for (int i = 0; i < 8; ++i) { d[i] = dts[(seg * 8 + i) * 16 + h]; run += d[i] * a; cs[i] = run; }
            segs[seg * 16 + h] = run; }
        __syncthreads();
        if (tid < 256) { float pre = 0.f;
#pragma unroll
            for (int s2 = 0; s2 < 16; ++s2) pre += (s2 < seg) ? segs[s2 * 16 + h] : 0.f;
#pragma unroll
            for (int i = 0; i < 8; ++i) cs[i] += pre;
            const size_t o = (size_t)(b * 16 + h) * 2048 + c * 128 + seg * 8;
            st8f((float*)(P.ws + WS_DT) + o, d); st8f((float*)(P.ws + WS_ACUM) + o, cs); }
    } else {
        float* dtsg = (float*)(P.ws + WS_DTS);
        for (int i = tid; i < 2048; i += 512) dtsg[i] = dts[i];
    }
    __syncthreads();
}
__device__ __forceinline__ void p0_tile(const Params& P, LAS unsigned char* lds, int t) {
    const int tid = threadIdx.x;
    const float* src; bf16_t* dst; int K, Ns, kt, nt, c0;
    if (t < 1408) { src = P.w_in; dst = (bf16_t*)(P.ws + WS_WIN); K = 1024; Ns = DINP; kt = t / 88; nt = t % 88; c0 = map_in(nt * 64); }
    else if (t < 1920) { t -= 1408; src = P.w_out; dst = (bf16_t*)(P.ws + WS_WOUT); K = 2048; Ns = 1024; kt = t >> 4; nt = t & 15; c0 = nt * 64; }
    else if (t < 3328) { t -= 1920; src = P.w_ffn_in; dst = (bf16_t*)(P.ws + WS_WFFN); K = 1024; Ns = NIN; kt = t / 88; nt = t % 88; c0 = nt * 64; }
    else { t -= 3328; src = P.w_down; dst = (bf16_t*)(P.ws + WS_WDOWN); K = 2816; Ns = 1024; kt = t >> 4; nt = t & 15; c0 = nt * 64; }
    LAS float* tl = (LAS float*)lds;
    const int k0 = kt * 64;
#pragma unroll
    for (int i = 0; i < 2; ++i) { const int kr = (tid >> 4) + 32 * i, c4 = (tid & 15) * 4; const f32x4 v = *(const f32x4*)(src + (size_t)(k0 + kr) * Ns + c0 + c4);
        tl[kr * 65 + c4 + 0] = v[0]; tl[kr * 65 + c4 + 1] = v[1]; tl[kr * 65 + c4 + 2] = v[2]; tl[kr * 65 + c4 + 3] = v[3]; }
    __syncthreads();
    { const int n = tid >> 3, k8 = (tid & 7) * 8; float f[8];
#pragma unroll
      for (int i = 0; i < 8; ++i) f[i] = tl[(k8 + i) * 65 + n];
      *(u32x4*)(dst + (size_t)(nt * 64 + n) * K + k0 + k8) = pack8(f); }
    __syncthreads();
}
__device__ __forceinline__ void phase0(const Params& P, LAS unsigned char* lds) {
    const int G = gridDim.x, bx = blockIdx.x, NCI = 129, NTL = 4032;
    for (int ci = bx; ci < NCI; ci += G) p0_chunk(P, lds, ci);
    if (G > NCI) { if (bx >= NCI) for (int t = bx - NCI; t < NTL; t += G - NCI) p0_tile(P, lds, t); }
    else for (int t = bx; t < NTL; t += G) p0_tile(P, lds, t);
}

__device__ __forceinline__ void p2_conv_item(const Params& P, LAS unsigned char* lds, int item) {
    const int tid = threadIdx.x;
    const int strip = item % 24, bc = item / 24, b = bc >> 4, c = bc & 15, t0 = c * 128;
    const int colg = strip < 16 ? strip * 64 : (strip < 20 ? 1024 + (strip - 16) * 64 : 1280 + (strip - 20) * 64);
    LAS bf16_t* raw = (LAS bf16_t*)lds;
    LAS bf16_t* outn = (LAS bf16_t*)(lds + 16768);
    const bf16_t* xbc = (const bf16_t*)(P.ws + WS_XBC);
    for (int i = tid; i < 131 * 8; i += 512) { const int rr = i >> 3, c8 = (i & 7) * 8; const int tl = t0 - 3 + rr;
        u32x4 v = (u32x4){0u, 0u, 0u, 0u};
        if (tl >= 0) v = *(const u32x4*)(xbc + (size_t)(b * 2048 + tl) * XBC + colg + c8);
        *(LAS u32x4*)(raw + rr * 64 + c8) = v; }
    __syncthreads();
    const int col = tid & 63, rg = tid >> 6;
    const float w0 = P.ssd_conv_w[colg + col], w1 = P.ssd_conv_w[XBC + colg + col], w2 = P.ssd_conv_w[2 * XBC + colg + col], w3 = P.ssd_conv_w[3 * XBC + colg + col], bs = P.ssd_conv_b[colg + col];
    float o[16];
    { float x0 = bf2f(raw[(rg * 16 + 0) * 64 + col]), x1 = bf2f(raw[(rg * 16 + 1) * 64 + col]), x2 = bf2f(raw[(rg * 16 + 2) * 64 + col]);
#pragma unroll
      for (int i = 0; i < 16; ++i) { const float x3 = bf2f(raw[(rg * 16 + i + 3) * 64 + col]); o[i] = silu_f(x0 * w0 + x1 * w1 + x2 * w2 + x3 * w3 + bs); x0 = x1; x1 = x2; x2 = x3; } }
    u32x4 pk0, pk1;
    pk0.x = cvt_pk_bf16(o[0], o[1]); pk0.y = cvt_pk_bf16(o[2], o[3]); pk0.z = cvt_pk_bf16(o[4], o[5]); pk0.w = cvt_pk_bf16(o[6], o[7]);
    pk1.x = cvt_pk_bf16(o[8], o[9]); pk1.y = cvt_pk_bf16(o[10], o[11]); pk1.z = cvt_pk_bf16(o[12], o[13]); pk1.w = cvt_pk_bf16(o[14], o[15]);
    if (strip < 16) {
        bf16_t* d = (bf16_t*)(P.ws + WS_A1) + ((size_t)(b * 16 + strip) * 64 + col) * 2048 + t0 + rg * 16;
        *(u32x4*)d = pk0; *(u32x4*)(d + 8) = pk1;
    } else {
        const int sb = (strip - 16) & 3, g = sb >> 1, n0 = (sb & 1) * 64;
        if (strip < 20) { bf16_t* d = (bf16_t*)((unsigned char*)P.out + OS_BT) + ((size_t)(b * 2 + g) * 128 + n0 + col) * 2048 + t0 + rg * 16; *(u32x4*)d = pk0; *(u32x4*)(d + 8) = pk1; }
#pragma unroll
        for (int i = 0; i < 16; ++i) outn[(rg * 16 + i) * 64 + col] = f2bf(o[i]);
        __syncthreads();
        bf16_t* nat = (bf16_t*)((unsigned char*)P.out + (strip < 20 ? OS_BN : OS_CN)) + ((size_t)(b * 2 + g) * 2048 + t0) * 128 + n0;
        for (int i = tid; i < 1024; i += 512) { const int rr = i >> 3, c8 = (i & 7) * 8; *(u32x4*)(nat + (size_t)rr * 128 + c8) = *(const LAS u32x4*)(outn + rr * 64 + c8); }
    }
    if (c == 15 && tid < 192) { const int rr = tid >> 6; P.out[O_PSSDC + (size_t)(b * 3 + rr) * XBC + colg + col] = bf2f(raw[(128 + rr) * 64 + col]); }
    __syncthreads();
}
__device__ __forceinline__ void p2_sample_item(const Params& P, LAS unsigned char* lds, int item) {
    const int tid = threadIdx.x, lane = tid & 63, wid = tid >> 6;
    const int bs = item >> 1, g = item & 1, row = TPR + bs;
    LAS float* sx = (LAS float*)lds;
    LAS float* ssqs = sx + 768;
    const bf16_t* xbc = (const bf16_t*)(P.ws + WS_XBC) + (size_t)row * XBC;
    bf16_t* mix = (bf16_t*)(P.ws + WS_MIX) + (size_t)row * 2048;
    for (int i = tid; i < 768; i += 512) {
        const int j = i < 512 ? g * 512 + i : (i < 640 ? 1024 + g * 128 + (i - 512) : 1280 + g * 128 + (i - 640));
        const float* st = P.state_ssd_conv + (size_t)bs * 3 * XBC + j;
        const float s0 = st[0], s1 = st[XBC], s2 = st[2 * XBC], xr = bf2f(xbc[j]);
        const float v = s0 * P.ssd_conv_w[j] + s1 * P.ssd_conv_w[XBC + j] + s2 * P.ssd_conv_w[2 * XBC + j] + xr * P.ssd_conv_w[3 * XBC + j] + P.ssd_conv_b[j];
        sx[i] = silu_f(v);
        float* so = P.out + O_SSSDC + (size_t)bs * 3 * XBC + j; so[0] = s1; so[XBC] = s2; so[2 * XBC] = xr;
    }
    {
        const int j = g * 512 + tid; const bf16_t* ub = (const bf16_t*)(P.ws + WS_U) + (size_t)row * 1024;
        const float* st = P.state_sc + (size_t)bs * 2 * 1024 + j; const float s0 = st[0], s1 = st[1024], uc = bf2f(ub[j]);
        const float cv = s0 * P.sc_conv_w[j] + s1 * P.sc_conv_w[1024 + j] + uc * P.sc_conv_w[2048 + j];
        const float gb = bf2f(mix[1024 + j]); mix[1024 + j] = f2bf(gb * cv);
        float* so = P.out + O_SSC + (size_t)bs * 2 * 1024 + j; so[0] = s1; so[1024] = uc;
    }
    __syncthreads();
    const int h = g * 8 + wid;
    const float dt = ((const float*)(P.ws + WS_DTS))[bs * 16 + h], a = -__expf(P.a_log[h]), dA = __expf(dt * a);
    const float B0 = sx[512 + 2 * lane], B1 = sx[512 + 2 * lane + 1], C0 = sx[640 + 2 * lane], C1 = sx[640 + 2 * lane + 1];
    const float* hin = P.state_ssm + ((size_t)(bs * 16 + h) * 64) * 128 + 2 * lane;
    float* hout = P.out + O_SSSM + ((size_t)(bs * 16 + h) * 64) * 128 + 2 * lane;
    float ymine = 0.f;
#pragma unroll 8
    for (int p = 0; p < 64; ++p) { const float2 h0 = *(const float2*)(hin + p * 128); const float xd = dt * sx[wid * 64 + p];
        float2 hn; hn.x = dA * h0.x + xd * B0; hn.y = dA * h0.y + xd * B1; *(float2*)(hout + p * 128) = hn;
        float part = hn.x * C0 + hn.y * C1;
        part += __shfl_xor(part, 1); part += __shfl_xor(part, 2); part += __shfl_xor(part, 4); part += __shfl_xor(part, 8); part += __shfl_xor(part, 16); part += __shfl_xor(part, 32);
        if (lane == p) ymine = part; }
    const float xsv = sx[wid * 64 + lane];
    float y = ymine + P.ssd_d[h] * xsv;
    y *= silu_f(bf2f(mix[h * 64 + lane]));
    float sq = y * y;
    sq += __shfl_xor(sq, 1); sq += __shfl_xor(sq, 2); sq += __shfl_xor(sq, 4); sq += __shfl_xor(sq, 8); sq += __shfl_xor(sq, 16); sq += __shfl_xor(sq, 32);
    if (lane == 0) ssqs[wid] = sq;
    __syncthreads();
    float tot = 0.f;
#pragma unroll
    for (int i = 0; i < 8; ++i) tot += ssqs[i];
    const float rstd = rsqrtf(tot * (1.0f / 512.0f) + EPS);
    mix[h * 64 + lane] = f2bf(y * rstd * P.ssd_norm_w[h * 64 + lane]);
    __syncthreads();
}

__device__ __forceinline__ void p3_item(const Params& P, LAS unsigned char* lds, int item) {
    const int tid = threadIdx.x, lane = tid & 63, wid = tid >> 6, r16 = lane & 15, q = lane >> 4;
    const int b = item >> 5, c = (item >> 1) & 15, g = item & 1, h = g * 8 + wid, t0 = c * 128;
    LAS float* wsc = (LAS float*)lds + wid * 128;
    const float* dtp = (const float*)(P.ws + WS_DT) + (size_t)(b * 16 + h) * 2048 + t0;
    const float* acp = (const float*)(P.ws + WS_ACUM) + (size_t)(b * 16 + h) * 2048 + t0;
    const float alast = acp[127];
    wsc[lane] = dtp[lane] * __expf(alast - acp[lane]); wsc[lane + 64] = dtp[lane + 64] * __expf(alast - acp[lane + 64]);
    __syncthreads();
    const bf16_t* BTp = (const bf16_t*)((const unsigned char*)P.out + OS_BT) + ((size_t)(b * 2 + g) * 128) * 2048 + t0;
    const bf16_t* xsT = (const bf16_t*)(P.ws + WS_A1) + ((size_t)(b * 16 + h) * 64) * 2048 + t0;
    f32x4 acc[8][4];
#pragma unroll
    for (int i = 0; i < 8; ++i)
#pragma unroll
        for (int j = 0; j < 4; ++j) acc[i][j] = (f32x4){0.f, 0.f, 0.f, 0.f};
#pragma unroll 1
    for (int kk = 0; kk < 4; ++kk) { const int s0 = 32 * kk + 8 * q;
        float sc[8]; { const f32x4 a = *(const LAS f32x4*)(wsc + s0), b2 = *(const LAS f32x4*)(wsc + s0 + 4); sc[0] = a[0]; sc[1] = a[1]; sc[2] = a[2]; sc[3] = a[3]; sc[4] = b2[0]; sc[5] = b2[1]; sc[6] = b2[2]; sc[7] = b2[3]; }
        bf16x8 bfr[4];
#pragma unroll
        for (int pt = 0; pt < 4; ++pt) { const u32x4 rawv = *(const u32x4*)(xsT + (size_t)(pt * 16 + r16) * 2048 + s0); float f[8]; unpack8(rawv, f);
#pragma unroll
            for (int j = 0; j < 8; ++j) f[j] *= sc[j];
            bfr[pt] = __builtin_bit_cast(bf16x8, pack8(f)); }
#pragma unroll
        for (int nt = 0; nt < 8; ++nt) { const bf16x8 afr = *(const bf16x8*)(BTp + (size_t)(nt * 16 + r16) * 2048 + s0);
#pragma unroll
            for (int pt = 0; pt < 4; ++pt) acc[nt][pt] = __builtin_amdgcn_mfma_f32_16x16x32_bf16(afr, bfr[pt], acc[nt][pt], 0, 0, 0); }
    }
    bf16_t* stp = (bf16_t*)((unsigned char*)P.out + OS_ST) + (((size_t)(b * 16 + c) * 16 + h) * 64) * 128;
#pragma unroll
    for (int nt = 0; nt < 8; ++nt)
#pragma unroll
        for (int pt = 0; pt < 4; ++pt) { u32x2 w; w.x = cvt_pk_bf16(acc[nt][pt][0], acc[nt][pt][1]); w.y = cvt_pk_bf16(acc[nt][pt][2], acc[nt][pt][3]);
            *(u32x2*)(stp + (size_t)(pt * 16 + r16) * 128 + nt * 16 + 4 * q) = w; }
    __syncthreads();
}

__device__ __forceinline__ void phase4(const Params& P) {
    const int tid = threadIdx.x, G = gridDim.x, bx = blockIdx.x;
    for (int idx = bx * 512 + tid; idx < 262144; idx += G * 512) {
        const int n4 = idx & 31, pp = (idx >> 5) & 63, h = (idx >> 11) & 15, b = idx >> 15;
        const float* acp = (const float*)(P.ws + WS_ACUM) + (size_t)(b * 16 + h) * 2048;
        f32x4 hs = (f32x4){0.f, 0.f, 0.f, 0.f};
#pragma unroll 4
        for (int c = 0; c < 16; ++c) { u32x2* ptr = (u32x2*)((bf16_t*)((unsigned char*)P.out + OS_ST) + ((((size_t)(b * 16 + c) * 16 + h) * 64 + pp) * 128 + n4 * 4));
            const u32x2 s = *ptr; u32x2 w; w.x = cvt_pk_bf16(hs[0], hs[1]); w.y = cvt_pk_bf16(hs[2], hs[3]); *ptr = w;
            const float dec = __expf(acp[c * 128 + 127]);
            hs[0] = dec * hs[0] + bf_lo(s.x); hs[1] = dec * hs[1] + bf_hi(s.x); hs[2] = dec * hs[2] + bf_lo(s.y); hs[3] = dec * hs[3] + bf_hi(s.y); }
        *(f32x4*)(P.out + O_PSSM + ((size_t)(b * 16 + h) * 64 + pp) * 128 + n4 * 4) = hs;
    }
    for (int it = bx; it < 256; it += G) {
        const int rowbase = it * 64, b = it >> 5, tl0 = (it & 31) * 64, cg8 = (tid & 127) * 8, r0 = (tid >> 7) * 16;
        const bf16_t* ub = (const bf16_t*)(P.ws + WS_U) + (size_t)(rowbase + r0) * 1024 + cg8;
        bf16_t* mix = (bf16_t*)(P.ws + WS_MIX) + (size_t)(rowbase + r0) * 2048 + 1024 + cg8;
        float w0[8], w1[8], w2[8], um2[8], um1[8];
        ld8f(P.sc_conv_w + cg8, w0); ld8f(P.sc_conv_w + 1024 + cg8, w1); ld8f(P.sc_conv_w + 2048 + cg8, w2);
        if (tl0 + r0 >= 2) { unpack8(*(const u32x4*)(ub - 2 * 1024), um2); unpack8(*(const u32x4*)(ub - 1024), um1); }
        else {
#pragma unroll
            for (int j = 0; j < 8; ++j) { um2[j] = 0.f; um1[j] = 0.f; } }
#pragma unroll 4
        for (int i = 0; i < 16; ++i) { float uc[8], gb[8]; unpack8(*(const u32x4*)(ub + (size_t)i * 1024), uc); unpack8(*(const u32x4*)(mix + (size_t)i * 2048), gb);
#pragma unroll
            for (int j = 0; j < 8; ++j) { gb[j] *= um2[j] * w0[j] + um1[j] * w1[j] + uc[j] * w2[j]; um2[j] = um1[j]; um1[j] = uc[j]; }
            *(u32x4*)(mix + (size_t)i * 2048) = pack8(gb); }
        if (tl0 + r0 + 16 == 2048) { st8f(P.out + O_PSC + (size_t)(b * 2) * 1024 + cg8, um2); st8f(P.out + O_PSC + (size_t)(b * 2 + 1) * 1024 + cg8, um1); }
    }
}

__device__ __forceinline__ void p5_item(const Params& P, int item) {
    const int tid = threadIdx.x, lane = tid & 63, w = __builtin_amdgcn_readfirstlane(tid >> 6), r16 = lane & 15, q = lane >> 4;
    const int b = item >> 5, c = (item >> 1) & 15, g = item & 1, t0 = c * 128, l0 = 16 * w;
    const bf16_t* Bn = (const bf16_t*)((const unsigned char*)P.out + OS_BN) + ((size_t)(b * 2 + g) * 2048 + t0) * 128;
    const bf16_t* Cn = (const bf16_t*)((const unsigned char*)P.out + OS_CN) + ((size_t)(b * 2 + g) * 2048 + t0) * 128;
    bf16x8 cfr[4];
#pragma unroll
    for (int kk = 0; kk < 4; ++kk) cfr[kk] = *(const bf16x8*)(Cn + (size_t)(l0 + r16) * 128 + 32 * kk + 8 * q);
    f32x4 GT[8];
#pragma unroll
    for (int j = 0; j < 8; ++j) { GT[j] = (f32x4){0.f, 0.f, 0.f, 0.f};
        if (j <= w) {
#pragma unroll
            for (int kk = 0; kk < 4; ++kk) { const bf16x8 afr = *(const bf16x8*)(Bn + (size_t)(16 * j + r16) * 128 + 32 * kk + 8 * q); GT[j] = __builtin_amdgcn_mfma_f32_16x16x32_bf16(afr, cfr[kk], GT[j], 0, 0, 0); } } }
    const int lidx = l0 + r16;
    bf16_t* mixrow = (bf16_t*)(P.ws + WS_MIX) + (size_t)(b * 2048 + t0 + lidx) * 2048;
    float ssq = 0.f;
#pragma unroll 1
    for (int r = 0; r < 8; ++r) {
        const int h = g * 8 + r;
        const float* acp = (const float*)(P.ws + WS_ACUM) + (size_t)(b * 16 + h) * 2048 + t0;
        const float* dtp = (const float*)(P.ws + WS_DT) + (size_t)(b * 16 + h) * 2048 + t0;
        const float acl = acp[lidx], Dh = P.ssd_d[h];
        const bf16_t* Hp = (const bf16_t*)((const unsigned char*)P.out + OS_ST) + (((size_t)(b * 16 + c) * 16 + h) * 64) * 128;
        const bf16_t* xsT = (const bf16_t*)(P.ws + WS_A1) + ((size_t)(b * 16 + h) * 64) * 2048 + t0;
        f32x4 acc[4];
#pragma unroll
        for (int pt = 0; pt < 4; ++pt) acc[pt] = (f32x4){0.f, 0.f, 0.f, 0.f};
#pragma unroll
        for (int kk = 0; kk < 4; ++kk)
#pragma unroll
            for (int pt = 0; pt < 4; ++pt) { const bf16x8 afr = *(const bf16x8*)(Hp + (size_t)(pt * 16 + r16) * 128 + 32 * kk + 8 * q); acc[pt] = __builtin_amdgcn_mfma_f32_16x16x32_bf16(afr, cfr[kk], acc[pt], 0, 0, 0); }
        { const float el = __expf(acl);
#pragma unroll
          for (int pt = 0; pt < 4; ++pt) acc[pt] *= el; }
#pragma unroll
        for (int kk = 0; kk < 4; ++kk) if (2 * kk <= w) {
            const f32x4 asa = *(const f32x4*)(acp + 32 * kk + 4 * q), dta = *(const f32x4*)(dtp + 32 * kk + 4 * q);
            const f32x4 asb = *(const f32x4*)(acp + 32 * kk + 16 + 4 * q), dtb = *(const f32x4*)(dtp + 32 * kk + 16 + 4 * q);
            float m[8];
#pragma unroll
            for (int j = 0; j < 4; ++j) { const int s = 32 * kk + 4 * q + j; float v = GT[2 * kk][j] * __expf(fminf(acl - asa[j], 0.f)) * dta[j]; v = s > lidx ? 0.f : v; v = s == lidx ? v + Dh : v; m[j] = v; }
#pragma unroll
            for (int j = 0; j < 4; ++j) { const int s = 32 * kk + 16 + 4 * q + j; float v = GT[2 * kk + 1][j] * __expf(fminf(acl - asb[j], 0.f)) * dtb[j]; v = s > lidx ? 0.f : v; v = s == lidx ? v + Dh : v; m[4 + j] = v; }
            const bf16x8 bfr = __builtin_bit_cast(bf16x8, pack8(m));
#pragma unroll
            for (int pt = 0; pt < 4; ++pt) { const bf16_t* xp = xsT + (size_t)(pt * 16 + r16) * 2048 + 32 * kk + 4 * q; const u32x2 lo = *(const u32x2*)xp, hi = *(const u32x2*)(xp + 16);
                u32x4 av; av.x = lo.x; av.y = lo.y; av.z = hi.x; av.w = hi.y;
                acc[pt] = __builtin_amdgcn_mfma_f32_16x16x32_bf16(__builtin_bit_cast(bf16x8, av), bfr, acc[pt], 0, 0, 0); }
        }
#pragma unroll
        for (int pt = 0; pt < 4; ++pt) { u32x2* zp = (u32x2*)(mixrow + h * 64 + pt * 16 + 4 * q); const u32x2 zz = *zp;
            const float y0 = acc[pt][0] * silu_f(bf_lo(zz.x)), y1 = acc[pt][1] * silu_f(bf_hi(zz.x)), y2 = acc[pt][2] * silu_f(bf_lo(zz.y)), y3 = acc[pt][3] * silu_f(bf_hi(zz.y));
            ssq += y0 * y0 + y1 * y1 + y2 * y2 + y3 * y3;
            u32x2 o; o.x = cvt_pk_bf16(y0, y1); o.y = cvt_pk_bf16(y2, y3); *zp = o; }
    }
    ssq += __shfl_xor(ssq, 16); ssq += __shfl_xor(ssq, 32);
    const float rstd = rsqrtf(ssq * (1.0f / 512.0f) + EPS);
    asm volatile("s_waitcnt vmcnt(0)" ::: "memory");
#pragma unroll 2
    for (int r = 0; r < 8; ++r)
#pragma unroll
        for (int pt = 0; pt < 4; ++pt) { const int cc = (g * 8 + r) * 64 + pt * 16 + 4 * q; u32x2* yp = (u32x2*)(mixrow + cc); const u32x2 yy = *yp; const f32x4 nw = *(const f32x4*)(P.ssd_norm_w + cc);
            u32x2 o; o.x = cvt_pk_bf16(bf_lo(yy.x) * rstd * nw[0], bf_hi(yy.x) * rstd * nw[1]); o.y = cvt_pk_bf16(bf_lo(yy.y) * rstd * nw[2], bf_hi(yy.y) * rstd * nw[3]); *yp = o; }
}

__device__ __forceinline__ void rmsnorm_rows(const float* src, const float* w, bf16_t* dstb, float* dstf) {
    const int tid = threadIdx.x, lane = tid & 63, wid = tid >> 6;
    for (int row = blockIdx.x * 8 + wid; row < TT; row += gridDim.x * 8) {
        const float* s = src + (size_t)row * 1024 + lane * 4;
        f32x4 v[4]; float ss = 0.f;
#pragma unroll
        for (int i = 0; i < 4; ++i) { v[i] = *(const f32x4*)(s + i * 256); ss += v[i][0] * v[i][0] + v[i][1] * v[i][1] + v[i][2] * v[i][2] + v[i][3] * v[i][3]; }
        ss += __shfl_xor(ss, 1); ss += __shfl_xor(ss, 2); ss += __shfl_xor(ss, 4); ss += __shfl_xor(ss, 8); ss += __shfl_xor(ss, 16); ss += __shfl_xor(ss, 32);
        const float rstd = rsqrtf(ss * (1.0f / 1024.0f) + EPS);
#pragma unroll
        for (int i = 0; i < 4; ++i) { const f32x4 wv = *(const f32x4*)(w + lane * 4 + i * 256); const f32x4 o = v[i] * rstd * wv;
            if (dstb) { u32x2 pk; pk.x = cvt_pk_bf16(o[0], o[1]); pk.y = cvt_pk_bf16(o[2], o[3]); *(u32x2*)(dstb + (size_t)row * 1024 + lane * 4 + i * 256) = pk; }
            else *(f32x4*)(dstf + (size_t)row * 1024 + lane * 4 + i * 256) = o; }
    }
}

__device__ __forceinline__ void phase9(const Params& P) {
    const int tid = threadIdx.x, G = gridDim.x, bx = blockIdx.x;
    const bf16_t* gate = (const bf16_t*)(P.ws + WS_GATE); bf16_t* up = (bf16_t*)(P.ws + WS_UP);
    const int NU = (TPR / 16) * 352;
    for (int uidx = bx * 512 + tid; uidx < NU; uidx += G * 512) {
        const int rb = uidx / 352, cg8 = (uidx % 352) * 8, row0 = rb * 16, b = row0 >> 11, tl0 = row0 & 2047;
        float w0[8], w1[8], w2[8], bb[8], gm2[8], gm1[8];
        ld8f(P.ffn_conv_w + cg8, w0); ld8f(P.ffn_conv_w + DFF + cg8, w1); ld8f(P.ffn_conv_w + 2 * DFF + cg8, w2); ld8f(P.ffn_conv_b + cg8, bb);
        const bf16_t* gp = gate + (size_t)row0 * DFF + cg8; bf16_t* upp = up + (size_t)row0 * DFF + cg8;
        if (tl0 >= 2) { unpack8(*(const u32x4*)(gp - 2 * DFF), gm2); unpack8(*(const u32x4*)(gp - DFF), gm1); }
        else {
#pragma unroll
            for (int j = 0; j < 8; ++j) { gm2[j] = 0.f; gm1[j] = 0.f; } }
#pragma unroll 4
        for (int i = 0; i < 16; ++i) { float gc[8], uv[8]; unpack8(*(const u32x4*)(gp + (size_t)i * DFF), gc); unpack8(*(const u32x4*)(upp + (size_t)i * DFF), uv);
#pragma unroll
            for (int j = 0; j < 8; ++j) { uv[j] *= silu_f(gm2[j] * w0[j] + gm1[j] * w1[j] + gc[j] * w2[j] + bb[j]); gm2[j] = gm1[j]; gm1[j] = gc[j]; }
            *(u32x4*)(upp + (size_t)i * DFF) = pack8(uv); }
        if (tl0 + 16 == 2048) { st8f(P.out + O_PFFN + (size_t)(b * 2) * DFF + cg8, gm2); st8f(P.out + O_PFFN + (size_t)(b * 2 + 1) * DFF + cg8, gm1); }
    }
    for (int uidx = bx * 512 + tid; uidx < TSM * 352; uidx += G * 512) {
        const int bs = uidx / 352, cg8 = (uidx % 352) * 8, row = TPR + bs;
        float w0[8], w1[8], w2[8], bb[8], s0[8], s1[8], gc[8], uv[8];
        ld8f(P.ffn_conv_w + cg8, w0); ld8f(P.ffn_conv_w + DFF + cg8, w1); ld8f(P.ffn_conv_w + 2 * DFF + cg8, w2); ld8f(P.ffn_conv_b + cg8, bb);
        ld8f(P.state_ffn + (size_t)(bs * 2) * DFF + cg8, s0); ld8f(P.state_ffn + (size_t)(bs * 2 + 1) * DFF + cg8, s1);
        unpack8(*(const u32x4*)(gate + (size_t)row * DFF + cg8), gc); unpack8(*(const u32x4*)(up + (size_t)row * DFF + cg8), uv);
#pragma unroll
        for (int j = 0; j < 8; ++j) uv[j] *= silu_f(s0[j] * w0[j] + s1[j] * w1[j] + gc[j] * w2[j] + bb[j]);
        *(u32x4*)(up + (size_t)row * DFF + cg8) = pack8(uv);
        st8f(P.out + O_SFFN + (size_t)(bs * 2) * DFF + cg8, s1); st8f(P.out + O_SFFN + (size_t)(bs * 2 + 1) * DFF + cg8, gc);
    }
}

constexpr int NPHASE = 12;
__global__ void __launch_bounds__(512, 2) fwd_megakernel(Params P) {
    extern __shared__ __attribute__((aligned(16))) unsigned char lds_raw[];
    LAS unsigned char* lds = (LAS unsigned char*)lds_raw;
    volatile LAS unsigned* stw = (volatile LAS unsigned*)(lds + 131072);
    if (threadIdx.x < 4) stw[threadIdx.x] = 0u;
    __syncthreads();
    const XcdBarrier bar = xcd_barrier_post((unsigned*)(P.ws + WS_BAR), stw);
    const int lo = P.ph_lo, hi = P.ph_hi, G = gridDim.x, bx = blockIdx.x;
#define IN(k) (lo <= (k) && (k) < hi)
#define SEAM(k) do { if (IN(k) && IN((k) + 1)) xcd_barrier(bar); } while (0)
    if (IN(0)) phase0(P, lds);
    SEAM(0);
    if (IN(1)) { pg8::Gemm g{(const bf16_t*)(P.ws + WS_A1), (const bf16_t*)(P.ws + WS_WIN), TPAD, NIN, 1024}; pg8::StaticOrder S; S.init(TPAD, NIN, G, bx);
        EpiIn E{(bf16_t*)(P.ws + WS_MIX), (bf16_t*)(P.ws + WS_XBC), (bf16_t*)(P.ws + WS_U)}; pg8::gemm_phase<EpiIn>(lds, g, S, E); }
    SEAM(1);
    if (IN(2)) { for (int it = bx; it < 3072; it += G) p2_conv_item(P, lds, it);
        for (int it = bx; it < 256; it += G) p2_sample_item(P, lds, it); }
    SEAM(2);
    if (IN(3)) { for (int it = bx; it < 256; it += G) p3_item(P, lds, it); }
    SEAM(3);
    if (IN(4)) phase4(P);
    SEAM(4);
    if (IN(5)) { for (int it = bx; it < 256; it += G) p5_item(P, it); }
    SEAM(5);
    if (IN(6)) { pg8::Gemm g{(const bf16_t*)(P.ws + WS_MIX), (const bf16_t*)(P.ws + WS_WOUT), TPAD, 1024, 2048}; pg8::StaticOrder S; S.init(TPAD, 1024, G, bx);
        EpiRes E{P.x_prompt, P.x_sample, P.out, 1}; pg8::gemm_phase<EpiRes>(lds, g, S, E); }
    SEAM(6);
    if (IN(7)) rmsnorm_rows(P.out, P.norm_ffn_w, (bf16_t*)(P.ws + WS_A1), nullptr);
    SEAM(7);
    if (IN(8)) { pg8::Gemm g{(const bf16_t*)(P.ws + WS_A1), (const bf16_t*)(P.ws + WS_WFFN), TPAD, NIN, 1024}; pg8::StaticOrder S; S.init(TPAD, NIN, G, bx);
        EpiFfn E{(bf16_t*)(P.ws + WS_GATE), (bf16_t*)(P.ws + WS_UP)}; pg8::gemm_phase<EpiFfn>(lds, g, S, E); }
    SEAM(8);
    if (IN(9)) phase9(P);
    SEAM(9);
    if (IN(10)) { pg8::Gemm g{(const bf16_t*)(P.ws + WS_UP), (const bf16_t*)(P.ws + WS_WDOWN), TPAD, 1024, DFF}; pg8::StaticOrder S; S.init(TPAD, 1024, G, bx);
        EpiRes E{P.x_prompt, P.x_sample, P.out, 0}; pg8::gemm_phase<EpiRes>(lds, g, S, E); }
    SEAM(10);
    if (IN(11)) rmsnorm_rows(P.out, P.norm_final_w, nullptr, P.out);
#undef IN
#undef SEAM
}

#ifndef N_LAUNCHES
#define N_LAUNCHES 1
#endif
extern "C" void kernel_launch(void* const* d_in, const int* in_sizes, int n_in, void* d_out, int out_size, void* d_ws, size_t ws_size, hipStream_t stream) {
    static int grid_blocks = 0;
    if (!grid_blocks) {
        int dev = 0, cus = 0, per_cu = 0;
        (void)hipGetDevice(&dev);
        (void)hipDeviceGetAttribute(&cus, hipDeviceAttributeMultiprocessorCount, dev);
        (void)hipFuncSetAttribute((const void*)fwd_megakernel, hipFuncAttributeMaxDynamicSharedMemorySize, LDS_BYTES);
        (void)hipOccupancyMaxActiveBlocksPerMultiprocessor(&per_cu, (const void*)fwd_megakernel, 512, LDS_BYTES);
        if (per_cu < 1) { fprintf(stderr, "occupancy query says %d blocks per CU\n", per_cu); per_cu = 1; }
        if (per_cu > 1) per_cu = 1;
        grid_blocks = cus * per_cu;
        if (ws_size < WS_END) fprintf(stderr, "workspace too small: %zu < %zu\n", ws_size, (size_t)WS_END);
    }
    if (N_LAUNCHES == 1) (void)hipMemsetAsync((unsigned char*)d_ws + WS_BAR, 0, XCD_BAR_WORDS * 4, stream);
    Params p{};
    const float** pp = (const float**)&p;
    for (int i = 0; i < 22; ++i) pp[i] = (const float*)d_in[i];
    p.out = (float*)d_out; p.ws = (unsigned char*)d_ws;
    for (int li = 0; li < N_LAUNCHES; ++li) {
        p.ph_lo = (N_LAUNCHES == 1) ? 0 : li; p.ph_hi = (N_LAUNCHES == 1) ? NPHASE : li + 1;
        void* args[] = {&p};
        hipError_t e = hipLaunchCooperativeKernel((const void*)fwd_megakernel, dim3(grid_blocks), dim3(512), args, LDS_BYTES, stream);
        if (e != hipSuccess) fprintf(stderr, "cooperative launch failed: %s (grid %d)\n", hipGetErrorString(e), grid_blocks);
    }
}
```

```cpp
#include <hip/hip_runtime.h>
#include <cstdio>

#define PROBE_MASK 0
#define LAS __attribute__((address_space(3)))
typedef unsigned short bf16_t;
typedef short bf16x8 __attribute__((ext_vector_type(8)));
typedef float f32x4 __attribute__((ext_vector_type(4)));
typedef unsigned u32x4 __attribute__((ext_vector_type(4)));
typedef unsigned u32x2 __attribute__((ext_vector_type(2)));

constexpr int TPR = 16384, TSM = 128, TT = 16512, TPAD = 16640;
constexpr int NIN = 5632, DINP = 5648, XBC = 1536, DFF = 2816;
constexpr float EPS = 1e-5f;
constexpr int LDS_BYTES = 131072 + 16 + 4096;
constexpr int LDS_XCH = 131072 + 16;

constexpr size_t WS_WIN = 0;
constexpr size_t WS_WOUT = WS_WIN + (size_t)NIN * 1024 * 2;
constexpr size_t WS_WFFN = WS_WOUT + (size_t)1024 * 2048 * 2;
constexpr size_t WS_WDOWN = WS_WFFN + (size_t)NIN * 1024 * 2;
constexpr size_t WS_A1 = WS_WDOWN + (size_t)1024 * 2816 * 2;
constexpr size_t WS_DT = WS_A1 + (size_t)TPAD * 1024 * 2;
constexpr size_t WS_ACUM = WS_DT + (size_t)8 * 16 * 2048 * 4;
constexpr size_t WS_DTS = WS_ACUM + (size_t)8 * 16 * 2048 * 4;
constexpr size_t WS_RSTD = WS_DTS + (size_t)128 * 16 * 4;
constexpr size_t WS_BIG = WS_RSTD + (size_t)TPAD * 4;
constexpr size_t WS_XBC = WS_BIG;
constexpr size_t WS_MIX = WS_XBC + (size_t)TPAD * 1536 * 2;
constexpr size_t WS_UP = WS_BIG;
constexpr size_t WS_BAR = WS_MIX + (size_t)TPAD * 2048 * 2;
constexpr size_t WS_SLAB = WS_BAR + 16384;
constexpr size_t WS_SBGF = WS_SLAB + (size_t)11 * 128 * 1024 * 4;
constexpr size_t WS_SBGL = WS_SBGF + (size_t)65 * 2 * 2816 * 4;
constexpr size_t WS_SBUF = WS_SBGL + (size_t)65 * 2 * 2816 * 4;
constexpr size_t WS_SCUF = WS_SBUF + (size_t)65 * 2 * 2816 * 4;
constexpr size_t WS_SCUL = WS_SCUF + (size_t)65 * 2 * 1024 * 4;
constexpr size_t WS_SCGF = WS_SCUL + (size_t)65 * 2 * 1024 * 4;
constexpr size_t WS_X1B = WS_SCGF + (size_t)65 * 2 * 1024 * 4;
constexpr size_t WS_GRS = WS_X1B + (size_t)TPAD * 1024 * 2;
constexpr size_t WS_END = WS_GRS + (size_t)TPR * 2 * 4;
constexpr size_t OS_BN = 0;
constexpr size_t OS_BT = OS_BN + (size_t)8 * 2 * 2048 * 128 * 2;
constexpr size_t OS_CN = OS_BT + (size_t)8 * 2 * 2048 * 128 * 2;
constexpr size_t OS_ST = OS_CN + (size_t)8 * 2 * 2048 * 128 * 2;
constexpr size_t O_YS = 16777216, O_PSSM = 16908288, O_PSSDC = 17956864, O_PSC = 17993728, O_PFFN = 18010112;
constexpr size_t O_SSSM = 18055168, O_SSSDC = 34832384, O_SSC = 35422208, O_SFFN = 35684352;

typedef float f32x2_t __attribute__((ext_vector_type(2)));
typedef __bf16 bf16x2_t __attribute__((ext_vector_type(2)));
__device__ __forceinline__ unsigned cvt_pk_bf16(float lo, float hi) { const f32x2_t v = {lo, hi}; return __builtin_bit_cast(unsigned, __builtin_convertvector(v, bf16x2_t)); }
__device__ __forceinline__ float bf_lo(unsigned u) { return __uint_as_float(u << 16); }
__device__ __forceinline__ float bf_hi(unsigned u) { return __uint_as_float(u & 0xffff0000u); }
__device__ __forceinline__ bf16_t f2bf(float f) { return (bf16_t)(cvt_pk_bf16(f, 0.f) & 0xffffu); }
__device__ __forceinline__ float bf2f(bf16_t b) { return __uint_as_float(((unsigned)b) << 16); }
__device__ __forceinline__ float silu_f(float v) { return v * __builtin_amdgcn_rcpf(1.0f + __expf(-v)); }
__device__ __forceinline__ float softplus_f(float v) { return v > 20.f ? v : log1pf(__expf(v)); }
__device__ __forceinline__ void unpack8(const u32x4 u, float (&f)[8]) { f[0] = bf_lo(u.x); f[1] = bf_hi(u.x); f[2] = bf_lo(u.y); f[3] = bf_hi(u.y); f[4] = bf_lo(u.z); f[5] = bf_hi(u.z); f[6] = bf_lo(u.w); f[7] = bf_hi(u.w); }
__device__ __forceinline__ u32x4 pack8(const float (&f)[8]) { u32x4 u; u.x = cvt_pk_bf16(f[0], f[1]); u.y = cvt_pk_bf16(f[2], f[3]); u.z = cvt_pk_bf16(f[4], f[5]); u.w = cvt_pk_bf16(f[6], f[7]); return u; }
__device__ __forceinline__ void ld8f(const float* p, float (&f)[8]) { const f32x4 a = *(const f32x4*)p, b = *(const f32x4*)(p + 4); f[0] = a[0]; f[1] = a[1]; f[2] = a[2]; f[3] = a[3]; f[4] = b[0]; f[5] = b[1]; f[6] = b[2]; f[7] = b[3]; }
__device__ __forceinline__ void st8f(float* p, const float (&f)[8]) { *(f32x4*)p = (f32x4){f[0], f[1], f[2], f[3]}; *(f32x4*)(p + 4) = (f32x4){f[4], f[5], f[6], f[7]}; }


#define XB_TMO      128
#define XB_XCNT(j)  (256  + 64 * (j))
#define XB_XSUB(j)  (1280 + 64 * (j))
#define XB_XGEN(j)  (2304 + 64 * (j))
#define XB_TOP      3328
#define XB_TOPGEN   3392
#define XCD_BAR_WORDS 3456
#define XB_SPIN_CAP (1u << 18)
__device__ __forceinline__ unsigned xb_ld(unsigned* p)              { return __hip_atomic_load(p, __ATOMIC_RELAXED, __HIP_MEMORY_SCOPE_AGENT); }
__device__ __forceinline__ unsigned xb_add(unsigned* p, unsigned v) { return __hip_atomic_fetch_add(p, v, __ATOMIC_RELAXED, __HIP_MEMORY_SCOPE_AGENT); }
__device__ __forceinline__ unsigned xb_xcc_id() { return (unsigned)__builtin_amdgcn_s_getreg((3 << 11) | 20) & 0xFu; }
#define XB_SPIN(cond, bar) do { unsigned _sp = 0; while (cond) { __builtin_amdgcn_s_sleep(1); \
    if ((++_sp & 255u) == 0u) { if (xb_ld(&(bar)[XB_TMO])) break; if (_sp > XB_SPIN_CAP) { atomicAdd(&(bar)[XB_TMO], 1u); break; } } } } while (0)
struct XcdBarrier { unsigned* bar; unsigned x; volatile LAS unsigned* st; };
__device__ __forceinline__ XcdBarrier xcd_barrier_post(unsigned* bar, volatile LAS unsigned* st) {
    XcdBarrier b; b.bar = bar; b.x = xb_xcc_id(); b.st = st;
    if (threadIdx.x == 0) (void)xb_add(&bar[XB_XCNT(b.x)], 1u);
    return b;
}
__device__ __forceinline__ void xcd_barrier_complete(unsigned* bar, unsigned x, unsigned& nloc, unsigned& nx) {
    const unsigned G = gridDim.x * gridDim.y * gridDim.z;
    unsigned sum, cnt, mine, sp = 0u;
    for (;;) {
        sum = 0u; cnt = 0u; mine = 0u;
#pragma unroll
        for (unsigned j = 0; j < 16; ++j) { const unsigned c = xb_ld(&bar[XB_XCNT(j)]); sum += c; cnt += (c > 0u) ? 1u : 0u; mine = (j == x) ? c : mine; }
        if (sum == G) break;
        __builtin_amdgcn_s_sleep(1);
        if ((++sp & 255u) == 0u) { if (xb_ld(&bar[XB_TMO])) break; if (sp > XB_SPIN_CAP) { atomicAdd(&bar[XB_TMO], 1u); break; } }
    }
    nloc = mine > 0u ? mine : 1u; nx = cnt > 0u ? cnt : 1u;
}
__device__ __forceinline__ void xcd_barrier(const XcdBarrier& b) {
    asm volatile("s_waitcnt vmcnt(0)" ::: "memory");
    __syncthreads();
    if (threadIdx.x == 0) {
        unsigned* bar = b.bar;
        __builtin_amdgcn_s_waitcnt(0);
        unsigned nloc = b.st[0], nx = b.st[1];
        if (nloc == 0u) { xcd_barrier_complete(bar, b.x, nloc, nx); b.st[0] = nloc; b.st[1] = nx; }
        const unsigned old = xb_add(&bar[XB_XSUB(b.x)], 1u);
        const unsigned gen = old / nloc;
        if (old + 1u == (gen + 1u) * nloc) {
            __builtin_amdgcn_fence(__ATOMIC_RELEASE, "agent");
            asm volatile("s_waitcnt vmcnt(0)" ::: "memory");
            const unsigned og = xb_add(&bar[XB_TOP], 1u);
            const unsigned tg = og / nx;
            if (og + 1u == (tg + 1u) * nx) xb_add(&bar[XB_TOPGEN], 1u);
            else XB_SPIN(xb_ld(&bar[XB_TOPGEN]) == tg, bar);
            __builtin_amdgcn_fence(__ATOMIC_ACQUIRE, "agent");
            xb_add(&bar[XB_XGEN(b.x)], 1u);
            asm volatile("s_waitcnt vmcnt(0)" ::: "memory");
        } else {
            XB_SPIN(xb_ld(&bar[XB_XGEN(b.x)]) == gen, bar);
            __builtin_amdgcn_fence(__ATOMIC_ACQUIRE, "agent");
            asm volatile("s_waitcnt vmcnt(0)" ::: "memory");
        }
    }
    __syncthreads();
}

namespace pg8 {
constexpr int BM = 256, BK = 64, HALF = 128, HTB = HALF * BK * 2, NXCD = 8, WGM = 8;
__device__ __forceinline__ int lds_byte(int r, int c) { const int st = (r >> 4) * 2 + (c >> 5), rr = r & 15, cc = c & 31, ob = rr * 64 + cc * 2; return st * 1024 + (ob ^ (((ob >> 9) & 1) << 5)); }
__device__ __forceinline__ void stage_rc(int b, int& R, int& C) { const int st = b / 1024, sb = b % 1024, swz = sb ^ (((sb >> 9) & 1) << 5); R = (st >> 1) * 16 + swz / 64; C = (st & 1) * 32 + (swz % 64) / 2; }
__device__ __forceinline__ int perm32(int rho) { const int n = rho >> 4, i = rho & 15; return 8 * (i >> 2) + 4 * n + (i & 3); }
struct Unit { int pm, pn, ko; };
struct Gemm { const bf16_t* A; const bf16_t* Bt; int M, N, K, lda, ldb; };
struct StaticOrder {
    int nM, nN, nwg, G, c;
    __device__ void init(int M, int N, int G_, int c_) { nM = M / BM; nN = N / BM; nwg = nM * nN; G = G_; c = c_; }
    __device__ bool next(int i, Unit& u) const {
        const long L = (long)i * G + c; if (L >= nwg) return false;
        int wgid = (int)L; { const int q = nwg / NXCD, r = nwg % NXCD, xcd = wgid % NXCD, off = wgid / NXCD; wgid = (xcd < r ? xcd * (q + 1) : r * (q + 1) + (xcd - r) * q) + off; }
        const int nig = WGM * nN, gid = wgid / nig, fm = gid * WGM, gsz = (nM - fm) < WGM ? (nM - fm) : WGM;
        u.pm = fm + ((wgid % nig) % gsz); u.pn = (wgid % nig) / gsz; u.ko = 0; return true;
    }
};
struct SplitOrder {
    int nu, c, K;
    __device__ bool next(int i, Unit& u) const { if (i != 0 || c >= nu) return false; u.pm = 0; u.pn = c & 3; u.ko = (c >> 2) * K; return true; }
};
template <class Epi, class Sched, bool SCALE = false>
__device__ __forceinline__ void gemm_phase(LAS unsigned char* lds, const Gemm g, const Sched& S, const Epi& E, const LAS float* sctab = nullptr) {
    const int tid = threadIdx.x, wid = __builtin_amdgcn_readfirstlane(tid >> 6), lane = tid & 63, wr = wid >> 2, wc = wid & 3, fr = lane & 15, fq = lane >> 4;
    const int K = g.K, nt = K / BK;
    unsigned voffA[2], voffB[2];
#pragma unroll
    for (int i = 0; i < 2; ++i) { int R, C; stage_rc(tid * 16 + i * 8192, R, C); const int Rb = Epi::PERM ? ((R & ~31) + perm32(R & 31)) : R;
        voffA[i] = (unsigned)(R * g.lda + C) * 2u; voffB[i] = (unsigned)(Rb * g.ldb + C) * 2u; }
    const size_t kstep = (size_t)(BK * 2);
    const size_t hstepA = (size_t)HALF * g.lda * 2, hstepB = (size_t)HALF * g.ldb * 2;
    const size_t tstepA = 2 * hstepA, tstepB = 2 * hstepB;
    const unsigned ldsw = (unsigned)wid * 1024u;
    const int aoff = lds_byte(wr * 64 + fr, fq * 8), boff = lds_byte(wc * 32 + fr, fq * 8);
#define PG8_SA(b, h) (((b) * 2 + (h)) * HTB)
#define PG8_SB(b, h) ((4 + (b) * 2 + (h)) * HTB)
#define PG8_STAGE(bufoff, gbase, voff) do { _Pragma("unroll") for (int _i = 0; _i < 2; ++_i) \
        __builtin_amdgcn_global_load_lds((const unsigned*)((const char*)(gbase) + (voff)[_i]), (LAS unsigned*)(lds + (bufoff) + ldsw + _i * 8192), 16, 0, 0); } while (0)
#define PG8_LDA(dst, b, h) do { _Pragma("unroll") for (int m = 0; m < 4; ++m) _Pragma("unroll") for (int k = 0; k < 2; ++k) dst[m][k] = *(const LAS bf16x8*)(lds + PG8_SA(b, h) + aoff + m * 2048 + k * 1024); } while (0)
#define PG8_LDB(dst, b, h) do { _Pragma("unroll") for (int n = 0; n < 2; ++n) _Pragma("unroll") for (int k = 0; k < 2; ++k) dst[n][k] = *(const LAS bf16x8*)(lds + PG8_SB(b, h) + boff + n * 2048 + k * 1024); } while (0)
#define PG8_MMA(ai, bj, At, Bt) do { __builtin_amdgcn_s_setprio(1); _Pragma("unroll") for (int m = 0; m < 4; ++m) _Pragma("unroll") for (int n = 0; n < 2; ++n) _Pragma("unroll") for (int k = 0; k < 2; ++k) \
        acc[ai][bj][m][n] = __builtin_amdgcn_mfma_f32_16x16x32_bf16(Bt[n][k], At[m][k], acc[ai][bj][m][n], 0, 0, 0); __builtin_amdgcn_s_setprio(0); } while (0)
#define PG8_WAIT_V(n) asm volatile("s_waitcnt vmcnt(" #n ")" ::: "memory")
#define PG8_WAIT_L(n) asm volatile("s_waitcnt lgkmcnt(" #n ")" ::: "memory")
#define PG8_BAR __builtin_amdgcn_s_barrier()
#define PG8_SCHED __builtin_amdgcn_sched_barrier(0)
    Unit cur, nxt; int ui = 0;
    if (!S.next(0, cur)) return;
    f32x4 acc[2][2][4][2];
#pragma unroll
    for (int a = 0; a < 2; ++a)
#pragma unroll
        for (int b = 0; b < 2; ++b)
#pragma unroll
            for (int m = 0; m < 4; ++m)
#pragma unroll
                for (int n = 0; n < 2; ++n) acc[a][b][m][n] = (f32x4){0.f, 0.f, 0.f, 0.f};
    bf16x8 At[4][2], B0[2][2], B1[2][2];
    const char* cA = (const char*)g.A + (size_t)cur.pm * tstepA + (size_t)cur.ko * 2; const char* cB = (const char*)g.Bt + (size_t)cur.pn * tstepB + (size_t)cur.ko * 2;
    PG8_STAGE(PG8_SB(0, 0), cB, voffB); PG8_STAGE(PG8_SA(0, 0), cA, voffA); PG8_STAGE(PG8_SB(0, 1), cB + hstepB, voffB); PG8_STAGE(PG8_SA(0, 1), cA + hstepA, voffA);
    if (wr == 1) PG8_BAR;
    PG8_WAIT_V(4); PG8_BAR;
    PG8_STAGE(PG8_SB(1, 0), cB + kstep, voffB); PG8_STAGE(PG8_SA(1, 0), cA + kstep, voffA); PG8_STAGE(PG8_SB(1, 1), cB + hstepB + kstep, voffB);
    PG8_WAIT_V(6); PG8_BAR;
    for (;;) {
        const bool has_next = S.next(ui + 1, nxt);
        const char* nA = has_next ? (const char*)g.A + (size_t)nxt.pm * tstepA + (size_t)nxt.ko * 2 : cA; const char* nB = has_next ? (const char*)g.Bt + (size_t)nxt.pn * tstepB + (size_t)nxt.ko * 2 : cB;
        for (int t = 0; t < nt; t += 2) {
            const bool last = (t == nt - 2);
            const char* a1 = cA + (size_t)(t + 1) * kstep;
            const char* a2 = last ? nA : cA + (size_t)(t + 2) * kstep; const char* b2 = last ? nB : cB + (size_t)(t + 2) * kstep;
            const char* a3 = a2 + kstep; const char* b3 = b2 + kstep;
            if (SCALE && (t == 8 || t == 16)) {
                const LAS float* tb = sctab + (t == 8 ? 0 : 256) + wr * 64 + fr;
#pragma unroll
                for (int ai = 0; ai < 2; ++ai)
#pragma unroll
                    for (int m = 0; m < 4; ++m) { const float sv = tb[ai * 128 + m * 16];
#pragma unroll
                        for (int bj = 0; bj < 2; ++bj)
#pragma unroll
                            for (int n = 0; n < 2; ++n) acc[ai][bj][m][n] *= sv; }
                PG8_WAIT_L(0); PG8_SCHED;
            }
            PG8_LDB(B0, 0, 0); PG8_SCHED; PG8_LDA(At, 0, 0); PG8_STAGE(PG8_SA(1, 1), a1 + hstepA, voffA);
            PG8_WAIT_L(8); PG8_BAR; PG8_WAIT_L(0); PG8_MMA(0, 0, At, B0); PG8_BAR; PG8_SCHED;
            PG8_LDB(B1, 0, 1); PG8_STAGE(PG8_SB(0, 0), b2, voffB);
            PG8_BAR; PG8_WAIT_L(0); PG8_MMA(0, 1, At, B1); PG8_BAR;
            PG8_LDA(At, 0, 1); PG8_STAGE(PG8_SA(0, 0), a2, voffA);
            PG8_BAR; PG8_WAIT_L(0); PG8_MMA(1, 0, At, B0); PG8_BAR; PG8_SCHED;
            PG8_STAGE(PG8_SB(0, 1), b2 + hstepB, voffB);
            PG8_WAIT_V(6); PG8_BAR; PG8_MMA(1, 1, At, B1); PG8_BAR;
            PG8_LDB(B0, 1, 0); PG8_SCHED; PG8_LDA(At, 1, 0); PG8_STAGE(PG8_SA(0, 1), a2 + hstepA, voffA);
            PG8_WAIT_L(8); PG8_BAR; PG8_WAIT_L(0); PG8_MMA(0, 0, At, B0); PG8_BAR; PG8_SCHED;
            PG8_LDB(B1, 1, 1); PG8_STAGE(PG8_SB(1, 0), b3, voffB);
            PG8_BAR; PG8_WAIT_L(0); PG8_MMA(0, 1, At, B1); PG8_BAR;
            PG8_LDA(At, 1, 1); PG8_STAGE(PG8_SA(1, 0), a3, voffA);
            PG8_BAR; PG8_WAIT_L(0); PG8_MMA(1, 0, At, B0); PG8_BAR; PG8_SCHED;
            PG8_STAGE(PG8_SB(1, 1), b3 + hstepB, voffB);
            PG8_WAIT_V(6); PG8_BAR; PG8_MMA(1, 1, At, B1); PG8_BAR;
        }
        E(acc, cur, wr, wc, fr, fq);
        if (!has_next) break;
#pragma unroll
        for (int a = 0; a < 2; ++a)
#pragma unroll
            for (int b = 0; b < 2; ++b)
#pragma unroll
                for (int m = 0; m < 4; ++m)
#pragma unroll
                    for (int n = 0; n < 2; ++n) acc[a][b][m][n] = (f32x4){0.f, 0.f, 0.f, 0.f};
        cur = nxt; cA = nA; cB = nB; ++ui;
    }
    PG8_WAIT_V(0);
    if (wr == 0) PG8_BAR;
    PG8_BAR;
#undef PG8_SA
#undef PG8_SB
#undef PG8_STAGE
#undef PG8_LDA
#undef PG8_LDB
#undef PG8_MMA
#undef PG8_WAIT_V
#undef PG8_WAIT_L
#undef PG8_BAR
#undef PG8_SCHED
}
}

__device__ __forceinline__ float dpp_ror1(float v) { return __builtin_bit_cast(float, __builtin_amdgcn_update_dpp(0, __builtin_bit_cast(int, v), 0x121, 0xF, 0xF, true)); }
__device__ __forceinline__ float dpp_ror2(float v) { return __builtin_bit_cast(float, __builtin_amdgcn_update_dpp(0, __builtin_bit_cast(int, v), 0x122, 0xF, 0xF, true)); }
struct EpiIn {
    static constexpr bool PERM = true;
    bf16_t* mix; bf16_t* xbc; const float* rstd; float* uf; float* ul; float* gbf; const float* cw; const float* st; float* sout; LAS float* xch;
    __device__ __forceinline__ void operator()(const f32x4 (&acc)[2][2][4][2], const pg8::Unit& u, int wr, int wc, int fr_, int fq_) const {
        int fr = fr_, fq = fq_; asm volatile("" : "+v"(fr), "+v"(fq));
        const int row0 = u.pm * 256 + wr * 64 + fr;
        float rs[2][4];
#pragma unroll
        for (int ai = 0; ai < 2; ++ai)
#pragma unroll
            for (int m = 0; m < 4; ++m) rs[ai][m] = rstd[row0 + ai * 128 + m * 16];
        if (u.pn >= 16) {
            bf16_t* base = xbc + (u.pn - 16) * 256 + wc * 32 + 8 * fq;
#pragma unroll
            for (int ai = 0; ai < 2; ++ai)
#pragma unroll
                for (int m = 0; m < 4; ++m) { bf16_t* rp = base + (size_t)(row0 + ai * 128 + m * 16) * XBC;
#pragma unroll
                    for (int bj = 0; bj < 2; ++bj) { const f32x4 v0 = acc[ai][bj][m][0] * rs[ai][m], v1 = acc[ai][bj][m][1] * rs[ai][m];
                        u32x4 w; w.x = cvt_pk_bf16(v0[0], v0[1]); w.y = cvt_pk_bf16(v0[2], v0[3]); w.z = cvt_pk_bf16(v1[0], v1[1]); w.w = cvt_pk_bf16(v1[2], v1[3]);
                        *(u32x4*)(rp + bj * 128) = w; } }
            return;
        }
        const int cl = wc * 16 + 4 * fq, jj = u.pn * 64 + cl;
        const f32x4 w0 = *(const f32x4*)(cw + jj), w1 = *(const f32x4*)(cw + 1024 + jj), w2 = *(const f32x4*)(cw + 2048 + jj);
        if (u.pm == 64) {
#pragma unroll
            for (int m = 0; m < 4; ++m) { const int bs = wr * 64 + m * 16 + fr; const float r = rs[0][m];
                const f32x4 s0 = *(const f32x4*)(st + (size_t)(bs * 2) * 1024 + jj), s1 = *(const f32x4*)(st + (size_t)(bs * 2 + 1) * 1024 + jj);
                const f32x4 gb = acc[0][0][m][0] * r, uu = acc[0][0][m][1] * acc[0][1][m][0] * (r * r), zz = acc[0][1][m][1] * r;
                const f32x4 ys = gb * (s0 * w0 + s1 * w1 + uu * w2);
                *(f32x4*)(sout + (size_t)(bs * 2) * 1024 + jj) = s1; *(f32x4*)(sout + (size_t)(bs * 2 + 1) * 1024 + jj) = uu;
                bf16_t* rp = mix + (size_t)(TPR + bs) * 2048 + jj;
                u32x2 oz, oy; oz.x = cvt_pk_bf16(zz[0], zz[1]); oz.y = cvt_pk_bf16(zz[2], zz[3]); oy.x = cvt_pk_bf16(ys[0], ys[1]); oy.y = cvt_pk_bf16(ys[2], ys[3]);
                *(u32x2*)rp = oz; *(u32x2*)(rp + 1024) = oy; }
            return;
        }
        if (fr >= 14) {
#pragma unroll
            for (int ai = 0; ai < 2; ++ai) { const float r = rs[ai][3]; *(LAS f32x4*)(xch + ((2 * ai + wr) * 2 + (fr - 14)) * 64 + cl) = acc[ai][0][3][1] * acc[ai][1][3][0] * (r * r); }
            if (wr == 1) { const float r = rs[1][3]; *(f32x4*)(ul + (size_t)(u.pm * 2 + (fr - 14)) * 1024 + jj) = acc[1][0][3][1] * acc[1][1][3][0] * (r * r); }
        }
        if (fr < 2 && wr == 0) { const float r = rs[0][0];
            *(f32x4*)(uf + (size_t)(u.pm * 2 + fr) * 1024 + jj) = acc[0][0][0][1] * acc[0][1][0][0] * (r * r); *(f32x4*)(gbf + (size_t)(u.pm * 2 + fr) * 1024 + jj) = acc[0][0][0][0] * r; }
        asm volatile("s_waitcnt lgkmcnt(0)" ::: "memory"); __builtin_amdgcn_s_barrier(); __builtin_amdgcn_s_barrier(); asm volatile("" ::: "memory");
        const bool f1 = fr >= 1, f2 = fr >= 2;
        bf16_t* mrow = mix + (size_t)row0 * 2048 + jj;
#pragma unroll
        for (int ai = 0; ai < 2; ++ai) {
            const int k = 2 * ai + wr;
            f32x4 p1, p2;
            if (k > 0) { const f32x4 X0 = *(const LAS f32x4*)(xch + ((k - 1) * 2 + 0) * 64 + cl), X1 = *(const LAS f32x4*)(xch + ((k - 1) * 2 + 1) * 64 + cl);
                p1 = X1;
#pragma unroll
                for (int e = 0; e < 4; ++e) p2[e] = fr == 1 ? X1[e] : X0[e]; }
            else { p1 = (f32x4){0.f, 0.f, 0.f, 0.f}; p2 = p1; }
#pragma unroll
            for (int m = 0; m < 4; ++m) { const float r = rs[ai][m];
                const f32x4 gb = acc[ai][0][m][0] * r, uu = acc[ai][0][m][1] * acc[ai][1][m][0] * (r * r), zz = acc[ai][1][m][1] * r;
                float ys[4];
#pragma unroll
                for (int e = 0; e < 4; ++e) { const float r1 = dpp_ror1(uu[e]), r2 = dpp_ror2(uu[e]);
                    const float um1 = f1 ? r1 : p1[e], um2 = f2 ? r2 : p2[e];
                    ys[e] = gb[e] * (um2 * w0[e] + um1 * w1[e] + uu[e] * w2[e]);
                    p1[e] = r1; p2[e] = r2; }
                u32x2 oz, oy; oz.x = cvt_pk_bf16(zz[0], zz[1]); oz.y = cvt_pk_bf16(zz[2], zz[3]); oy.x = cvt_pk_bf16(ys[0], ys[1]); oy.y = cvt_pk_bf16(ys[2], ys[3]);
                bf16_t* rp = mrow + (size_t)(ai * 128 + m * 16) * 2048;
                *(u32x2*)rp = oz; *(u32x2*)(rp + 1024) = oy; }
            asm volatile("" ::: "memory");
        }
    }
};
struct EpiFfnAct {
    static constexpr bool PERM = true;
    bf16_t* act; float* gfirst; float* glast; float* ufirst; const float* cw; const float* cb; const float* st; float* sout; LAS float* xch;
    __device__ __forceinline__ void operator()(const f32x4 (&acc)[2][2][4][2], const pg8::Unit& u, int wr, int wc, int fr_, int fq_) const {
        int fr = fr_, fq = fq_; asm volatile("" : "+v"(fr), "+v"(fq));
        const int cl = wc * 32 + 8 * fq, cg = u.pn * 128 + cl;
        if (u.pm == 64) {
#pragma unroll
            for (int n = 0; n < 2; ++n) { const f32x4 w0 = *(const f32x4*)(cw + cg + 4 * n), w1 = *(const f32x4*)(cw + DFF + cg + 4 * n), w2 = *(const f32x4*)(cw + 2 * DFF + cg + 4 * n), bb = *(const f32x4*)(cb + cg + 4 * n);
#pragma unroll
                for (int m = 0; m < 4; ++m) { const int bs = wr * 64 + m * 16 + fr;
                    const f32x4 s0 = *(const f32x4*)(st + (size_t)(bs * 2) * DFF + cg + 4 * n), s1 = *(const f32x4*)(st + (size_t)(bs * 2 + 1) * DFF + cg + 4 * n);
                    const f32x4 g = acc[0][0][m][n], up = acc[0][1][m][n]; const f32x4 cv = s0 * w0 + s1 * w1 + g * w2 + bb;
                    u32x2 o; o.x = cvt_pk_bf16(silu_f(cv[0]) * up[0], silu_f(cv[1]) * up[1]); o.y = cvt_pk_bf16(silu_f(cv[2]) * up[2], silu_f(cv[3]) * up[3]);
                    *(f32x4*)(sout + (size_t)(bs * 2) * DFF + cg + 4 * n) = s1; *(f32x4*)(sout + (size_t)(bs * 2 + 1) * DFF + cg + 4 * n) = g;
                    *(u32x2*)(act + (size_t)(TPR + bs) * DFF + cg + 4 * n) = o; } }
            return;
        }
        if (fr >= 14) {
#pragma unroll
            for (int ai = 0; ai < 2; ++ai)
#pragma unroll
                for (int n = 0; n < 2; ++n) *(LAS f32x4*)(xch + ((2 * ai + wr) * 2 + (fr - 14)) * 128 + cl + 4 * n) = acc[ai][0][3][n];
            if (wr == 1) {
#pragma unroll
                for (int n = 0; n < 2; ++n) *(f32x4*)(glast + (size_t)(u.pm * 2 + (fr - 14)) * DFF + cg + 4 * n) = acc[1][0][3][n]; }
        }
        if (fr < 2 && wr == 0) {
#pragma unroll
            for (int n = 0; n < 2; ++n) { *(f32x4*)(gfirst + (size_t)(u.pm * 2 + fr) * DFF + cg + 4 * n) = acc[0][0][0][n]; *(f32x4*)(ufirst + (size_t)(u.pm * 2 + fr) * DFF + cg + 4 * n) = acc[0][1][0][n]; }
        }
        f32x4 w0[2], w1[2], w2[2], bb[2];
#pragma unroll
        for (int n = 0; n < 2; ++n) { w0[n] = *(const f32x4*)(cw + cg + 4 * n); w1[n] = *(const f32x4*)(cw + DFF + cg + 4 * n); w2[n] = *(const f32x4*)(cw + 2 * DFF + cg + 4 * n); bb[n] = *(const f32x4*)(cb + cg + 4 * n); }
        asm volatile("s_waitcnt lgkmcnt(0)" ::: "memory"); __builtin_amdgcn_s_barrier(); __builtin_amdgcn_s_barrier(); asm volatile("" ::: "memory");
        const bool f1 = fr >= 1, f2 = fr >= 2;
        bf16_t* arow = act + (size_t)(u.pm * 256 + wr * 64 + fr) * DFF + cg;
#pragma unroll
        for (int ai = 0; ai < 2; ++ai) {
            const int k = 2 * ai + wr;
            u32x2 o0[4];
#pragma unroll
            for (int n = 0; n < 2; ++n) {
                f32x4 p1, p2;
                if (k > 0) { const f32x4 X0 = *(const LAS f32x4*)(xch + ((k - 1) * 2 + 0) * 128 + cl + 4 * n), X1 = *(const LAS f32x4*)(xch + ((k - 1) * 2 + 1) * 128 + cl + 4 * n);
                    p1 = X1;
#pragma unroll
                    for (int e = 0; e < 4; ++e) p2[e] = fr == 1 ? X1[e] : X0[e]; }
                else { p1 = (f32x4){0.f, 0.f, 0.f, 0.f}; p2 = p1; }
#pragma unroll
                for (int m = 0; m < 4; ++m) { const f32x4 g = acc[ai][0][m][n], up = acc[ai][1][m][n]; float a[4];
#pragma unroll
                    for (int e = 0; e < 4; ++e) { const float r1 = dpp_ror1(g[e]), r2 = dpp_ror2(g[e]);
                        const float gm1 = f1 ? r1 : p1[e], gm2 = f2 ? r2 : p2[e];
                        a[e] = silu_f(gm2 * w0[n][e] + gm1 * w1[n][e] + g[e] * w2[n][e] + bb[n][e]) * up[e];
                        p1[e] = r1; p2[e] = r2; }
                    u32x2 o; o.x = cvt_pk_bf16(a[0], a[1]); o.y = cvt_pk_bf16(a[2], a[3]);
                    if (n == 0) o0[m] = o;
                    else { u32x4 w; w.x = o0[m].x; w.y = o0[m].y; w.z = o.x; w.w = o.y; *(u32x4*)(arow + (size_t)(ai * 128 + m * 16) * DFF) = w; } }
            }
            asm volatile("" ::: "memory");
        }
    }
};
struct EpiRes {
    static constexpr bool PERM = false;
    const float* bf; const bf16_t* b16; bf16_t* o16;
    __device__ __forceinline__ void operator()(const f32x4 (&acc)[2][2][4][2], const pg8::Unit& u, int wr, int wc, int fr_, int fq_) const {
        int fr = fr_, fq = fq_; asm volatile("" : "+v"(fr), "+v"(fq));
        const size_t off0 = (size_t)(u.pm * 256 + wr * 64 + fr) * 1024 + u.pn * 256 + wc * 32 + 4 * fq;
#pragma unroll
        for (int ai = 0; ai < 2; ++ai) {
            f32x4 bv[4][2][2];
            if (bf) {
#pragma unroll
                for (int m = 0; m < 4; ++m)
#pragma unroll
                    for (int bj = 0; bj < 2; ++bj)
#pragma unroll
                        for (int n = 0; n < 2; ++n) bv[m][bj][n] = *(const f32x4*)(bf + off0 + (size_t)(ai * 128 + m * 16) * 1024 + bj * 128 + n * 16);
            } else {
                u32x2 br[4][2][2];
#pragma unroll
                for (int m = 0; m < 4; ++m)
#pragma unroll
                    for (int bj = 0; bj < 2; ++bj)
#pragma unroll
                        for (int n = 0; n < 2; ++n) br[m][bj][n] = *(const u32x2*)(b16 + off0 + (size_t)(ai * 128 + m * 16) * 1024 + bj * 128 + n * 16);
#pragma unroll
                for (int m = 0; m < 4; ++m)
#pragma unroll
                    for (int bj = 0; bj < 2; ++bj)
#pragma unroll
                        for (int n = 0; n < 2; ++n) bv[m][bj][n] = (f32x4){bf_lo(br[m][bj][n].x), bf_hi(br[m][bj][n].x), bf_lo(br[m][bj][n].y), bf_hi(br[m][bj][n].y)};
            }
#pragma unroll
            for (int m = 0; m < 4; ++m)
#pragma unroll
                for (int bj = 0; bj < 2; ++bj)
#pragma unroll
                    for (int n = 0; n < 2; ++n) { const f32x4 o = bv[m][bj][n] + acc[ai][bj][m][n]; u32x2 pk; pk.x = cvt_pk_bf16(o[0], o[1]); pk.y = cvt_pk_bf16(o[2], o[3]);
                        *(u32x2*)(o16 + off0 + (size_t)(ai * 128 + m * 16) * 1024 + bj * 128 + n * 16) = pk; }
            asm volatile("" ::: "memory");
        }
    }
};
struct EpiSlab {
    static constexpr bool PERM = false;
    float* slab;
    __device__ __forceinline__ void operator()(const f32x4 (&acc)[2][2][4][2], const pg8::Unit& u, int wr, int wc, int fr, int fq) const {
        const int col0 = u.pn * 256 + wc * 32 + 4 * fq;
        float* sb = slab + (size_t)(u.ko >> 8) * (128 * 1024);
#pragma unroll
        for (int m = 0; m < 4; ++m) { float* o = sb + (size_t)(wr * 64 + m * 16 + fr) * 1024 + col0;
#pragma unroll
            for (int bj = 0; bj < 2; ++bj)
#pragma unroll
                for (int n = 0; n < 2; ++n) *(f32x4*)(o + bj * 128 + n * 16) = acc[0][bj][m][n]; }
    }
};

struct Params {
    const float* x_prompt; const float* x_sample; const float* state_ssm; const float* state_ssd_conv; const float* state_sc; const float* state_ffn;
    const float* norm_mix_w; const float* w_in; const float* ssd_conv_w; const float* ssd_conv_b; const float* dt_bias; const float* a_log; const float* ssd_d; const float* ssd_norm_w;
    const float* sc_conv_w; const float* w_out; const float* norm_ffn_w; const float* w_ffn_in; const float* ffn_conv_w; const float* ffn_conv_b; const float* w_down; const float* norm_final_w;
    float* out; unsigned char* ws; int ph_lo, ph_hi;
};

__device__ __forceinline__ int map_in4(int jd) {
    const int T = jd >> 8, L = jd & 255;
    if (T >= 16) return 1024 + (T - 16) * 256 + L;
    const int bj = L >> 7, wc = (L >> 5) & 3, fq = (L >> 3) & 3, n = (L >> 2) & 1, jj = T * 64 + wc * 16 + fq * 4;
    return (bj == 0 ? (n == 0 ? 2576 : 3600) : (n == 0 ? 4624 : 0)) + jj;
}
__device__ __forceinline__ int map_in_old(int j0) {
    if (j0 < 2560) return j0;
    if (j0 < 3584) return 2576 + (j0 - 2560);
    const int k = (j0 - 3584) >> 8, w = (j0 - 3584) & 255;
    return w < 128 ? 3600 + k * 128 + w : 4624 + k * 128 + (w - 128);
}
__device__ __forceinline__ void p0_chunk(const Params& P, LAS unsigned char* lds, int ci) {
    const int tid = threadIdx.x, lane = tid & 63, wid = tid >> 6, r16 = lane & 15, q = lane >> 4;
    LAS bf16_t* wdt = (LAS bf16_t*)lds;
    LAS float* dts = (LAS float*)(lds + 33024);
    LAS float* segs = (LAS float*)(lds + 33024 + 8192);
    LAS float* nws = (LAS float*)(lds + 33024 + 8192 + 1024);
    *(LAS float*)(nws + tid) = P.norm_mix_w[tid]; *(LAS float*)(nws + 512 + tid) = P.norm_mix_w[512 + tid];
#pragma unroll
    for (int i = 0; i < 8; ++i) { const int k = (tid >> 2) + 128 * i, c4 = (tid & 3) * 4; const f32x4 v = *(const f32x4*)(P.w_in + (size_t)k * DINP + 2560 + c4);
        wdt[(c4 + 0) * 1032 + k] = f2bf(v[0]); wdt[(c4 + 1) * 1032 + k] = f2bf(v[1]); wdt[(c4 + 2) * 1032 + k] = f2bf(v[2]); wdt[(c4 + 3) * 1032 + k] = f2bf(v[3]); }
    __syncthreads();
    const int row = ci * 128 + wid * 16 + r16;
    const float* src = (row < TPR ? P.x_prompt + (size_t)row * 1024 : P.x_sample + (size_t)(row - TPR) * 1024) + 8 * q;
    bf16_t* dst = (bf16_t*)(P.ws + WS_A1) + (size_t)row * 1024 + 8 * q;
    const LAS float* nw = nws + 8 * q;
    f32x4 acc = (f32x4){0.f, 0.f, 0.f, 0.f};
    float ss = 0.f;
    f32x4 xa[2][8], xb[2][8];
#pragma unroll
    for (int u = 0; u < 8; ++u) { xa[0][u] = __builtin_nontemporal_load((const f32x4*)(src + 32 * u)); xb[0][u] = __builtin_nontemporal_load((const f32x4*)(src + 32 * u + 4)); }
#pragma unroll
    for (int bt = 0; bt < 4; ++bt) { const int s0 = 8 * bt;
        if (bt < 3) {
#pragma unroll
            for (int u = 0; u < 8; ++u) { xa[(bt + 1) & 1][u] = __builtin_nontemporal_load((const f32x4*)(src + 32 * (s0 + 8 + u))); xb[(bt + 1) & 1][u] = __builtin_nontemporal_load((const f32x4*)(src + 32 * (s0 + 8 + u) + 4)); } }
#pragma unroll
        for (int u = 0; u < 8; ++u) { const int sidx = s0 + u; const f32x4 wa = *(const LAS f32x4*)(nw + 32 * sidx), wb = *(const LAS f32x4*)(nw + 32 * sidx + 4);
            const f32x4 a = xa[bt & 1][u], b = xb[bt & 1][u];
            ss += a[0] * a[0] + a[1] * a[1] + a[2] * a[2] + a[3] * a[3] + b[0] * b[0] + b[1] * b[1] + b[2] * b[2] + b[3] * b[3];
            const f32x4 ya = a * wa, yb = b * wb;
            u32x4 pk; pk.x = cvt_pk_bf16(ya[0], ya[1]); pk.y = cvt_pk_bf16(ya[2], ya[3]); pk.z = cvt_pk_bf16(yb[0], yb[1]); pk.w = cvt_pk_bf16(yb[2], yb[3]);
            *(u32x4*)(dst + 32 * sidx) = pk;
            const bf16x8 bfr = *(const LAS bf16x8*)(wdt + r16 * 1032 + 32 * sidx + 8 * q);
            acc = __builtin_amdgcn_mfma_f32_16x16x32_bf16(__builtin_bit_cast(bf16x8, pk), bfr, acc, 0, 0, 0); }
    }
    ss += __shfl_xor(ss, 16); ss += __shfl_xor(ss, 32);
    const float rstd = rsqrtf(ss * (1.0f / 1024.0f) + EPS);
    if (q == 0) ((float*)(P.ws + WS_RSTD))[row] = rstd;
#pragma unroll
    for (int j = 0; j < 4; ++j) acc[j] *= __shfl(rstd, 4 * q + j);
    { const float bias = P.dt_bias[r16];
#pragma unroll
      for (int j = 0; j < 4; ++j) dts[(wid * 16 + 4 * q + j) * 16 + r16] = softplus_f(acc[j] + bias); }
    __syncthreads();
    if (ci < 128) {
        const int b = ci >> 4, c = ci & 15, h = tid & 15, seg = (tid >> 4) & 15;
        float d[8], cs[8];
        if (tid < 256) { const float a = -__expf(P.a_log[h]); float run = 0.f;
#pragma unroll
            for (int i = 0; i < 8; ++i) { d[i] = dts[(seg * 8 + i) * 16 + h]; run += d[i] * a; cs[i] = run; }
            segs[seg * 16 + h] = run; }
        __syncthreads();
        if (tid < 256) { float pre = 0.f;
#pragma unroll
            for (int s2 = 0; s2 < 16; ++s2) pre += (s2 < seg) ? segs[s2 * 16 + h] : 0.f;
#pragma unroll
            for (int i = 0; i < 8; ++i) cs[i] += pre;
            const size_t o = (size_t)(b * 16 + h) * 2048 + c * 128 + seg * 8;
            st8f((float*)(P.ws + WS_DT) + o, d); st8f((float*)(P.ws + WS_ACUM) + o, cs); }
    } else {
        float* dtsg = (float*)(P.ws + WS_DTS);
        for (int i = tid; i < 2048; i += 512) dtsg[i] = dts[i];
    }
    __syncthreads();
}
__device__ __forceinline__ void tile_decode(const Params& P, int t, const float*& src, bf16_t*& dst, int& K, int& Ns, int& k0, int& n0, int& c0) {
    int kt, nt;
    if (t < 1408) { src = P.w_in; dst = (bf16_t*)(P.ws + WS_WIN); K = 1024; Ns = DINP; kt = t / 88; nt = t % 88; c0 = -1; }
    else if (t < 1920) { t -= 1408; src = P.w_out; dst = (bf16_t*)(P.ws + WS_WOUT); K = 2048; Ns = 1024; kt = t >> 4; nt = t & 15; c0 = nt * 64; }
    else if (t < 3328) { t -= 1920; src = P.w_ffn_in; dst = (bf16_t*)(P.ws + WS_WFFN); K = 1024; Ns = NIN; kt = t / 88; nt = t % 88; { const int j0 = nt * 64, k = j0 >> 8, w = j0 & 255; c0 = w < 128 ? k * 128 + w : DFF + k * 128 + (w - 128); } }
    else { t -= 3328; src = P.w_down; dst = (bf16_t*)(P.ws + WS_WDOWN); K = 2816; Ns = 1024; kt = t >> 4; nt = t & 15; c0 = nt * 64; }
    k0 = kt * 64; n0 = nt * 64;
}
__device__ __forceinline__ void conv_tiles(const Params& P, LAS unsigned char* lds, int tb, int te, int stride) {
    const int tid = threadIdx.x;
    LAS float* tl = (LAS float*)lds;
    for (int t4 = tb; t4 < te; t4 += 4 * stride) {
        f32x4 v[4][2];
#pragma unroll
        for (int u = 0; u < 4; ++u) { const int t = t4 + u * stride; if (t < te) { const float* src; bf16_t* dst; int K, Ns, k0, n0, c0; tile_decode(P, t, src, dst, K, Ns, k0, n0, c0);
            const int col = c0 < 0 ? map_in4(n0 + (tid & 15) * 4) : c0 + (tid & 15) * 4;
#pragma unroll
            for (int i = 0; i < 2; ++i) v[u][i] = *(const f32x4*)(src + (size_t)(k0 + (tid >> 4) + 32 * i) * Ns + col); } }
#pragma unroll
        for (int u = 0; u < 4; ++u) { const int t = t4 + u * stride; if (t < te) {
#pragma unroll
            for (int i = 0; i < 2; ++i) { const int kr = (tid >> 4) + 32 * i, c4 = (tid & 15) * 4; LAS float* d = tl + u * 4160 + kr * 65 + c4; d[0] = v[u][i][0]; d[1] = v[u][i][1]; d[2] = v[u][i][2]; d[3] = v[u][i][3]; } } }
        __syncthreads();
#pragma unroll
        for (int u = 0; u < 4; ++u) { const int t = t4 + u * stride; if (t < te) { const float* src; bf16_t* dst; int K, Ns, k0, n0, c0; tile_decode(P, t, src, dst, K, Ns, k0, n0, c0);
            const int n = tid >> 3, k8 = (tid & 7) * 8; float f[8];
#pragma unroll
            for (int i = 0; i < 8; ++i) f[i] = tl[u * 4160 + (k8 + i) * 65 + n];
            *(u32x4*)(dst + (size_t)(n0 + n) * K + k0 + k8) = pack8(f); } }
        __syncthreads();
    }
}
__device__ __forceinline__ void phase0(const Params& P, LAS unsigned char* lds) {
    const int G = gridDim.x, bx = blockIdx.x, NCI = 129;
    for (int ci = bx; ci < NCI; ci += G) p0_chunk(P, lds, ci);
    if (G > NCI) { if (bx >= NCI) conv_tiles(P, lds, bx - NCI, 1408, G - NCI); }
    else conv_tiles(P, lds, bx, 1408, G);
}
__device__ __forceinline__ void p1_late_tiles(const Params& P, LAS unsigned char* lds) {
    const int G = gridDim.x, bx = blockIdx.x, nwg = (TPAD / 256) * (NIN / 256), nfull = nwg % G;
    if (nfull > 0 && nfull < G) { if (bx >= nfull) conv_tiles(P, lds, 1408 + bx - nfull, 4032, G - nfull); }
    else conv_tiles(P, lds, 1408 + bx, 4032, G);
}

__device__ __forceinline__ void p2_conv_load(const Params& P, int item, u32x4 (&pre)[3]) {
    const int tid = threadIdx.x;
    const int strip = item % 24, bc = item / 24, b = bc >> 4, c = bc & 15, t0 = c * 128;
    const int colg = strip < 16 ? strip * 64 : (strip < 20 ? 1024 + (strip - 16) * 64 : 1280 + (strip - 20) * 64);
    const bf16_t* xbc = (const bf16_t*)(P.ws + WS_XBC);
#pragma unroll
    for (int k = 0; k < 3; ++k) { const int i = tid + 512 * k; pre[k] = (u32x4){0u, 0u, 0u, 0u};
        if (i < 131 * 8) { const int rr = i >> 3, c8 = (i & 7) * 8, tl = t0 - 3 + rr; if (tl >= 0) pre[k] = *(const u32x4*)(xbc + (size_t)(b * 2048 + tl) * XBC + colg + c8); } }
}
__device__ __forceinline__ void p2_conv_item(const Params& P, LAS unsigned char* lds, int item, int next_item, u32x4 (&pre)[3]) {
    const int tid = threadIdx.x;
    const int strip = item % 24, bc = item / 24, b = bc >> 4, c = bc & 15, t0 = c * 128;
    const int colg = strip < 16 ? strip * 64 : (strip < 20 ? 1024 + (strip - 16) * 64 : 1280 + (strip - 20) * 64);
    LAS bf16_t* raw = (LAS bf16_t*)lds;
    LAS bf16_t* outn = (LAS bf16_t*)(lds + 16768);
#pragma unroll
    for (int k = 0; k < 3; ++k) { const int i = tid + 512 * k; if (i < 131 * 8) *(LAS u32x4*)(raw + (i >> 3) * 64 + (i & 7) * 8) = pre[k]; }
    __syncthreads();
    if (next_item >= 0) p2_conv_load(P, next_item, pre);
    const int col = tid & 63, rg = tid >> 6;
    const float w0 = P.ssd_conv_w[colg + col], w1 = P.ssd_conv_w[XBC + colg + col], w2 = P.ssd_conv_w[2 * XBC + colg + col], w3 = P.ssd_conv_w[3 * XBC + colg + col], bs = P.ssd_conv_b[colg + col];
    float o[16];
    { float x0 = bf2f(raw[(rg * 16 + 0) * 64 + col]), x1 = bf2f(raw[(rg * 16 + 1) * 64 + col]), x2 = bf2f(raw[(rg * 16 + 2) * 64 + col]);
#pragma unroll
      for (int i = 0; i < 16; ++i) { const float x3 = bf2f(raw[(rg * 16 + i + 3) * 64 + col]); o[i] = silu_f(x0 * w0 + x1 * w1 + x2 * w2 + x3 * w3 + bs); x0 = x1; x1 = x2; x2 = x3; } }
    u32x4 pk0, pk1;
    pk0.x = cvt_pk_bf16(o[0], o[1]); pk0.y = cvt_pk_bf16(o[2], o[3]); pk0.z = cvt_pk_bf16(o[4], o[5]); pk0.w = cvt_pk_bf16(o[6], o[7]);
    pk1.x = cvt_pk_bf16(o[8], o[9]); pk1.y = cvt_pk_bf16(o[10], o[11]); pk1.z = cvt_pk_bf16(o[12], o[13]); pk1.w = cvt_pk_bf16(o[14], o[15]);
    LAS unsigned char* outT = lds + 16768 + 16384;
    if (strip < 20) { *(LAS u32x4*)(outT + col * 272 + rg * 32) = pk0; *(LAS u32x4*)(outT + col * 272 + rg * 32 + 16) = pk1; }
    if (strip >= 16) {
#pragma unroll
        for (int i = 0; i < 16; ++i) outn[(rg * 16 + i) * 64 + col] = f2bf(o[i]); }
    __syncthreads();
    if (strip < 20) {
        bf16_t* dT = strip < 16 ? (bf16_t*)(P.ws + WS_A1) + ((size_t)(b * 16 + strip) * 64) * 2048 + t0
                                : (bf16_t*)((unsigned char*)P.out + OS_BT) + ((size_t)(b * 2 + ((strip - 16) >> 1)) * 128 + ((strip - 16) & 1) * 64) * 2048 + t0;
        for (int i = tid; i < 1024; i += 512) { const int rr = i >> 4, c16 = i & 15; *(u32x4*)(dT + (size_t)rr * 2048 + c16 * 8) = *(const LAS u32x4*)(outT + rr * 272 + c16 * 16); }
    }
    if (strip >= 16) {
        const int sb = (strip - 16) & 3, g = sb >> 1, n0 = (sb & 1) * 64;
        bf16_t* nat = (bf16_t*)((unsigned char*)P.out + (strip < 20 ? OS_BN : OS_CN)) + ((size_t)(b * 2 + g) * 2048 + t0) * 128 + n0;
        for (int i = tid; i < 1024; i += 512) { const int rr = i >> 3, c8 = (i & 7) * 8; *(u32x4*)(nat + (size_t)rr * 128 + c8) = *(const LAS u32x4*)(outn + rr * 64 + c8); }
    }
    if (c == 15 && tid < 192) { const int rr = tid >> 6; P.out[O_PSSDC + (size_t)(b * 3 + rr) * XBC + colg + col] = bf2f(raw[(128 + rr) * 64 + col]); }
    __syncthreads();
}
__device__ __forceinline__ void p2_state_load(const Params& P, int item, int i0, f32x4 (&hv)[16]) {
    const int lane = threadIdx.x & 63, wid = threadIdx.x >> 6, bs = item >> 1, g = item & 1;
    const float* hin = P.state_ssm + ((size_t)(bs * 16 + g * 8 + wid) * 64 + (lane >> 5)) * 128 + 4 * (lane & 31);
#pragma unroll
    for (int i = 0; i < 16; ++i) hv[i] = __builtin_nontemporal_load((const f32x4*)(hin + (size_t)(i0 + i) * 256));
}
__device__ __forceinline__ void p2_sample_item(const Params& P, LAS unsigned char* lds, int item) {
    const int tid = threadIdx.x, lane = tid & 63, wid = tid >> 6;
    const int bs = item >> 1, g = item & 1, row = TPR + bs;
    LAS float* sx = (LAS float*)lds;
    const int half = lane >> 5, l32 = lane & 31;
    float* hout = P.out + O_SSSM + ((size_t)(bs * 16 + g * 8 + wid) * 64 + half) * 128 + 4 * l32;
    f32x4 hva[16]; p2_state_load(P, item, 0, hva);
    LAS float* ssqs = sx + 768;
    const bf16_t* xbc = (const bf16_t*)(P.ws + WS_XBC) + (size_t)row * XBC;
    bf16_t* mix = (bf16_t*)(P.ws + WS_MIX) + (size_t)row * 2048;
    for (int i = tid; i < 768; i += 512) {
        const int j = i < 512 ? g * 512 + i : (i < 640 ? 1024 + g * 128 + (i - 512) : 1280 + g * 128 + (i - 640));
        const float* st = P.state_ssd_conv + (size_t)bs * 3 * XBC + j;
        const float s0 = st[0], s1 = st[XBC], s2 = st[2 * XBC], xr = bf2f(xbc[j]);
        const float v = s0 * P.ssd_conv_w[j] + s1 * P.ssd_conv_w[XBC + j] + s2 * P.ssd_conv_w[2 * XBC + j] + xr * P.ssd_conv_w[3 * XBC + j] + P.ssd_conv_b[j];
        sx[i] = silu_f(v);
        float* so = P.out + O_SSSDC + (size_t)bs * 3 * XBC + j; so[0] = s1; so[XBC] = s2; so[2 * XBC] = xr;
    }
    __syncthreads();
    const int h = g * 8 + wid;
    const float dt = ((const float*)(P.ws + WS_DTS))[bs * 16 + h], a = -__expf(P.a_log[h]), dA = __expf(dt * a);
    const f32x4 Bv = *(const LAS f32x4*)(sx + 512 + 4 * l32), Cv = *(const LAS f32x4*)(sx + 640 + 4 * l32);
    float v[32];
#pragma unroll
    for (int i0 = 0; i0 < 32; i0 += 16) {
        f32x4 hv[16];
        if (i0 == 0) {
#pragma unroll
            for (int i = 0; i < 16; ++i) hv[i] = hva[i]; }
        else p2_state_load(P, item, 16, hv);
#pragma unroll
        for (int i = 0; i < 16; ++i) { const float xd = dt * sx[wid * 64 + 2 * (i0 + i) + half]; const f32x4 hn = dA * hv[i] + xd * Bv;
            __builtin_nontemporal_store(hn, (f32x4*)(hout + (size_t)(i0 + i) * 256));
            v[i0 + i] = hn[0] * Cv[0] + hn[1] * Cv[1] + hn[2] * Cv[2] + hn[3] * Cv[3]; }
    }
#pragma unroll
    for (int m = 16; m >= 1; m >>= 1) {
#pragma unroll
        for (int i = 0; i < m; ++i) { const bool up = (l32 & m) != 0; const float keep = up ? v[i + m] : v[i], send = up ? v[i] : v[i + m]; v[i] = keep + __shfl_xor(send, m); } }
    const int pl = 2 * l32 + half;
    const float ymine = v[0];
    const float xsv = sx[wid * 64 + pl];
    float y = ymine + P.ssd_d[h] * xsv;
    y *= silu_f(bf2f(mix[h * 64 + pl]));
    float sq = y * y;
    sq += __shfl_xor(sq, 1); sq += __shfl_xor(sq, 2); sq += __shfl_xor(sq, 4); sq += __shfl_xor(sq, 8); sq += __shfl_xor(sq, 16); sq += __shfl_xor(sq, 32);
    if (lane == 0) ssqs[wid] = sq;
    __syncthreads();
    float tot = 0.f;
#pragma unroll
    for (int i = 0; i < 8; ++i) tot += ssqs[i];
    const float rstd = rsqrtf(tot * (1.0f / 512.0f) + EPS);
    mix[h * 64 + pl] = f2bf(y * rstd * P.ssd_norm_w[h * 64 + pl]);
    __syncthreads();
}

__device__ __forceinline__ void p3_item(const Params& P, LAS unsigned char* lds, int item) {
    const int tid = threadIdx.x, lane = tid & 63, wid = tid >> 6, r16 = lane & 15, q = lane >> 4;
    const int b = item >> 5, c = (item >> 1) & 15, g = item & 1, h = g * 8 + wid, t0 = c * 128;
    LAS float* wsc = (LAS float*)lds + wid * 128;
    const float* dtp = (const float*)(P.ws + WS_DT) + (size_t)(b * 16 + h) * 2048 + t0;
    const float* acp = (const float*)(P.ws + WS_ACUM) + (size_t)(b * 16 + h) * 2048 + t0;
    const float alast = acp[127];
    wsc[lane] = dtp[lane] * __expf(alast - acp[lane]); wsc[lane + 64] = dtp[lane + 64] * __expf(alast - acp[lane + 64]);
    __syncthreads();
    const bf16_t* BTp = (const bf16_t*)((const unsigned char*)P.out + OS_BT) + ((size_t)(b * 2 + g) * 128) * 2048 + t0;
    const bf16_t* xsT = (const bf16_t*)(P.ws + WS_A1) + ((size_t)(b * 16 + h) * 64) * 2048 + t0;
    f32x4 acc[8][4];
#pragma unroll
    for (int i = 0; i < 8; ++i)
#pragma unroll
        for (int j = 0; j < 4; ++j) acc[i][j] = (f32x4){0.f, 0.f, 0.f, 0.f};
#pragma unroll 2
    for (int kk = 0; kk < 4; ++kk) { const int s0 = 32 * kk + 8 * q;
        float sc[8]; { const f32x4 a = *(const LAS f32x4*)(wsc + s0), b2 = *(const LAS f32x4*)(wsc + s0 + 4); sc[0] = a[0]; sc[1] = a[1]; sc[2] = a[2]; sc[3] = a[3]; sc[4] = b2[0]; sc[5] = b2[1]; sc[6] = b2[2]; sc[7] = b2[3]; }
        bf16x8 bfr[4];
#pragma unroll
        for (int pt = 0; pt < 4; ++pt) { const u32x4 rawv = *(const u32x4*)(xsT + (size_t)(pt * 16 + r16) * 2048 + s0); float f[8]; unpack8(rawv, f);
#pragma unroll
            for (int j = 0; j < 8; ++j) f[j] *= sc[j];
            bfr[pt] = __builtin_bit_cast(bf16x8, pack8(f)); }
#pragma unroll
        for (int nt = 0; nt < 8; ++nt) { const bf16x8 afr = *(const bf16x8*)(BTp + (size_t)(nt * 16 + r16) * 2048 + s0);
#pragma unroll
            for (int pt = 0; pt < 4; ++pt) acc[nt][pt] = __builtin_amdgcn_mfma_f32_16x16x32_bf16(afr, bfr[pt], acc[nt][pt], 0, 0, 0); }
    }
    bf16_t* stp = (bf16_t*)((unsigned char*)P.out + OS_ST) + (((size_t)(b * 16 + c) * 16 + h) * 64) * 128;
#pragma unroll
    for (int nt = 0; nt < 8; ++nt)
#pragma unroll
        for (int pt = 0; pt < 4; ++pt) { u32x2 w; w.x = cvt_pk_bf16(acc[nt][pt][0], acc[nt][pt][1]); w.y = cvt_pk_bf16(acc[nt][pt][2], acc[nt][pt][3]);
            *(u32x2*)(stp + (size_t)(pt * 16 + r16) * 128 + nt * 16 + 4 * q) = w; }
    __syncthreads();
}

__device__ __forceinline__ void phase4(const Params& P) {
    const int tid = threadIdx.x, G = gridDim.x, bx = blockIdx.x;
    for (int idx = bx * 512 + tid; idx < 262144; idx += G * 512) {
        const int n4 = idx & 31, pp = (idx >> 5) & 63, h = (idx >> 11) & 15, b = idx >> 15;
        const float* acp = (const float*)(P.ws + WS_ACUM) + (size_t)(b * 16 + h) * 2048;
        f32x4 hs = (f32x4){0.f, 0.f, 0.f, 0.f};
        u32x2* ptr0 = (u32x2*)((bf16_t*)((unsigned char*)P.out + OS_ST) + ((((size_t)(b * 16) * 16 + h) * 64 + pp) * 128 + n4 * 4));
        u32x2 sv[16]; float dec[16];
#pragma unroll
        for (int c = 0; c < 16; ++c) { sv[c] = ptr0[(size_t)c * 32768]; dec[c] = acp[c * 128 + 127]; }
#pragma unroll
        for (int c = 0; c < 16; ++c) { u32x2 w; w.x = cvt_pk_bf16(hs[0], hs[1]); w.y = cvt_pk_bf16(hs[2], hs[3]); ptr0[(size_t)c * 32768] = w;
            const float d = __expf(dec[c]); const u32x2 sc = sv[c];
            hs[0] = d * hs[0] + bf_lo(sc.x); hs[1] = d * hs[1] + bf_hi(sc.x); hs[2] = d * hs[2] + bf_lo(sc.y); hs[3] = d * hs[3] + bf_hi(sc.y); }
        *(f32x4*)(P.out + O_PSSM + ((size_t)(b * 16 + h) * 64 + pp) * 128 + n4 * 4) = hs;
    }
}

__device__ __forceinline__ void p5_stage_load(const bf16_t* Hp, const bf16_t* xsT, u32x4 (&sr)[4]) {
    const int tid = threadIdx.x;
#pragma unroll
    for (int k = 0; k < 2; ++k) { const int i = tid + 512 * k, row = i >> 4, c16 = i & 15;
        sr[k] = *(const u32x4*)(Hp + (size_t)row * 128 + c16 * 8); sr[2 + k] = *(const u32x4*)(xsT + (size_t)row * 2048 + c16 * 8); }
}
__device__ __forceinline__ void p5_stage_write(LAS unsigned char* buf, const u32x4 (&sr)[4]) {
    const int tid = threadIdx.x;
#pragma unroll
    for (int k = 0; k < 2; ++k) { const int i = tid + 512 * k, row = i >> 4, c16 = i & 15;
        *(LAS u32x4*)(buf + row * 272 + c16 * 16) = sr[k]; *(LAS u32x4*)(buf + 17408 + row * 272 + c16 * 16) = sr[2 + k]; }
}
__device__ __forceinline__ void p5_item(const Params& P, LAS unsigned char* lds, int item) {
    const int tid = threadIdx.x, lane = tid & 63, w = __builtin_amdgcn_readfirstlane(tid >> 6), r16 = lane & 15, q = lane >> 4;
    const int b = item >> 5, c = (item >> 1) & 15, g = item & 1, t0 = c * 128, l0 = 16 * w;
    LAS float* acs = (LAS float*)lds;
    LAS float* dtl = acs + 1024;
    LAS unsigned char* sbuf = lds + 8192;
    LAS float* nwl = (LAS float*)(lds + 8192 + 69632);
    nwl[tid] = P.ssd_norm_w[g * 512 + tid];
    const bf16_t* Hbase = (const bf16_t*)((const unsigned char*)P.out + OS_ST) + (((size_t)(b * 16 + c) * 16 + g * 8) * 64) * 128;
    const bf16_t* Xbase = (const bf16_t*)(P.ws + WS_A1) + ((size_t)(b * 16 + g * 8) * 64) * 2048 + t0;
    u32x4 sr[4];
    p5_stage_load(Hbase, Xbase, sr);
    if (tid < 256) { const size_t o = (size_t)(b * 16 + g * 8 + (tid >> 5)) * 2048 + t0 + (tid & 31) * 4;
      *(LAS f32x4*)(acs + tid * 4) = *(const f32x4*)((const float*)(P.ws + WS_ACUM) + o); *(LAS f32x4*)(dtl + tid * 4) = *(const f32x4*)((const float*)(P.ws + WS_DT) + o); }
    const bf16_t* Bn = (const bf16_t*)((const unsigned char*)P.out + OS_BN) + ((size_t)(b * 2 + g) * 2048 + t0) * 128;
    const bf16_t* Cn = (const bf16_t*)((const unsigned char*)P.out + OS_CN) + ((size_t)(b * 2 + g) * 2048 + t0) * 128;
    bf16x8 cfr[4];
#pragma unroll
    for (int kk = 0; kk < 4; ++kk) cfr[kk] = *(const bf16x8*)(Cn + (size_t)(l0 + r16) * 128 + 32 * kk + 8 * q);
    f32x4 GT[8];
#pragma unroll
    for (int j = 0; j < 8; ++j) GT[j] = (f32x4){0.f, 0.f, 0.f, 0.f};
#pragma unroll
    for (int j0 = 0; j0 < 8; j0 += 4) if (j0 <= w) {
        bf16x8 bf[4][4];
#pragma unroll
        for (int j = 0; j < 4; ++j)
#pragma unroll
            for (int kk = 0; kk < 4; ++kk) bf[j][kk] = *(const bf16x8*)(Bn + (size_t)(16 * (j0 + j) + r16) * 128 + 32 * kk + 8 * q);
#pragma unroll
        for (int j = 0; j < 4; ++j)
#pragma unroll
            for (int kk = 0; kk < 4; ++kk) GT[j0 + j] = __builtin_amdgcn_mfma_f32_16x16x32_bf16(bf[j][kk], cfr[kk], GT[j0 + j], 0, 0, 0);
    }
    p5_stage_write(sbuf, sr);
    __syncthreads();
    const int lidx = l0 + r16;
    bf16_t* mixrow = (bf16_t*)(P.ws + WS_MIX) + (size_t)(b * 2048 + t0 + lidx) * 2048;
    float ssq = 0.f;
    if (PROBE_MASK && blockIdx.x == 0 && tid == 0) ((unsigned long long*)(P.ws + WS_BAR + 14336))[14] = __builtin_amdgcn_s_memrealtime();
#pragma unroll 1
    for (int r = 0; r < 8; ++r) {
        const int h = g * 8 + r;
        if (r < 7) p5_stage_load(Hbase + (size_t)(r + 1) * 8192, Xbase + (size_t)(r + 1) * 131072, sr);
        u32x2 zz[4];
#pragma unroll
        for (int pt = 0; pt < 4; ++pt) zz[pt] = *(const u32x2*)(mixrow + h * 64 + pt * 16 + 4 * q);
        const LAS unsigned char* Hb = sbuf + (r & 1) * 34816 + r16 * 272 + 16 * q;
        const LAS unsigned char* Xb = sbuf + (r & 1) * 34816 + 17408 + r16 * 272 + 8 * q;
        const float acl = acs[r * 128 + lidx], Dh = P.ssd_d[h];
        f32x4 acc[4];
#pragma unroll
        for (int pt = 0; pt < 4; ++pt) acc[pt] = (f32x4){0.f, 0.f, 0.f, 0.f};
#pragma unroll
        for (int kk = 0; kk < 4; ++kk)
#pragma unroll
            for (int pt = 0; pt < 4; ++pt) { const bf16x8 afr = *(const LAS bf16x8*)(Hb + pt * 4352 + kk * 64); acc[pt] = __builtin_amdgcn_mfma_f32_16x16x32_bf16(afr, cfr[kk], acc[pt], 0, 0, 0); }
        { const float el = __expf(acl);
#pragma unroll
          for (int pt = 0; pt < 4; ++pt) acc[pt] *= el; }
#pragma unroll
        for (int kk = 0; kk < 4; ++kk) if (2 * kk <= w) {
            const f32x4 asa = *(const LAS f32x4*)(acs + r * 128 + 32 * kk + 4 * q), dta = *(const LAS f32x4*)(dtl + r * 128 + 32 * kk + 4 * q);
            const f32x4 asb = *(const LAS f32x4*)(acs + r * 128 + 32 * kk + 16 + 4 * q), dtb = *(const LAS f32x4*)(dtl + r * 128 + 32 * kk + 16 + 4 * q);
            float m[8];
#pragma unroll
            for (int j = 0; j < 4; ++j) { const int s = 32 * kk + 4 * q + j; float v = GT[2 * kk][j] * __expf(fminf(acl - asa[j], 0.f)) * dta[j]; v = s > lidx ? 0.f : v; v = s == lidx ? v + Dh : v; m[j] = v; }
#pragma unroll
            for (int j = 0; j < 4; ++j) { const int s = 32 * kk + 16 + 4 * q + j; float v = GT[2 * kk + 1][j] * __expf(fminf(acl - asb[j], 0.f)) * dtb[j]; v = s > lidx ? 0.f : v; v = s == lidx ? v + Dh : v; m[4 + j] = v; }
            const bf16x8 bfr = __builtin_bit_cast(bf16x8, pack8(m));
#pragma unroll
            for (int pt = 0; pt < 4; ++pt) { const u32x2 lo = *(const LAS u32x2*)(Xb + pt * 4352 + kk * 64), hi = *(const LAS u32x2*)(Xb + pt * 4352 + kk * 64 + 32);
                u32x4 av; av.x = lo.x; av.y = lo.y; av.z = hi.x; av.w = hi.y;
                acc[pt] = __builtin_amdgcn_mfma_f32_16x16x32_bf16(__builtin_bit_cast(bf16x8, av), bfr, acc[pt], 0, 0, 0); }
        }
#pragma unroll
        for (int pt = 0; pt < 4; ++pt) {
            const float y0 = acc[pt][0] * silu_f(bf_lo(zz[pt].x)), y1 = acc[pt][1] * silu_f(bf_hi(zz[pt].x)), y2 = acc[pt][2] * silu_f(bf_lo(zz[pt].y)), y3 = acc[pt][3] * silu_f(bf_hi(zz[pt].y));
            ssq += y0 * y0 + y1 * y1 + y2 * y2 + y3 * y3;
            const f32x4 nw = *(const LAS f32x4*)(nwl + r * 64 + pt * 16 + 4 * q);
            u32x2 o; o.x = cvt_pk_bf16(y0 * nw[0], y1 * nw[1]); o.y = cvt_pk_bf16(y2 * nw[2], y3 * nw[3]); *(u32x2*)(mixrow + h * 64 + pt * 16 + 4 * q) = o; }
        if (r < 7) p5_stage_write(sbuf + ((r + 1) & 1) * 34816, sr);
        __syncthreads();
    }
    if (PROBE_MASK && blockIdx.x == 0 && tid == 0) ((unsigned long long*)(P.ws + WS_BAR + 14336))[15] = __builtin_amdgcn_s_memrealtime();
    ssq += __shfl_xor(ssq, 16); ssq += __shfl_xor(ssq, 32);
    const float rstd = rsqrtf(ssq * (1.0f / 512.0f) + EPS);
    if (q == 0) ((float*)(P.ws + WS_GRS))[(size_t)(b * 2048 + t0 + lidx) * 2 + g] = rstd;
    __syncthreads();
    if (PROBE_MASK && blockIdx.x == 0 && tid == 0) ((unsigned long long*)(P.ws + WS_BAR + 14336))[16] = __builtin_amdgcn_s_memrealtime();
}

__device__ __forceinline__ void rmsnorm_rows(float* srcf, const bf16_t* src16, const float* w, bf16_t* dstb, float* dstf, const float* slab, int nslab, const float* xs_base) {
    const int tid = threadIdx.x, lane = tid & 63, wid = tid >> 6;
    f32x4 wv[4];
#pragma unroll
    for (int i = 0; i < 4; ++i) wv[i] = *(const f32x4*)(w + lane * 4 + i * 256);
    for (int row = blockIdx.x * 8 + wid; row < TT; row += gridDim.x * 8) {
        f32x4 v[4];
        if (row < TPR) {
            u32x2 r[4];
#pragma unroll
            for (int i = 0; i < 4; ++i) r[i] = *(const u32x2*)(src16 + (size_t)row * 1024 + lane * 4 + i * 256);
#pragma unroll
            for (int i = 0; i < 4; ++i) v[i] = (f32x4){bf_lo(r[i].x), bf_hi(r[i].x), bf_lo(r[i].y), bf_hi(r[i].y)};
        } else {
            const float* s = (xs_base ? xs_base + (size_t)(row - TPR) * 1024 : srcf + (size_t)row * 1024) + lane * 4;
#pragma unroll
            for (int i = 0; i < 4; ++i) v[i] = *(const f32x4*)(s + i * 256);
            for (int k = 0; k < nslab; ++k) { const float* sp = slab + ((size_t)k * 128 + (row - TPR)) * 1024 + lane * 4;
#pragma unroll
                for (int i = 0; i < 4; ++i) v[i] += *(const f32x4*)(sp + i * 256); }
            if (xs_base) {
#pragma unroll
                for (int i = 0; i < 4; ++i) *(f32x4*)(srcf + (size_t)row * 1024 + lane * 4 + i * 256) = v[i]; }
        }
        float ss = 0.f;
#pragma unroll
        for (int i = 0; i < 4; ++i) ss += v[i][0] * v[i][0] + v[i][1] * v[i][1] + v[i][2] * v[i][2] + v[i][3] * v[i][3];
        ss += __shfl_xor(ss, 1); ss += __shfl_xor(ss, 2); ss += __shfl_xor(ss, 4); ss += __shfl_xor(ss, 8); ss += __shfl_xor(ss, 16); ss += __shfl_xor(ss, 32);
        const float rstd = rsqrtf(ss * (1.0f / 1024.0f) + EPS);
#pragma unroll
        for (int i = 0; i < 4; ++i) { const f32x4 o = v[i] * rstd * wv[i];
            if (dstb) { u32x2 pk; pk.x = cvt_pk_bf16(o[0], o[1]); pk.y = cvt_pk_bf16(o[2], o[3]); *(u32x2*)(dstb + (size_t)row * 1024 + lane * 4 + i * 256) = pk; }
            else __builtin_nontemporal_store(o, (f32x4*)(dstf + (size_t)row * 1024 + lane * 4 + i * 256)); }
    }
}

__device__ __forceinline__ void phase9_fix(const Params& P, int G, int bx) {
    const int tid = threadIdx.x;
    bf16_t* act = (bf16_t*)(P.ws + WS_UP);
    const float* gf = (const float*)(P.ws + WS_SBGF); const float* gl = (const float*)(P.ws + WS_SBGL); const float* uf = (const float*)(P.ws + WS_SBUF);
    pg8::StaticOrder S; S.init(TPR, 1024, G, bx); pg8::Unit u;
    for (int i = 0; S.next(i, u); ++i) {
        const int pm = u.pm;
        if ((pm & 7) == 0) continue;
        for (int idx = tid; idx < 704; idx += 512) { const int c4 = idx * 4;
            const f32x4 w0 = *(const f32x4*)(P.ffn_conv_w + c4), w1 = *(const f32x4*)(P.ffn_conv_w + DFF + c4), w2 = *(const f32x4*)(P.ffn_conv_w + 2 * DFF + c4), bb = *(const f32x4*)(P.ffn_conv_b + c4);
            const f32x4 gl0 = *(const f32x4*)(gl + (size_t)((pm - 1) * 2) * DFF + c4), gl1 = *(const f32x4*)(gl + (size_t)((pm - 1) * 2 + 1) * DFF + c4);
            const f32x4 gf0 = *(const f32x4*)(gf + (size_t)(pm * 2) * DFF + c4), gf1 = *(const f32x4*)(gf + (size_t)(pm * 2 + 1) * DFF + c4);
            const f32x4 u0 = *(const f32x4*)(uf + (size_t)(pm * 2) * DFF + c4), u1 = *(const f32x4*)(uf + (size_t)(pm * 2 + 1) * DFF + c4);
            const f32x4 c0 = gl0 * w0 + gl1 * w1 + gf0 * w2 + bb, c1 = gl1 * w0 + gf0 * w1 + gf1 * w2 + bb;
            u32x2 o0, o1;
            o0.x = cvt_pk_bf16(silu_f(c0[0]) * u0[0], silu_f(c0[1]) * u0[1]); o0.y = cvt_pk_bf16(silu_f(c0[2]) * u0[2], silu_f(c0[3]) * u0[3]);
            o1.x = cvt_pk_bf16(silu_f(c1[0]) * u1[0], silu_f(c1[1]) * u1[1]); o1.y = cvt_pk_bf16(silu_f(c1[2]) * u1[2], silu_f(c1[3]) * u1[3]);
            *(u32x2*)(act + (size_t)(pm * 256) * DFF + c4) = o0; *(u32x2*)(act + (size_t)(pm * 256 + 1) * DFF + c4) = o1; }
    }
    for (int idx = bx * 512 + tid; idx < 8 * 2 * 704; idx += G * 512) {
        const int b = idx / 1408, r = (idx / 704) & 1, c4 = (idx % 704) * 4;
        *(f32x4*)(P.out + O_PFFN + (size_t)(b * 2 + r) * DFF + c4) = *(const f32x4*)(gl + (size_t)((8 * b + 7) * 2 + r) * DFF + c4);
    }
    asm volatile("s_waitcnt vmcnt(0)" ::: "memory");
    __syncthreads();
}

__device__ __forceinline__ void phase6_fix(const Params& P, int G, int bx) {
    const int tid = threadIdx.x;
    bf16_t* mix = (bf16_t*)(P.ws + WS_MIX);
    const float* uf = (const float*)(P.ws + WS_SCUF); const float* ul = (const float*)(P.ws + WS_SCUL); const float* gbf = (const float*)(P.ws + WS_SCGF);
    pg8::StaticOrder S; S.init(TPR, 1024, G, bx); pg8::Unit u;
    for (int i = 0; S.next(i, u); ++i) {
        const int pm = u.pm;
        if ((pm & 7) == 0 || tid >= 256) continue;
        const int c4 = tid * 4;
        const f32x4 w0 = *(const f32x4*)(P.sc_conv_w + c4), w1 = *(const f32x4*)(P.sc_conv_w + 1024 + c4), w2 = *(const f32x4*)(P.sc_conv_w + 2048 + c4);
        const f32x4 ul0 = *(const f32x4*)(ul + (size_t)((pm - 1) * 2) * 1024 + c4), ul1 = *(const f32x4*)(ul + (size_t)((pm - 1) * 2 + 1) * 1024 + c4);
        const f32x4 uf0 = *(const f32x4*)(uf + (size_t)(pm * 2) * 1024 + c4), uf1 = *(const f32x4*)(uf + (size_t)(pm * 2 + 1) * 1024 + c4);
        const f32x4 g0 = *(const f32x4*)(gbf + (size_t)(pm * 2) * 1024 + c4), g1 = *(const f32x4*)(gbf + (size_t)(pm * 2 + 1) * 1024 + c4);
        const f32x4 y0 = g0 * (ul0 * w0 + ul1 * w1 + uf0 * w2), y1 = g1 * (ul1 * w0 + uf0 * w1 + uf1 * w2);
        u32x2 o0, o1; o0.x = cvt_pk_bf16(y0[0], y0[1]); o0.y = cvt_pk_bf16(y0[2], y0[3]); o1.x = cvt_pk_bf16(y1[0], y1[1]); o1.y = cvt_pk_bf16(y1[2], y1[3]);
        *(u32x2*)(mix + (size_t)(pm * 256) * 2048 + 1024 + c4) = o0; *(u32x2*)(mix + (size_t)(pm * 256 + 1) * 2048 + 1024 + c4) = o1;
    }
    for (int idx = bx * 512 + tid; idx < 8 * 2 * 256; idx += G * 512) {
        const int b = idx >> 9, r = (idx >> 8) & 1, c4 = (idx & 255) * 4;
        *(f32x4*)(P.out + O_PSC + (size_t)(b * 2 + r) * 1024 + c4) = *(const f32x4*)(ul + (size_t)((8 * b + 7) * 2 + r) * 1024 + c4);
    }
    asm volatile("s_waitcnt vmcnt(0)" ::: "memory");
    __syncthreads();
}

constexpr int NPHASE = 12;
static_assert(WS_END <= (size_t)256 * 1024 * 1024, "workspace map exceeds the guaranteed 256 MiB");
static_assert(WS_UP + (size_t)TPAD * 2816 * 2 <= WS_BAR, "act overlays only the dead xBC / MIX region");
__global__ void __launch_bounds__(512, 2) fwd_megakernel(Params P) {
    extern __shared__ __attribute__((aligned(16))) unsigned char lds_raw[];
    LAS unsigned char* lds = (LAS unsigned char*)lds_raw;
    volatile LAS unsigned* stw = (volatile LAS unsigned*)(lds + 131072);
    if (threadIdx.x < 4) stw[threadIdx.x] = 0u;
    __syncthreads();
    const XcdBarrier bar = xcd_barrier_post((unsigned*)(P.ws + WS_BAR), stw);
    const int lo = P.ph_lo, hi = P.ph_hi, G = gridDim.x, bx = blockIdx.x;
#define IN(k) (lo <= (k) && (k) < hi)
    unsigned long long* stamps = (unsigned long long*)(P.ws + WS_BAR + 14336);
#define STAMP(k) do { if (PROBE_MASK && bx == 0 && threadIdx.x == 0) stamps[k] = __builtin_amdgcn_s_memrealtime(); } while (0)
    STAMP(0);
#define SEAM(k) do { if (IN(k) && IN((k) + 1)) xcd_barrier(bar); STAMP((k) + 1); } while (0)
    if (IN(0)) phase0(P, lds);
    SEAM(0);
    if (IN(1)) { pg8::Gemm g{(const bf16_t*)(P.ws + WS_A1), (const bf16_t*)(P.ws + WS_WIN), TPAD, NIN, 1024, 1024, 1024}; pg8::StaticOrder S; S.init(TPAD, NIN, G, bx);
        EpiIn E{(bf16_t*)(P.ws + WS_MIX), (bf16_t*)(P.ws + WS_XBC), (const float*)(P.ws + WS_RSTD), (float*)(P.ws + WS_SCUF), (float*)(P.ws + WS_SCUL), (float*)(P.ws + WS_SCGF), P.sc_conv_w, P.state_sc, P.out + O_SSC, (LAS float*)(lds + LDS_XCH)}; pg8::gemm_phase<EpiIn>(lds, g, S, E);
        p1_late_tiles(P, lds); }
    SEAM(1);
    if (IN(2)) { { u32x4 pre[3]; if (bx < 3072) p2_conv_load(P, bx, pre);
          for (int it = bx; it < 3072; it += G) p2_conv_item(P, lds, it, it + G < 3072 ? it + G : -1, pre); }
        STAMP(13);
        for (int it = bx; it < 256; it += G) p2_sample_item(P, lds, it); }
    SEAM(2);
    if (IN(3)) { for (int it = bx; it < 256; it += G) p3_item(P, lds, it); }
    SEAM(3);
    if (IN(4)) phase4(P);
    SEAM(4);
    if (IN(5)) { for (int it = bx; it < 256; it += G) p5_item(P, lds, it); }
    SEAM(5);
    if (IN(6)) { phase6_fix(P, G, bx);
        { pg8::Gemm g{(const bf16_t*)(P.ws + WS_MIX), (const bf16_t*)(P.ws + WS_WOUT), TPR, 1024, 2048, 2048, 2048}; pg8::StaticOrder S; S.init(TPR, 1024, G, bx);
          LAS float* sct = (LAS float*)(lds + LDS_XCH);
          { pg8::Unit u0; if (S.next(0, u0) && threadIdx.x < 256) { const float* gr = (const float*)(P.ws + WS_GRS) + (size_t)(u0.pm * 256 + threadIdx.x) * 2; const float r0 = gr[0], r1 = gr[1];
                sct[threadIdx.x] = r0 / r1; sct[256 + threadIdx.x] = r1; } }
          __syncthreads();
          EpiRes E{P.x_prompt, nullptr, (bf16_t*)(P.ws + WS_X1B)};
          pg8::gemm_phase<EpiRes, pg8::StaticOrder, true>(lds, g, S, E, sct); }
        { pg8::Gemm g{(const bf16_t*)(P.ws + WS_MIX) + (size_t)TPR * 2048, (const bf16_t*)(P.ws + WS_WOUT), 256, 1024, 256, 2048, 2048}; pg8::SplitOrder S{32, bx, 256};
          EpiSlab E{(float*)(P.ws + WS_SLAB)}; pg8::gemm_phase<EpiSlab>(lds, g, S, E); } }
    SEAM(6);
    if (IN(7)) rmsnorm_rows(P.out, (const bf16_t*)(P.ws + WS_X1B), P.norm_ffn_w, (bf16_t*)(P.ws + WS_A1), nullptr, (const float*)(P.ws + WS_SLAB), 8, P.x_sample);
    SEAM(7);
    if (IN(8)) { pg8::Gemm g{(const bf16_t*)(P.ws + WS_A1), (const bf16_t*)(P.ws + WS_WFFN), TPAD, NIN, 1024, 1024, 1024}; pg8::StaticOrder S; S.init(TPAD, NIN, G, bx);
        EpiFfnAct E{(bf16_t*)(P.ws + WS_UP), (float*)(P.ws + WS_SBGF), (float*)(P.ws + WS_SBGL), (float*)(P.ws + WS_SBUF), P.ffn_conv_w, P.ffn_conv_b, P.state_ffn, P.out + O_SFFN, (LAS float*)(lds + LDS_XCH)};
        pg8::gemm_phase<EpiFfnAct>(lds, g, S, E); }
    SEAM(8);
    if (IN(10)) { phase9_fix(P, G, bx);
        { pg8::Gemm g{(const bf16_t*)(P.ws + WS_UP), (const bf16_t*)(P.ws + WS_WDOWN), TPR, 1024, DFF, DFF, DFF}; pg8::StaticOrder S; S.init(TPR, 1024, G, bx);
          EpiRes E{nullptr, (const bf16_t*)(P.ws + WS_X1B), (bf16_t*)(P.ws + WS_A1)}; pg8::gemm_phase<EpiRes>(lds, g, S, E); }
        { pg8::Gemm g{(const bf16_t*)(P.ws + WS_UP) + (size_t)TPR * DFF, (const bf16_t*)(P.ws + WS_WDOWN), 256, 1024, 256, DFF, DFF}; pg8::SplitOrder S{44, bx, 256};
          EpiSlab E{(float*)(P.ws + WS_SLAB)}; pg8::gemm_phase<EpiSlab>(lds, g, S, E); } }
    SEAM(10);
    if (IN(11)) rmsnorm_rows(P.out, (const bf16_t*)(P.ws + WS_A1), P.norm_final_w, nullptr, P.out, (const float*)(P.ws + WS_SLAB), 11, nullptr);
    if (PROBE_MASK && bx == 0 && threadIdx.x == 0) {
        const unsigned long long tend = __builtin_amdgcn_s_memrealtime(); stamps[12] = tend; unsigned long long extra = 0;
        asm volatile("s_waitcnt vmcnt(0)" ::: "memory");
        for (int k = 0; k < 12; ++k) if ((PROBE_MASK >> k) & 1) extra += stamps[k + 1] - stamps[k];
        if (PROBE_MASK & 0x1000) extra += stamps[13] - stamps[2];
        if (PROBE_MASK & 0x2000) extra += stamps[15] - stamps[14];
        if (PROBE_MASK & 0x4000) extra += stamps[14] - stamps[5];
        if (PROBE_MASK & 0x8000) extra += stamps[16] - stamps[15];
        if (PROBE_MASK & 0x10000) extra += stamps[6] - stamps[16];
        while (__builtin_amdgcn_s_memrealtime() - tend < extra) __builtin_amdgcn_s_sleep(8);
    }
#undef IN
#undef SEAM
}

#ifndef N_LAUNCHES
#define N_LAUNCHES 1
#endif
extern "C" void kernel_launch(void* const* d_in, const int* in_sizes, int n_in, void* d_out, int out_size, void* d_ws, size_t ws_size, hipStream_t stream) {
    static int grid_blocks = 0;
    if (!grid_blocks) {
        int dev = 0, cus = 0, per_cu = 0;
        (void)hipGetDevice(&dev);
        (void)hipDeviceGetAttribute(&cus, hipDeviceAttributeMultiprocessorCount, dev);
        (void)hipFuncSetAttribute((const void*)fwd_megakernel, hipFuncAttributeMaxDynamicSharedMemorySize, LDS_BYTES);
        (void)hipOccupancyMaxActiveBlocksPerMultiprocessor(&per_cu, (const void*)fwd_megakernel, 512, LDS_BYTES);
        if (per_cu < 1) { fprintf(stderr, "occupancy query says %d blocks per CU\n", per_cu); per_cu = 1; }
        if (per_cu > 1) per_cu = 1;
        grid_blocks = cus * per_cu;
        if (grid_blocks > 256) grid_blocks = 256;
        if (grid_blocks < 256) { fprintf(stderr, "this kernel is built for a 256-CU device (resident capacity reported: %d workgroups); nothing launched\n", grid_blocks); grid_blocks = -1; }
        if (ws_size < WS_END) fprintf(stderr, "workspace too small: %zu < %zu\n", ws_size, (size_t)WS_END);
    }
    if (grid_blocks < 0) return;
    if (N_LAUNCHES == 1) (void)hipMemsetAsync((unsigned char*)d_ws + WS_BAR, 0, XCD_BAR_WORDS * 4, stream);
    Params p{};
    const float** pp = (const float**)&p;
    for (int i = 0; i < 22; ++i) pp[i] = (const float*)d_in[i];
    p.out = (float*)d_out; p.ws = (unsigned char*)d_ws;
    for (int li = 0; li < N_LAUNCHES; ++li) {
        p.ph_lo = (N_LAUNCHES == 1) ? 0 : li; p.ph_hi = (N_LAUNCHES == 1) ? NPHASE : li + 1;
        void* args[] = {&p};
        hipError_t e = hipLaunchCooperativeKernel((const void*)fwd_megakernel, dim3(grid_blocks), dim3(512), args, LDS_BYTES, stream);
        if (e != hipSuccess) fprintf(stderr, "cooperative launch failed: %s (grid %d)\n", hipGetErrorString(e), grid_blocks);
    }
}
```

```cpp
#include <hip/hip_runtime.h>
#include <cstdio>

#define PROBE_MASK 0
#define LAS __attribute__((address_space(3)))
typedef unsigned short bf16_t;
typedef short bf16x8 __attribute__((ext_vector_type(8)));
typedef float f32x4 __attribute__((ext_vector_type(4)));
typedef unsigned u32x4 __attribute__((ext_vector_type(4)));
typedef unsigned u32x2 __attribute__((ext_vector_type(2)));

constexpr int TPR = 16384, TSM = 128, TT = 16512, TPAD = 16640;
constexpr int NIN = 5632, DINP = 5648, XBC = 1536, DFF = 2816;
constexpr float EPS = 1e-5f;
constexpr int LDS_BYTES = 131072 + 16 + 4096;
constexpr int LDS_XCH = 131072 + 16;

constexpr size_t WS_WIN = 0;
constexpr size_t WS_WOUT = WS_WIN + (size_t)NIN * 1024 * 2;
constexpr size_t WS_WFFN = WS_WOUT + (size_t)1024 * 2048 * 2;
constexpr size_t WS_WDOWN = WS_WFFN + (size_t)NIN * 1024 * 2;
constexpr size_t WS_A1 = WS_WDOWN + (size_t)1024 * 2816 * 2;
constexpr size_t WS_DT = WS_A1 + (size_t)TPAD * 1024 * 2;
constexpr size_t WS_ACUM = WS_DT + (size_t)8 * 16 * 2048 * 4;
constexpr size_t WS_DTS = WS_ACUM + (size_t)8 * 16 * 2048 * 4;
constexpr size_t WS_RSTD = WS_DTS + (size_t)128 * 16 * 4;
constexpr size_t WS_BIG = WS_RSTD + (size_t)TPAD * 4;
constexpr size_t WS_XBC = WS_BIG;
constexpr size_t WS_MIX = WS_XBC + (size_t)TPAD * 1536 * 2;
constexpr size_t WS_UP = WS_BIG;
constexpr size_t WS_BAR = WS_MIX + (size_t)TPAD * 2048 * 2;
constexpr size_t WS_SLAB = WS_BAR + 16384;
constexpr size_t WS_SBGF = WS_SLAB + (size_t)11 * 128 * 1024 * 4;
constexpr size_t WS_SBGL = WS_SBGF + (size_t)65 * 2 * 2816 * 4;
constexpr size_t WS_SBUF = WS_SBGL + (size_t)65 * 2 * 2816 * 4;
constexpr size_t WS_SCUF = WS_SBUF + (size_t)65 * 2 * 2816 * 4;
constexpr size_t WS_SCUL = WS_SCUF + (size_t)65 * 2 * 1024 * 4;
constexpr size_t WS_SCGF = WS_SCUL + (size_t)65 * 2 * 1024 * 4;
constexpr size_t WS_X1B = WS_SCGF + (size_t)65 * 2 * 1024 * 4;
constexpr size_t WS_GRS = WS_X1B + (size_t)TPAD * 1024 * 2;
constexpr size_t WS_END = WS_GRS + (size_t)TPR * 2 * 4;
constexpr size_t OS_BN = 0;
constexpr size_t OS_BT = OS_BN + (size_t)8 * 2 * 2048 * 128 * 2;
constexpr size_t OS_CN = OS_BT + (size_t)8 * 2 * 2048 * 128 * 2;
constexpr size_t OS_ST = OS_CN + (size_t)8 * 2 * 2048 * 128 * 2;
constexpr size_t O_YS = 16777216, O_PSSM = 16908288, O_PSSDC = 17956864, O_PSC = 17993728, O_PFFN = 18010112;
constexpr size_t O_SSSM = 18055168, O_SSSDC = 34832384, O_SSC = 35422208, O_SFFN = 35684352;

typedef float f32x2_t __attribute__((ext_vector_type(2)));
typedef __bf16 bf16x2_t __attribute__((ext_vector_type(2)));
__device__ __forceinline__ unsigned cvt_pk_bf16(float lo, float hi) { const f32x2_t v = {lo, hi}; return __builtin_bit_cast(unsigned, __builtin_convertvector(v, bf16x2_t)); }
__device__ __forceinline__ float bf_lo(unsigned u) { return __uint_as_float(u << 16); }
__device__ __forceinline__ float bf_hi(unsigned u) { return __uint_as_float(u & 0xffff0000u); }
__device__ __forceinline__ bf16_t f2bf(float f) { return (bf16_t)(cvt_pk_bf16(f, 0.f) & 0xffffu); }
__device__ __forceinline__ float bf2f(bf16_t b) { return __uint_as_float(((unsigned)b) << 16); }
__device__ __forceinline__ float silu_f(float v) { return v * __builtin_amdgcn_rcpf(1.0f + __expf(-v)); }
__device__ __forceinline__ float softplus_f(float v) { return v > 20.f ? v : log1pf(__expf(v)); }
__device__ __forceinline__ void unpack8(const u32x4 u, float (&f)[8]) { f[0] = bf_lo(u.x); f[1] = bf_hi(u.x); f[2] = bf_lo(u.y); f[3] = bf_hi(u.y); f[4] = bf_lo(u.z); f[5] = bf_hi(u.z); f[6] = bf_lo(u.w); f[7] = bf_hi(u.w); }
__device__ __forceinline__ u32x4 pack8(const float (&f)[8]) { u32x4 u; u.x = cvt_pk_bf16(f[0], f[1]); u.y = cvt_pk_bf16(f[2], f[3]); u.z = cvt_pk_bf16(f[4], f[5]); u.w = cvt_pk_bf16(f[6], f[7]); return u; }
__device__ __forceinline__ void ld8f(const float* p, float (&f)[8]) { const f32x4 a = *(const f32x4*)p, b = *(const f32x4*)(p + 4); f[0] = a[0]; f[1] = a[1]; f[2] = a[2]; f[3] = a[3]; f[4] = b[0]; f[5] = b[1]; f[6] = b[2]; f[7] = b[3]; }
__device__ __forceinline__ void st8f(float* p, const float (&f)[8]) { *(f32x4*)p = (f32x4){f[0], f[1], f[2], f[3]}; *(f32x4*)(p + 4) = (f32x4){f[4], f[5], f[6], f[7]}; }


#define XB_TMO      128
#define XB_XCNT(j)  (256  + 64 * (j))
#define XB_XSUB(j)  (1280 + 64 * (j))
#define XB_XGEN(j)  (2304 + 64 * (j))
#define XB_TOP      3328
#define XB_TOPGEN   3392
#define XCD_BAR_WORDS 3456
#define XB_SPIN_CAP (1u << 18)
__device__ __forceinline__ unsigned xb_ld(unsigned* p)              { return __hip_atomic_load(p, __ATOMIC_RELAXED, __HIP_MEMORY_SCOPE_AGENT); }
__device__ __forceinline__ unsigned xb_add(unsigned* p, unsigned v) { return __hip_atomic_fetch_add(p, v, __ATOMIC_RELAXED, __HIP_MEMORY_SCOPE_AGENT); }
__device__ __forceinline__ unsigned xb_xcc_id() { return (unsigned)__builtin_amdgcn_s_getreg((3 << 11) | 20) & 0xFu; }
#define XB_SPIN(cond, bar) do { unsigned _sp = 0; while (cond) { __builtin_amdgcn_s_sleep(1); \
    if ((++_sp & 255u) == 0u) { if (xb_ld(&(bar)[XB_TMO])) break; if (_sp > XB_SPIN_CAP) { atomicAdd(&(bar)[XB_TMO], 1u); break; } } } } while (0)
struct XcdBarrier { unsigned* bar; unsigned x; volatile LAS unsigned* st; };
__device__ __forceinline__ XcdBarrier xcd_barrier_post(unsigned* bar, volatile LAS unsigned* st) {
    XcdBarrier b; b.bar = bar; b.x = xb_xcc_id(); b.st = st;
    if (threadIdx.x == 0) (void)xb_add(&bar[XB_XCNT(b.x)], 1u);
    return b;
}
__device__ __forceinline__ void xcd_barrier_complete(unsigned* bar, unsigned x, unsigned& nloc, unsigned& nx) {
    const unsigned G = gridDim.x * gridDim.y * gridDim.z;
    unsigned sum, cnt, mine, sp = 0u;
    for (;;) {
        sum = 0u; cnt = 0u; mine = 0u;
#pragma unroll
        for (unsigned j = 0; j < 16; ++j) { const unsigned c = xb_ld(&bar[XB_XCNT(j)]); sum += c; cnt += (c > 0u) ? 1u : 0u; mine = (j == x) ? c : mine; }
        if (sum == G) break;
        __builtin_amdgcn_s_sleep(1);
        if ((++sp & 255u) == 0u) { if (xb_ld(&bar[XB_TMO])) break; if (sp > XB_SPIN_CAP) { atomicAdd(&bar[XB_TMO], 1u); break; } }
    }
    nloc = mine > 0u ? mine : 1u; nx = cnt > 0u ? cnt : 1u;
}
__device__ __forceinline__ void xcd_barrier(const XcdBarrier& b) {
    asm volatile("s_waitcnt vmcnt(0)" ::: "memory");
    __syncthreads();
    if (threadIdx.x == 0) {
        unsigned* bar = b.bar;
        __builtin_amdgcn_s_waitcnt(0);
        unsigned nloc = b.st[0], nx = b.st[1];
        if (nloc == 0u) { xcd_barrier_complete(bar, b.x, nloc, nx); b.st[0] = nloc; b.st[1] = nx; }
        const unsigned old = xb_add(&bar[XB_XSUB(b.x)], 1u);
        const unsigned gen = old / nloc;
        if (old + 1u == (gen + 1u) * nloc) {
            __builtin_amdgcn_fence(__ATOMIC_RELEASE, "agent");
            asm volatile("s_waitcnt vmcnt(0)" ::: "memory");
            const unsigned og = xb_add(&bar[XB_TOP], 1u);
            const unsigned tg = og / nx;
            if (og + 1u == (tg + 1u) * nx) xb_add(&bar[XB_TOPGEN], 1u);
            else XB_SPIN(xb_ld(&bar[XB_TOPGEN]) == tg, bar);
            __builtin_amdgcn_fence(__ATOMIC_ACQUIRE, "agent");
            xb_add(&bar[XB_XGEN(b.x)], 1u);
            asm volatile("s_waitcnt vmcnt(0)" ::: "memory");
        } else {
            XB_SPIN(xb_ld(&bar[XB_XGEN(b.x)]) == gen, bar);
            __builtin_amdgcn_fence(__ATOMIC_ACQUIRE, "agent");
            asm volatile("s_waitcnt vmcnt(0)" ::: "memory");
        }
    }
    __syncthreads();
}

namespace pg8 {
constexpr int BM = 256, BK = 64, HALF = 128, HTB = HALF * BK * 2, NXCD = 8, WGM = 8;
__device__ __forceinline__ int lds_byte(int r, int c) { const int st = (r >> 4) * 2 + (c >> 5), rr = r & 15, cc = c & 31, ob = rr * 64 + cc * 2; return st * 1024 + (ob ^ (((ob >> 9) & 1) << 5)); }
__device__ __forceinline__ void stage_rc(int b, int& R, int& C) { const int st = b / 1024, sb = b % 1024, swz = sb ^ (((sb >> 9) & 1) << 5); R = (st >> 1) * 16 + swz / 64; C = (st & 1) * 32 + (swz % 64) / 2; }
__device__ __forceinline__ int perm32(int rho) { const int n = rho >> 4, i = rho & 15; return 8 * (i >> 2) + 4 * n + (i & 3); }
struct Unit { int pm, pn, ko; };
struct Gemm { const bf16_t* A; const bf16_t* Bt; int M, N, K, lda, ldb; };
struct StaticOrder {
    int nM, nN, nwg, G, c;
    __device__ void init(int M, int N, int G_, int c_) { nM = M / BM; nN = N / BM; nwg = nM * nN; G = G_; c = c_; }
    __device__ bool next(int i, Unit& u) const {
        const long L = (long)i * G + c; if (L >= nwg) return false;
        int wgid = (int)L; { const int q = nwg / NXCD, r = nwg % NXCD, xcd = wgid % NXCD, off = wgid / NXCD; wgid = (xcd < r ? xcd * (q + 1) : r * (q + 1) + (xcd - r) * q) + off; }
        const int nig = WGM * nN, gid = wgid / nig, fm = gid * WGM, gsz = (nM - fm) < WGM ? (nM - fm) : WGM;
        u.pm = fm + ((wgid % nig) % gsz); u.pn = (wgid % nig) / gsz; u.ko = 0; return true;
    }
};
struct SplitOrder {
    int nu, c, K;
    __device__ bool next(int i, Unit& u) const { if (i != 0 || c >= nu) return false; u.pm = 0; u.pn = c & 3; u.ko = (c >> 2) * K; return true; }
};
template <class Epi, class Sched, bool SCALE = false>
__device__ __forceinline__ void gemm_phase(LAS unsigned char* lds, const Gemm g, const Sched& S, const Epi& E, const LAS float* sctab = nullptr) {
    const int tid = threadIdx.x, wid = __builtin_amdgcn_readfirstlane(tid >> 6), lane = tid & 63, wr = wid >> 2, wc = wid & 3, fr = lane & 15, fq = lane >> 4;
    const int K = g.K, nt = K / BK;
    unsigned voffA[2], voffB[2];
#pragma unroll
    for (int i = 0; i < 2; ++i) { int R, C; stage_rc(tid * 16 + i * 8192, R, C); const int Rb = Epi::PERM ? ((R & ~31) + perm32(R & 31)) : R;
        voffA[i] = (unsigned)(R * g.lda + C) * 2u; voffB[i] = (unsigned)(Rb * g.ldb + C) * 2u; }
    const size_t kstep = (size_t)(BK * 2);
    const size_t hstepA = (size_t)HALF * g.lda * 2, hstepB = (size_t)HALF * g.ldb * 2;
    const size_t tstepA = 2 * hstepA, tstepB = 2 * hstepB;
    const unsigned ldsw = (unsigned)wid * 1024u;
    const int aoff = lds_byte(wr * 64 + fr, fq * 8), boff = lds_byte(wc * 32 + fr, fq * 8);
#define PG8_SA(b, h) (((b) * 2 + (h)) * HTB)
#define PG8_SB(b, h) ((4 + (b) * 2 + (h)) * HTB)
#define PG8_STAGE(bufoff, gbase, voff) do { _Pragma("unroll") for (int _i = 0; _i < 2; ++_i) \
        __builtin_amdgcn_global_load_lds((const unsigned*)((const char*)(gbase) + (voff)[_i]), (LAS unsigned*)(lds + (bufoff) + ldsw + _i * 8192), 16, 0, 0); } while (0)
#define PG8_LDA(dst, b, h) do { _Pragma("unroll") for (int m = 0; m < 4; ++m) _Pragma("unroll") for (int k = 0; k < 2; ++k) dst[m][k] = *(const LAS bf16x8*)(lds + PG8_SA(b, h) + aoff + m * 2048 + k * 1024); } while (0)
#define PG8_LDB(dst, b, h) do { _Pragma("unroll") for (int n = 0; n < 2; ++n) _Pragma("unroll") for (int k = 0; k < 2; ++k) dst[n][k] = *(const LAS bf16x8*)(lds + PG8_SB(b, h) + boff + n * 2048 + k * 1024); } while (0)
#define PG8_MMA(ai, bj, At, Bt) do { __builtin_amdgcn_s_setprio(1); _Pragma("unroll") for (int m = 0; m < 4; ++m) _Pragma("unroll") for (int n = 0; n < 2; ++n) _Pragma("unroll") for (int k = 0; k < 2; ++k) \
        acc[ai][bj][m][n] = __builtin_amdgcn_mfma_f32_16x16x32_bf16(Bt[n][k], At[m][k], acc[ai][bj][m][n], 0, 0, 0); __builtin_amdgcn_s_setprio(0); } while (0)
#define PG8_WAIT_V(n) asm volatile("s_waitcnt vmcnt(" #n ")" ::: "memory")
#define PG8_WAIT_L(n) asm volatile("s_waitcnt lgkmcnt(" #n ")" ::: "memory")
#define PG8_BAR __builtin_amdgcn_s_barrier()
#define PG8_SCHED __builtin_amdgcn_sched_barrier(0)
    Unit cur, nxt; int ui = 0;
    if (!S.next(0, cur)) return;
    f32x4 acc[2][2][4][2];
#pragma unroll
    for (int a = 0; a < 2; ++a)
#pragma unroll
        for (int b = 0; b < 2; ++b)
#pragma unroll
            for (int m = 0; m < 4; ++m)
#pragma unroll
                for (int n = 0; n < 2; ++n) acc[a][b][m][n] = (f32x4){0.f, 0.f, 0.f, 0.f};
    bf16x8 At[4][2], B0[2][2], B1[2][2];
    const char* cA = (const char*)g.A + (size_t)cur.pm * tstepA + (size_t)cur.ko * 2; const char* cB = (const char*)g.Bt + (size_t)cur.pn * tstepB + (size_t)cur.ko * 2;
    PG8_STAGE(PG8_SB(0, 0), cB, voffB); PG8_STAGE(PG8_SA(0, 0), cA, voffA); PG8_STAGE(PG8_SB(0, 1), cB + hstepB, voffB); PG8_STAGE(PG8_SA(0, 1), cA + hstepA, voffA);
    if (wr == 1) PG8_BAR;
    PG8_WAIT_V(4); PG8_BAR;
    PG8_STAGE(PG8_SB(1, 0), cB + kstep, voffB); PG8_STAGE(PG8_SA(1, 0), cA + kstep, voffA); PG8_STAGE(PG8_SB(1, 1), cB + hstepB + kstep, voffB);
    PG8_WAIT_V(6); PG8_BAR;
    for (;;) {
        const bool has_next = S.next(ui + 1, nxt);
        const char* nA = has_next ? (const char*)g.A + (size_t)nxt.pm * tstepA + (size_t)nxt.ko * 2 : cA; const char* nB = has_next ? (const char*)g.Bt + (size_t)nxt.pn * tstepB + (size_t)nxt.ko * 2 : cB;
        for (int t = 0; t < nt; t += 2) {
            const bool last = (t == nt - 2);
            const char* a1 = cA + (size_t)(t + 1) * kstep;
            const char* a2 = last ? nA : cA + (size_t)(t + 2) * kstep; const char* b2 = last ? nB : cB + (size_t)(t + 2) * kstep;
            const char* a3 = a2 + kstep; const char* b3 = b2 + kstep;
            if (SCALE && (t == 8 || t == 16)) {
                const LAS float* tb = sctab + (t == 8 ? 0 : 256) + wr * 64 + fr;
#pragma unroll
                for (int ai = 0; ai < 2; ++ai)
#pragma unroll
                    for (int m = 0; m < 4; ++m) { const float sv = tb[ai * 128 + m * 16];
#pragma unroll
                        for (int bj = 0; bj < 2; ++bj)
#pragma unroll
                            for (int n = 0; n < 2; ++n) acc[ai][bj][m][n] *= sv; }
                PG8_WAIT_L(0); PG8_SCHED;
            }
            PG8_LDB(B0, 0, 0); PG8_SCHED; PG8_LDA(At, 0, 0); PG8_STAGE(PG8_SA(1, 1), a1 + hstepA, voffA);
            PG8_WAIT_L(8); PG8_BAR; PG8_WAIT_L(0); PG8_MMA(0, 0, At, B0); PG8_BAR; PG8_SCHED;
            PG8_LDB(B1, 0, 1); PG8_STAGE(PG8_SB(0, 0), b2, voffB);
            PG8_BAR; PG8_WAIT_L(0); PG8_MMA(0, 1, At, B1); PG8_BAR;
            PG8_LDA(At, 0, 1); PG8_STAGE(PG8_SA(0, 0), a2, voffA);
            PG8_BAR; PG8_WAIT_L(0); PG8_MMA(1, 0, At, B0); PG8_BAR; PG8_SCHED;
            PG8_STAGE(PG8_SB(0, 1), b2 + hstepB, voffB);
            PG8_WAIT_V(6); PG8_BAR; PG8_MMA(1, 1, At, B1); PG8_BAR;
            PG8_LDB(B0, 1, 0); PG8_SCHED; PG8_LDA(At, 1, 0); PG8_STAGE(PG8_SA(0, 1), a2 + hstepA, voffA);
            PG8_WAIT_L(8); PG8_BAR; PG8_WAIT_L(0); PG8_MMA(0, 0, At, B0); PG8_BAR; PG8_SCHED;
            PG8_LDB(B1, 1, 1); PG8_STAGE(PG8_SB(1, 0), b3, voffB);
            PG8_BAR; PG8_WAIT_L(0); PG8_MMA(0, 1, At, B1); PG8_BAR;
            PG8_LDA(At, 1, 1); PG8_STAGE(PG8_SA(1, 0), a3, voffA);
            PG8_BAR; PG8_WAIT_L(0); PG8_MMA(1, 0, At, B0); PG8_BAR; PG8_SCHED;
            PG8_STAGE(PG8_SB(1, 1), b3 + hstepB, voffB);
            PG8_WAIT_V(6); PG8_BAR; PG8_MMA(1, 1, At, B1); PG8_BAR;
        }
        E(acc, cur, wr, wc, fr, fq);
        if (!has_next) break;
#pragma unroll
        for (int a = 0; a < 2; ++a)
#pragma unroll
            for (int b = 0; b < 2; ++b)
#pragma unroll
                for (int m = 0; m < 4; ++m)
#pragma unroll
                    for (int n = 0; n < 2; ++n) acc[a][b][m][n] = (f32x4){0.f, 0.f, 0.f, 0.f};
        cur = nxt; cA = nA; cB = nB; ++ui;
    }
    PG8_WAIT_V(0);
    if (wr == 0) PG8_BAR;
    PG8_BAR;
#undef PG8_SA
#undef PG8_SB
#undef PG8_STAGE
#undef PG8_LDA
#undef PG8_LDB
#undef PG8_MMA
#undef PG8_WAIT_V
#undef PG8_WAIT_L
#undef PG8_BAR
#undef PG8_SCHED
}
}

__device__ __forceinline__ float dpp_ror1(float v) { return __builtin_bit_cast(float, __builtin_amdgcn_update_dpp(0, __builtin_bit_cast(int, v), 0x121, 0xF, 0xF, true)); }
__device__ __forceinline__ float dpp_ror2(float v) { return __builtin_bit_cast(float, __builtin_amdgcn_update_dpp(0, __builtin_bit_cast(int, v), 0x122, 0xF, 0xF, true)); }
struct EpiIn {
    static constexpr bool PERM = true;
    bf16_t* mix; bf16_t* xbc; const float* rstd; float* uf; float* ul; float* gbf; const float* cw; const float* st; float* sout; LAS float* xch;
    __device__ __forceinline__ void operator()(const f32x4 (&acc)[2][2][4][2], const pg8::Unit& u, int wr, int wc, int fr_, int fq_) const {
        int fr = fr_, fq = fq_; asm volatile("" : "+v"(fr), "+v"(fq));
        const int row0 = u.pm * 256 + wr * 64 + fr;
        float rs[2][4];
#pragma unroll
        for (int ai = 0; ai < 2; ++ai)
#pragma unroll
            for (int m = 0; m < 4; ++m) rs[ai][m] = rstd[row0 + ai * 128 + m * 16];
        if (u.pn >= 16) {
            bf16_t* base = xbc + (u.pn - 16) * 256 + wc * 32 + 8 * fq;
#pragma unroll
            for (int ai = 0; ai < 2; ++ai)
#pragma unroll
                for (int m = 0; m < 4; ++m) { bf16_t* rp = base + (size_t)(row0 + ai * 128 + m * 16) * XBC;
#pragma unroll
                    for (int bj = 0; bj < 2; ++bj) { const f32x4 v0 = acc[ai][bj][m][0] * rs[ai][m], v1 = acc[ai][bj][m][1] * rs[ai][m];
                        u32x4 w; w.x = cvt_pk_bf16(v0[0], v0[1]); w.y = cvt_pk_bf16(v0[2], v0[3]); w.z = cvt_pk_bf16(v1[0], v1[1]); w.w = cvt_pk_bf16(v1[2], v1[3]);
                        *(u32x4*)(rp + bj * 128) = w; } }
            return;
        }
        const int cl = wc * 16 + 4 * fq, jj = u.pn * 64 + cl;
        const f32x4 w0 = *(const f32x4*)(cw + jj), w1 = *(const f32x4*)(cw + 1024 + jj), w2 = *(const f32x4*)(cw + 2048 + jj);
        if (u.pm == 64) {
#pragma unroll
            for (int m = 0; m < 4; ++m) { const int bs = wr * 64 + m * 16 + fr; const float r = rs[0][m];
                const f32x4 s0 = *(const f32x4*)(st + (size_t)(bs * 2) * 1024 + jj), s1 = *(const f32x4*)(st + (size_t)(bs * 2 + 1) * 1024 + jj);
                const f32x4 gb = acc[0][0][m][0] * r, uu = acc[0][0][m][1] * acc[0][1][m][0] * (r * r), zz = acc[0][1][m][1] * r;
                const f32x4 ys = gb * (s0 * w0 + s1 * w1 + uu * w2);
                *(f32x4*)(sout + (size_t)(bs * 2) * 1024 + jj) = s1; *(f32x4*)(sout + (size_t)(bs * 2 + 1) * 1024 + jj) = uu;
                bf16_t* rp = mix + (size_t)(TPR + bs) * 2048 + jj;
                u32x2 oz, oy; oz.x = cvt_pk_bf16(zz[0], zz[1]); oz.y = cvt_pk_bf16(zz[2], zz[3]); oy.x = cvt_pk_bf16(ys[0], ys[1]); oy.y = cvt_pk_bf16(ys[2], ys[3]);
                *(u32x2*)rp = oz; *(u32x2*)(rp + 1024) = oy; }
            return;
        }
        if (fr >= 14) {
#pragma unroll
            for (int ai = 0; ai < 2; ++ai) { const float r = rs[ai][3]; *(LAS f32x4*)(xch + ((2 * ai + wr) * 2 + (fr - 14)) * 64 + cl) = acc[ai][0][3][1] * acc[ai][1][3][0] * (r * r); }
            if (wr == 1) { const float r = rs[1][3]; *(f32x4*)(ul + (size_t)(u.pm * 2 + (fr - 14)) * 1024 + jj) = acc[1][0][3][1] * acc[1][1][3][0] * (r * r); }
        }
        if (fr < 2 && wr == 0) { const float r = rs[0][0];
            *(f32x4*)(uf + (size_t)(u.pm * 2 + fr) * 1024 + jj) = acc[0][0][0][1] * acc[0][1][0][0] * (r * r); *(f32x4*)(gbf + (size_t)(u.pm * 2 + fr) * 1024 + jj) = acc[0][0][0][0] * r; }
        asm volatile("s_waitcnt lgkmcnt(0)" ::: "memory"); __builtin_amdgcn_s_barrier(); __builtin_amdgcn_s_barrier(); asm volatile("" ::: "memory");
        const bool f1 = fr >= 1, f2 = fr >= 2;
        bf16_t* mrow = mix + (size_t)row0 * 2048 + jj;
#pragma unroll
        for (int ai = 0; ai < 2; ++ai) {
            const int k = 2 * ai + wr;
            f32x4 p1, p2;
            if (k > 0) { const f32x4 X0 = *(const LAS f32x4*)(xch + ((k - 1) * 2 + 0) * 64 + cl), X1 = *(const LAS f32x4*)(xch + ((k - 1) * 2 + 1) * 64 + cl);
                p1 = X1;
#pragma unroll
                for (int e = 0; e < 4; ++e) p2[e] = fr == 1 ? X1[e] : X0[e]; }
            else { p1 = (f32x4){0.f, 0.f, 0.f, 0.f}; p2 = p1; }
#pragma unroll
            for (int m = 0; m < 4; ++m) { const float r = rs[ai][m];
                const f32x4 gb = acc[ai][0][m][0] * r, uu = acc[ai][0][m][1] * acc[ai][1][m][0] * (r * r), zz = acc[ai][1][m][1] * r;
                float ys[4];
#pragma unroll
                for (int e = 0; e < 4; ++e) { const float r1 = dpp_ror1(uu[e]), r2 = dpp_ror2(uu[e]);
                    const float um1 = f1 ? r1 : p1[e], um2 = f2 ? r2 : p2[e];
                    ys[e] = gb[e] * (um2 * w0[e] + um1 * w1[e] + uu[e] * w2[e]);
                    p1[e] = r1; p2[e] = r2; }
                u32x2 oz, oy; oz.x = cvt_pk_bf16(zz[0], zz[1]); oz.y = cvt_pk_bf16(zz[2], zz[3]); oy.x = cvt_pk_bf16(ys[0], ys[1]); oy.y = cvt_pk_bf16(ys[2], ys[3]);
                bf16_t* rp = mrow + (size_t)(ai * 128 + m * 16) * 2048;
                *(u32x2*)rp = oz; *(u32x2*)(rp + 1024) = oy; }
            asm volatile("" ::: "memory");
        }
    }
};
struct EpiFfnAct {
    static constexpr bool PERM = true;
    bf16_t* act; float* gfirst; float* glast; float* ufirst; const float* cw; const float* cb; const float* st; float* sout; LAS float* xch;
    __device__ __forceinline__ void operator()(const f32x4 (&acc)[2][2][4][2], const pg8::Unit& u, int wr, int wc, int fr_, int fq_) const {
        int fr = fr_, fq = fq_; asm volatile("" : "+v"(fr), "+v"(fq));
        const int cl = wc * 32 + 8 * fq, cg = u.pn * 128 + cl;
        if (u.pm == 64) {
#pragma unroll
            for (int n = 0; n < 2; ++n) { const f32x4 w0 = *(const f32x4*)(cw + cg + 4 * n), w1 = *(const f32x4*)(cw + DFF + cg + 4 * n), w2 = *(const f32x4*)(cw + 2 * DFF + cg + 4 * n), bb = *(const f32x4*)(cb + cg + 4 * n);
#pragma unroll
                for (int m = 0; m < 4; ++m) { const int bs = wr * 64 + m * 16 + fr;
                    const f32x4 s0 = *(const f32x4*)(st + (size_t)(bs * 2) * DFF + cg + 4 * n), s1 = *(const f32x4*)(st + (size_t)(bs * 2 + 1) * DFF + cg + 4 * n);
                    const f32x4 g = acc[0][0][m][n], up = acc[0][1][m][n]; const f32x4 cv = s0 * w0 + s1 * w1 + g * w2 + bb;
                    u32x2 o; o.x = cvt_pk_bf16(silu_f(cv[0]) * up[0], silu_f(cv[1]) * up[1]); o.y = cvt_pk_bf16(silu_f(cv[2]) * up[2], silu_f(cv[3]) * up[3]);
                    *(f32x4*)(sout + (size_t)(bs * 2) * DFF + cg + 4 * n) = s1; *(f32x4*)(sout + (size_t)(bs * 2 + 1) * DFF + cg + 4 * n) = g;
                    *(u32x2*)(act + (size_t)(TPR + bs) * DFF + cg + 4 * n) = o; } }
            return;
        }
        if (fr >= 14) {
#pragma unroll
            for (int ai = 0; ai < 2; ++ai)
#pragma unroll
                for (int n = 0; n < 2; ++n) *(LAS f32x4*)(xch + ((2 * ai + wr) * 2 + (fr - 14)) * 128 + cl + 4 * n) = acc[ai][0][3][n];
            if (wr == 1) {
#pragma unroll
                for (int n = 0; n < 2; ++n) *(f32x4*)(glast + (size_t)(u.pm * 2 + (fr - 14)) * DFF + cg + 4 * n) = acc[1][0][3][n]; }
        }
        if (fr < 2 && wr == 0) {
#pragma unroll
            for (int n = 0; n < 2; ++n) { *(f32x4*)(gfirst + (size_t)(u.pm * 2 + fr) * DFF + cg + 4 * n) = acc[0][0][0][n]; *(f32x4*)(ufirst + (size_t)(u.pm * 2 + fr) * DFF + cg + 4 * n) = acc[0][1][0][n]; }
        }
        f32x4 w0[2], w1[2], w2[2], bb[2];
#pragma unroll
        for (int n = 0; n < 2; ++n) { w0[n] = *(const f32x4*)(cw + cg + 4 * n); w1[n] = *(const f32x4*)(cw + DFF + cg + 4 * n); w2[n] = *(const f32x4*)(cw + 2 * DFF + cg + 4 * n); bb[n] = *(const f32x4*)(cb + cg + 4 * n); }
        asm volatile("s_waitcnt lgkmcnt(0)" ::: "memory"); __builtin_amdgcn_s_barrier(); __builtin_amdgcn_s_barrier(); asm volatile("" ::: "memory");
        const bool f1 = fr >= 1, f2 = fr >= 2;
        bf16_t* arow = act + (size_t)(u.pm * 256 + wr * 64 + fr) * DFF + cg;
#pragma unroll
        for (int ai = 0; ai < 2; ++ai) {
            const int k = 2 * ai + wr;
            u32x2 o0[4];
#pragma unroll
            for (int n = 0; n < 2; ++n) {
                f32x4 p1, p2;
                if (k > 0) { const f32x4 X0 = *(const LAS f32x4*)(xch + ((k - 1) * 2 + 0) * 128 + cl + 4 * n), X1 = *(const LAS f32x4*)(xch + ((k - 1) * 2 + 1) * 128 + cl + 4 * n);
                    p1 = X1;
#pragma unroll
                    for (int e = 0; e < 4; ++e) p2[e] = fr == 1 ? X1[e] : X0[e]; }
                else { p1 = (f32x4){0.f, 0.f, 0.f, 0.f}; p2 = p1; }
#pragma unroll
                for (int m = 0; m < 4; ++m) { const f32x4 g = acc[ai][0][m][n], up = acc[ai][1][m][n]; float a[4];
#pragma unroll
                    for (int e = 0; e < 4; ++e) { const float r1 = dpp_ror1(g[e]), r2 = dpp_ror2(g[e]);
                        const float gm1 = f1 ? r1 : p1[e], gm2 = f2 ? r2 : p2[e];
                        a[e] = silu_f(gm2 * w0[n][e] + gm1 * w1[n][e] + g[e] * w2[n][e] + bb[n][e]) * up[e];
                        p1[e] = r1; p2[e] = r2; }
                    u32x2 o; o.x = cvt_pk_bf16(a[0], a[1]); o.y = cvt_pk_bf16(a[2], a[3]);
                    if (n == 0) o0[m] = o;
                    else { u32x4 w; w.x = o0[m].x; w.y = o0[m].y; w.z = o.x; w.w = o.y; *(u32x4*)(arow + (size_t)(ai * 128 + m * 16) * DFF) = w; } }
            }
            asm volatile("" ::: "memory");
        }
    }
};
struct EpiRes {
    static constexpr bool PERM = false;
    const float* bf; const bf16_t* b16; bf16_t* o16;
    __device__ __forceinline__ void operator()(const f32x4 (&acc)[2][2][4][2], const pg8::Unit& u, int wr, int wc, int fr_, int fq_) const {
        int fr = fr_, fq = fq_; asm volatile("" : "+v"(fr), "+v"(fq));
        const size_t off0 = (size_t)(u.pm * 256 + wr * 64 + fr) * 1024 + u.pn * 256 + wc * 32 + 4 * fq;
#pragma unroll
        for (int ai = 0; ai < 2; ++ai) {
            f32x4 bv[4][2][2];
            if (bf) {
#pragma unroll
                for (int m = 0; m < 4; ++m)
#pragma unroll
                    for (int bj = 0; bj < 2; ++bj)
#pragma unroll
                        for (int n = 0; n < 2; ++n) bv[m][bj][n] = *(const f32x4*)(bf + off0 + (size_t)(ai * 128 + m * 16) * 1024 + bj * 128 + n * 16);
            } else {
                u32x2 br[4][2][2];
#pragma unroll
                for (int m = 0; m < 4; ++m)
#pragma unroll
                    for (int bj = 0; bj < 2; ++bj)
#pragma unroll
                        for (int n = 0; n < 2; ++n) br[m][bj][n] = *(const u32x2*)(b16 + off0 + (size_t)(ai * 128 + m * 16) * 1024 + bj * 128 + n * 16);
#pragma unroll
                for (int m = 0; m < 4; ++m)
#pragma unroll
                    for (int bj = 0; bj < 2; ++bj)
#pragma unroll
                        for (int n = 0; n < 2; ++n) bv[m][bj][n] = (f32x4){bf_lo(br[m][bj][n].x), bf_hi(br[m][bj][n].x), bf_lo(br[m][bj][n].y), bf_hi(br[m][bj][n].y)};
            }
#pragma unroll
            for (int m = 0; m < 4; ++m)
#pragma unroll
                for (int bj = 0; bj < 2; ++bj)
#pragma unroll
                    for (int n = 0; n < 2; ++n) { const f32x4 o = bv[m][bj][n] + acc[ai][bj][m][n]; u32x2 pk; pk.x = cvt_pk_bf16(o[0], o[1]); pk.y = cvt_pk_bf16(o[2], o[3]);
                        *(u32x2*)(o16 + off0 + (size_t)(ai * 128 + m * 16) * 1024 + bj * 128 + n * 16) = pk; }
            asm volatile("" ::: "memory");
        }
    }
};
struct EpiSlab {
    static constexpr bool PERM = false;
    float* slab;
    __device__ __forceinline__ void operator()(const f32x4 (&acc)[2][2][4][2], const pg8::Unit& u, int wr, int wc, int fr, int fq) const {
        const int col0 = u.pn * 256 + wc * 32 + 4 * fq;
        float* sb = slab + (size_t)(u.ko >> 8) * (128 * 1024);
#pragma unroll
        for (int m = 0; m < 4; ++m) { float* o = sb + (size_t)(wr * 64 + m * 16 + fr) * 1024 + col0;
#pragma unroll
            for (int bj = 0; bj < 2; ++bj)
#pragma unroll
                for (int n = 0; n < 2; ++n) *(f32x4*)(o + bj * 128 + n * 16) = acc[0][bj][m][n]; }
    }
};

struct Params {
    const float* x_prompt; const float* x_sample; const float* state_ssm; const float* state_ssd_conv; const float* state_sc; const float* state_ffn;
    const float* norm_mix_w; const float* w_in; const float* ssd_conv_w; const float* ssd_conv_b; const float* dt_bias; const float* a_log; const float* ssd_d; const float* ssd_norm_w;
    const float* sc_conv_w; const float* w_out; const float* norm_ffn_w; const float* w_ffn_in; const float* ffn_conv_w; const float* ffn_conv_b; const float* w_down; const float* norm_final_w;
    float* out; unsigned char* ws; int ph_lo, ph_hi;
};

__device__ __forceinline__ int map_in4(int jd) {
    const int T = jd >> 8, L = jd & 255;
    if (T >= 16) return 1024 + (T - 16) * 256 + L;
    const int bj = L >> 7, wc = (L >> 5) & 3, fq = (L >> 3) & 3, n = (L >> 2) & 1, jj = T * 64 + wc * 16 + fq * 4;
    return (bj == 0 ? (n == 0 ? 2576 : 3600) : (n == 0 ? 4624 : 0)) + jj;
}
__device__ __forceinline__ int map_in_old(int j0) {
    if (j0 < 2560) return j0;
    if (j0 < 3584) return 2576 + (j0 - 2560);
    const int k = (j0 - 3584) >> 8, w = (j0 - 3584) & 255;
    return w < 128 ? 3600 + k * 128 + w : 4624 + k * 128 + (w - 128);
}
__device__ __forceinline__ void p0_chunk(const Params& P, LAS unsigned char* lds, int ci) {
    const int tid = threadIdx.x, lane = tid & 63, wid = tid >> 6, r16 = lane & 15, q = lane >> 4;
    LAS bf16_t* wdt = (LAS bf16_t*)lds;
    LAS float* dts = (LAS float*)(lds + 33024);
    LAS float* segs = (LAS float*)(lds + 33024 + 8192);
    LAS float* nws = (LAS float*)(lds + 33024 + 8192 + 1024);
    *(LAS float*)(nws + tid) = P.norm_mix_w[tid]; *(LAS float*)(nws + 512 + tid) = P.norm_mix_w[512 + tid];
#pragma unroll
    for (int i = 0; i < 8; ++i) { const int k = (tid >> 2) + 128 * i, c4 = (tid & 3) * 4; const f32x4 v = *(const f32x4*)(P.w_in + (size_t)k * DINP + 2560 + c4);
        wdt[(c4 + 0) * 1032 + k] = f2bf(v[0]); wdt[(c4 + 1) * 1032 + k] = f2bf(v[1]); wdt[(c4 + 2) * 1032 + k] = f2bf(v[2]); wdt[(c4 + 3) * 1032 + k] = f2bf(v[3]); }
    __syncthreads();
    const int row = ci * 128 + wid * 16 + r16;
    const float* src = (row < TPR ? P.x_prompt + (size_t)row * 1024 : P.x_sample + (size_t)(row - TPR) * 1024) + 8 * q;
    bf16_t* dst = (bf16_t*)(P.ws + WS_A1) + (size_t)row * 1024 + 8 * q;
    const LAS float* nw = nws + 8 * q;
    f32x4 acc = (f32x4){0.f, 0.f, 0.f, 0.f};
    float ss = 0.f;
    f32x4 xa[2][8], xb[2][8];
#pragma unroll
    for (int u = 0; u < 8; ++u) { xa[0][u] = __builtin_nontemporal_load((const f32x4*)(src + 32 * u)); xb[0][u] = __builtin_nontemporal_load((const f32x4*)(src + 32 * u + 4)); }
#pragma unroll
    for (int bt = 0; bt < 4; ++bt) { const int s0 = 8 * bt;
        if (bt < 3) {
#pragma unroll
            for (int u = 0; u < 8; ++u) { xa[(bt + 1) & 1][u] = __builtin_nontemporal_load((const f32x4*)(src + 32 * (s0 + 8 + u))); xb[(bt + 1) & 1][u] = __builtin_nontemporal_load((const f32x4*)(src + 32 * (s0 + 8 + u) + 4)); } }
#pragma unroll
        for (int u = 0; u < 8; ++u) { const int sidx = s0 + u; const f32x4 wa = *(const LAS f32x4*)(nw + 32 * sidx), wb = *(const LAS f32x4*)(nw + 32 * sidx + 4);
            const f32x4 a = xa[bt & 1][u], b = xb[bt & 1][u];
            ss += a[0] * a[0] + a[1] * a[1] + a[2] * a[2] + a[3] * a[3] + b[0] * b[0] + b[1] * b[1] + b[2] * b[2] + b[3] * b[3];
            const f32x4 ya = a * wa, yb = b * wb;
            u32x4 pk; pk.x = cvt_pk_bf16(ya[0], ya[1]); pk.y = cvt_pk_bf16(ya[2], ya[3]); pk.z = cvt_pk_bf16(yb[0], yb[1]); pk.w = cvt_pk_bf16(yb[2], yb[3]);
            *(u32x4*)(dst + 32 * sidx) = pk;
            const bf16x8 bfr = *(const LAS bf16x8*)(wdt + r16 * 1032 + 32 * sidx + 8 * q);
            acc = __builtin_amdgcn_mfma_f32_16x16x32_bf16(__builtin_bit_cast(bf16x8, pk), bfr, acc, 0, 0, 0); }
    }
    ss += __shfl_xor(ss, 16); ss += __shfl_xor(ss, 32);
    const float rstd = rsqrtf(ss * (1.0f / 1024.0f) + EPS);
    if (q == 0) ((float*)(P.ws + WS_RSTD))[row] = rstd;
#pragma unroll
    for (int j = 0; j < 4; ++j) acc[j] *= __shfl(rstd, 4 * q + j);
    { const float bias = P.dt_bias[r16];
#pragma unroll
      for (int j = 0; j < 4; ++j) dts[(wid * 16 + 4 * q + j) * 16 + r16] = softplus_f(acc[j] + bias); }
    __syncthreads();
    if (ci < 128) {
        const int b = ci >> 4, c = ci & 15, h = tid & 15, seg = (tid >> 4) & 15;
        float d[8], cs[8];
        if (tid < 256) { const float a = -__expf(P.a_log[h]); float run = 0.f;
#pragma unroll
            for (int i = 0; i < 8; ++i) { d[i] = dts[(seg * 8 + i) * 16 + h]; run += d[i] * a; cs[i] = run; }
            segs[seg * 16 + h] = run; }
        __syncthreads();
        if (tid < 256) { float pre = 0.f;
#pragma unroll
            for (int s2 = 0; s2 < 16; ++s2) pre += (s2 < seg) ? segs[s2 * 16 + h] : 0.f;
#pragma unroll
            for (int i = 0; i < 8; ++i) cs[i] += pre;
            const size_t o = (size_t)(b * 16 + h) * 2048 + c * 128 + seg * 8;
            st8f((float*)(P.ws + WS_DT) + o, d); st8f((float*)(P.ws + WS_ACUM) + o, cs); }
    } else {
        float* dtsg = (float*)(P.ws + WS_DTS);
        for (int i = tid; i < 2048; i += 512) dtsg[i] = dts[i];
    }
    __syncthreads();
}
__device__ __forceinline__ void tile_decode(const Params& P, int t, const float*& src, bf16_t*& dst, int& K, int& Ns, int& k0, int& n0, int& c0) {
    int kt, nt;
    if (t < 1408) { src = P.w_in; dst = (bf16_t*)(P.ws + WS_WIN); K = 1024; Ns = DINP; kt = t / 88; nt = t % 88; c0 = -1; }
    else if (t < 1920) { t -= 1408; src = P.w_out; dst = (bf16_t*)(P.ws + WS_WOUT); K = 2048; Ns = 1024; kt = t >> 4; nt = t & 15; c0 = nt * 64; }
    else if (t < 3328) { t -= 1920; src = P.w_ffn_in; dst = (bf16_t*)(P.ws + WS_WFFN); K = 1024; Ns = NIN; kt = t / 88; nt = t % 88; { const int j0 = nt * 64, k = j0 >> 8, w = j0 & 255; c0 = w < 128 ? k * 128 + w : DFF + k * 128 + (w - 128); } }
    else { t -= 3328; src = P.w_down; dst = (bf16_t*)(P.ws + WS_WDOWN); K = 2816; Ns = 1024; kt = t >> 4; nt = t & 15; c0 = nt * 64; }
    k0 = kt * 64; n0 = nt * 64;
}
__device__ __forceinline__ void conv_tiles(const Params& P, LAS unsigned char* lds, int tb, int te, int stride) {
    const int tid = threadIdx.x;
    LAS float* tl = (LAS float*)lds;
    for (int t4 = tb; t4 < te; t4 += 4 * stride) {
        f32x4 v[4][2];
#pragma unroll
        for (int u = 0; u < 4; ++u) { const int t = t4 + u * stride; if (t < te) { const float* src; bf16_t* dst; int K, Ns, k0, n0, c0; tile_decode(P, t, src, dst, K, Ns, k0, n0, c0);
            const int col = c0 < 0 ? map_in4(n0 + (tid & 15) * 4) : c0 + (tid & 15) * 4;
#pragma unroll
            for (int i = 0; i < 2; ++i) v[u][i] = *(const f32x4*)(src + (size_t)(k0 + (tid >> 4) + 32 * i) * Ns + col); } }
#pragma unroll
        for (int u = 0; u < 4; ++u) { const int t = t4 + u * stride; if (t < te) {
#pragma unroll
            for (int i = 0; i < 2; ++i) { const int kr = (tid >> 4) + 32 * i, c4 = (tid & 15) * 4; LAS float* d = tl + u * 4160 + kr * 65 + c4; d[0] = v[u][i][0]; d[1] = v[u][i][1]; d[2] = v[u][i][2]; d[3] = v[u][i][3]; } } }
        __syncthreads();
#pragma unroll
        for (int u = 0; u < 4; ++u) { const int t = t4 + u * stride; if (t < te) { const float* src; bf16_t* dst; int K, Ns, k0, n0, c0; tile_decode(P, t, src, dst, K, Ns, k0, n0, c0);
            const int n = tid >> 3, k8 = (tid & 7) * 8; float f[8];
#pragma unroll
            for (int i = 0; i < 8; ++i) f[i] = tl[u * 4160 + (k8 + i) * 65 + n];
            *(u32x4*)(dst + (size_t)(n0 + n) * K + k0 + k8) = pack8(f); } }
        __syncthreads();
    }
}
__device__ __forceinline__ void phase0(const Params& P, LAS unsigned char* lds) {
    const int G = gridDim.x, bx = blockIdx.x, NCI = 129;
    for (int ci = bx; ci < NCI; ci += G) p0_chunk(P, lds, ci);
    if (G > NCI) { if (bx >= NCI) conv_tiles(P, lds, bx - NCI, 1408, G - NCI); }
    else conv_tiles(P, lds, bx, 1408, G);
}
__device__ __forceinline__ void p1_late_tiles(const Params& P, LAS unsigned char* lds) {
    const int G = gridDim.x, bx = blockIdx.x, nwg = (TPAD / 256) * (NIN / 256), nfull = nwg % G;
    if (nfull > 0 && nfull < G) { if (bx >= nfull) conv_tiles(P, lds, 1408 + bx - nfull, 4032, G - nfull); }
    else conv_tiles(P, lds, 1408 + bx, 4032, G);
}

__device__ __forceinline__ void p2_conv_load(const Params& P, int item, u32x4 (&pre)[3]) {
    const int tid = threadIdx.x;
    const int strip = item % 24, bc = item / 24, b = bc >> 4, c = bc & 15, t0 = c * 128;
    const int colg = strip < 16 ? strip * 64 : (strip < 20 ? 1024 + (strip - 16) * 64 : 1280 + (strip - 20) * 64);
    const bf16_t* xbc = (const bf16_t*)(P.ws + WS_XBC);
#pragma unroll
    for (int k = 0; k < 3; ++k) { const int i = tid + 512 * k; pre[k] = (u32x4){0u, 0u, 0u, 0u};
        if (i < 131 * 8) { const int rr = i >> 3, c8 = (i & 7) * 8, tl = t0 - 3 + rr; if (tl >= 0) pre[k] = *(const u32x4*)(xbc + (size_t)(b * 2048 + tl) * XBC + colg + c8); } }
}
__device__ __forceinline__ void p2_conv_item(const Params& P, LAS unsigned char* lds, int item, int next_item, u32x4 (&pre)[3]) {
    const int tid = threadIdx.x;
    const int strip = item % 24, bc = item / 24, b = bc >> 4, c = bc & 15, t0 = c * 128;
    const int colg = strip < 16 ? strip * 64 : (strip < 20 ? 1024 + (strip - 16) * 64 : 1280 + (strip - 20) * 64);
    LAS bf16_t* raw = (LAS bf16_t*)lds;
    LAS bf16_t* outn = (LAS bf16_t*)(lds + 16768);
#pragma unroll
    for (int k = 0; k < 3; ++k) { const int i = tid + 512 * k; if (i < 131 * 8) *(LAS u32x4*)(raw + (i >> 3) * 64 + (i & 7) * 8) = pre[k]; }
    __syncthreads();
    if (next_item >= 0) p2_conv_load(P, next_item, pre);
    const int col = tid & 63, rg = tid >> 6;
    const float w0 = P.ssd_conv_w[colg + col], w1 = P.ssd_conv_w[XBC + colg + col], w2 = P.ssd_conv_w[2 * XBC + colg + col], w3 = P.ssd_conv_w[3 * XBC + colg + col], bs = P.ssd_conv_b[colg + col];
    float o[16];
    { float x0 = bf2f(raw[(rg * 16 + 0) * 64 + col]), x1 = bf2f(raw[(rg * 16 + 1) * 64 + col]), x2 = bf2f(raw[(rg * 16 + 2) * 64 + col]);
#pragma unroll
      for (int i = 0; i < 16; ++i) { const float x3 = bf2f(raw[(rg * 16 + i + 3) * 64 + col]); o[i] = silu_f(x0 * w0 + x1 * w1 + x2 * w2 + x3 * w3 + bs); x0 = x1; x1 = x2; x2 = x3; } }
    u32x4 pk0, pk1;
    pk0.x = cvt_pk_bf16(o[0], o[1]); pk0.y = cvt_pk_bf16(o[2], o[3]); pk0.z = cvt_pk_bf16(o[4], o[5]); pk0.w = cvt_pk_bf16(o[6], o[7]);
    pk1.x = cvt_pk_bf16(o[8], o[9]); pk1.y = cvt_pk_bf16(o[10], o[11]); pk1.z = cvt_pk_bf16(o[12], o[13]); pk1.w = cvt_pk_bf16(o[14], o[15]);
    LAS unsigned char* outT = lds + 16768 + 16384;
    if (strip < 20) { *(LAS u32x4*)(outT + col * 272 + rg * 32) = pk0; *(LAS u32x4*)(outT + col * 272 + rg * 32 + 16) = pk1; }
    if (strip >= 16) {
#pragma unroll
        for (int i = 0; i < 16; ++i) outn[(rg * 16 + i) * 64 + col] = f2bf(o[i]); }
    __syncthreads();
    if (strip < 20) {
        bf16_t* dT = strip < 16 ? (bf16_t*)(P.ws + WS_A1) + ((size_t)(b * 16 + strip) * 64) * 2048 + t0
                                : (bf16_t*)((unsigned char*)P.out + OS_BT) + ((size_t)(b * 2 + ((strip - 16) >> 1)) * 128 + ((strip - 16) & 1) * 64) * 2048 + t0;
        for (int i = tid; i < 1024; i += 512) { const int rr = i >> 4, c16 = i & 15; *(u32x4*)(dT + (size_t)rr * 2048 + c16 * 8) = *(const LAS u32x4*)(outT + rr * 272 + c16 * 16); }
    }
    if (strip >= 16) {
        const int sb = (strip - 16) & 3, g = sb >> 1, n0 = (sb & 1) * 64;
        bf16_t* nat = (bf16_t*)((unsigned char*)P.out + (strip < 20 ? OS_BN : OS_CN)) + ((size_t)(b * 2 + g) * 2048 + t0) * 128 + n0;
        for (int i = tid; i < 1024; i += 512) { const int rr = i >> 3, c8 = (i & 7) * 8; *(u32x4*)(nat + (size_t)rr * 128 + c8) = *(const LAS u32x4*)(outn + rr * 64 + c8); }
    }
    if (c == 15 && tid < 192) { const int rr = tid >> 6; P.out[O_PSSDC + (size_t)(b * 3 + rr) * XBC + colg + col] = bf2f(raw[(128 + rr) * 64 + col]); }
    __syncthreads();
}
__device__ __forceinline__ void p2_state_load(const Params& P, int item, int i0, f32x4 (&hv)[16]) {
    const int lane = threadIdx.x & 63, wid = threadIdx.x >> 6, bs = item >> 1, g = item & 1;
    const float* hin = P.state_ssm + ((size_t)(bs * 16 + g * 8 + wid) * 64 + (lane >> 5)) * 128 + 4 * (lane & 31);
#pragma unroll
    for (int i = 0; i < 16; ++i) hv[i] = __builtin_nontemporal_load((const f32x4*)(hin + (size_t)(i0 + i) * 256));
}
__device__ __forceinline__ void p2_sample_item(const Params& P, LAS unsigned char* lds, int item) {
    const int tid = threadIdx.x, lane = tid & 63, wid = tid >> 6;
    const int bs = item >> 1, g = item & 1, row = TPR + bs;
    LAS float* sx = (LAS float*)lds;
    const int half = lane >> 5, l32 = lane & 31;
    float* hout = P.out + O_SSSM + ((size_t)(bs * 16 + g * 8 + wid) * 64 + half) * 128 + 4 * l32;
    f32x4 hva[16]; p2_state_load(P, item, 0, hva);
    LAS float* ssqs = sx + 768;
    const bf16_t* xbc = (const bf16_t*)(P.ws + WS_XBC) + (size_t)row * XBC;
    bf16_t* mix = (bf16_t*)(P.ws + WS_MIX) + (size_t)row * 2048;
    for (int i = tid; i < 768; i += 512) {
        const int j = i < 512 ? g * 512 + i : (i < 640 ? 1024 + g * 128 + (i - 512) : 1280 + g * 128 + (i - 640));
        const float* st = P.state_ssd_conv + (size_t)bs * 3 * XBC + j;
        const float s0 = st[0], s1 = st[XBC], s2 = st[2 * XBC], xr = bf2f(xbc[j]);
        const float v = s0 * P.ssd_conv_w[j] + s1 * P.ssd_conv_w[XBC + j] + s2 * P.ssd_conv_w[2 * XBC + j] + xr * P.ssd_conv_w[3 * XBC + j] + P.ssd_conv_b[j];
        sx[i] = silu_f(v);
        float* so = P.out + O_SSSDC + (size_t)bs * 3 * XBC + j; so[0] = s1; so[XBC] = s2; so[2 * XBC] = xr;
    }
    __syncthreads();
    const int h = g * 8 + wid;
    const float dt = ((const float*)(P.ws + WS_DTS))[bs * 16 + h], a = -__expf(P.a_log[h]), dA = __expf(dt * a);
    const f32x4 Bv = *(const LAS f32x4*)(sx + 512 + 4 * l32), Cv = *(const LAS f32x4*)(sx + 640 + 4 * l32);
    float v[32];
#pragma unroll
    for (int i0 = 0; i0 < 32; i0 += 16) {
        f32x4 hv[16];
        if (i0 == 0) {
#pragma unroll
            for (int i = 0; i < 16; ++i) hv[i] = hva[i]; }
        else p2_state_load(P, item, 16, hv);
#pragma unroll
        for (int i = 0; i < 16; ++i) { const float xd = dt * sx[wid * 64 + 2 * (i0 + i) + half]; const f32x4 hn = dA * hv[i] + xd * Bv;
            __builtin_nontemporal_store(hn, (f32x4*)(hout + (size_t)(i0 + i) * 256));
            v[i0 + i] = hn[0] * Cv[0] + hn[1] * Cv[1] + hn[2] * Cv[2] + hn[3] * Cv[3]; }
    }
#pragma unroll
    for (int m = 16; m >= 1; m >>= 1) {
#pragma unroll
        for (int i = 0; i < m; ++i) { const bool up = (l32 & m) != 0; const float keep = up ? v[i + m] : v[i], send = up ? v[i] : v[i + m]; v[i] = keep + __shfl_xor(send, m); } }
    const int pl = 2 * l32 + half;
    const float ymine = v[0];
    const float xsv = sx[wid * 64 + pl];
    float y = ymine + P.ssd_d[h] * xsv;
    y *= silu_f(bf2f(mix[h * 64 + pl]));
    float sq = y * y;
    sq += __shfl_xor(sq, 1); sq += __shfl_xor(sq, 2); sq += __shfl_xor(sq, 4); sq += __shfl_xor(sq, 8); sq += __shfl_xor(sq, 16); sq += __shfl_xor(sq, 32);
    if (lane == 0) ssqs[wid] = sq;
    __syncthreads();
    float tot = 0.f;
#pragma unroll
    for (int i = 0; i < 8; ++i) tot += ssqs[i];
    const float rstd = rsqrtf(tot * (1.0f / 512.0f) + EPS);
    mix[h * 64 + pl] = f2bf(y * rstd * P.ssd_norm_w[h * 64 + pl]);
    __syncthreads();
}

__device__ __forceinline__ void p3_item(const Params& P, LAS unsigned char* lds, int item) {
    const int tid = threadIdx.x, lane = tid & 63, wid = tid >> 6, r16 = lane & 15, q = lane >> 4;
    const int b = item >> 5, c = (item >> 1) & 15, g = item & 1, h = g * 8 + wid, t0 = c * 128;
    LAS float* wsc = (LAS float*)lds + wid * 128;
    LAS unsigned char* btl = lds + 4096;
    const bf16_t* BTp = (const bf16_t*)((const unsigned char*)P.out + OS_BT) + ((size_t)(b * 2 + g) * 128) * 2048 + t0;
    u32x4 btr[4];
#pragma unroll
    for (int k = 0; k < 4; ++k) { const int i = tid + 512 * k; btr[k] = *(const u32x4*)(BTp + (size_t)(i >> 4) * 2048 + (i & 15) * 8); }
    const float* dtp = (const float*)(P.ws + WS_DT) + (size_t)(b * 16 + h) * 2048 + t0;
    const float* acp = (const float*)(P.ws + WS_ACUM) + (size_t)(b * 16 + h) * 2048 + t0;
    const float alast = acp[127];
    wsc[lane] = dtp[lane] * __expf(alast - acp[lane]); wsc[lane + 64] = dtp[lane + 64] * __expf(alast - acp[lane + 64]);
#pragma unroll
    for (int k = 0; k < 4; ++k) { const int i = tid + 512 * k; *(LAS u32x4*)(btl + (i >> 4) * 272 + (i & 15) * 16) = btr[k]; }
    __syncthreads();
    const bf16_t* xsT = (const bf16_t*)(P.ws + WS_A1) + ((size_t)(b * 16 + h) * 64) * 2048 + t0;
    f32x4 acc[8][4];
#pragma unroll
    for (int i = 0; i < 8; ++i)
#pragma unroll
        for (int j = 0; j < 4; ++j) acc[i][j] = (f32x4){0.f, 0.f, 0.f, 0.f};
#pragma unroll 2
    for (int kk = 0; kk < 4; ++kk) { const int s0 = 32 * kk + 8 * q;
        float sc[8]; { const f32x4 a = *(const LAS f32x4*)(wsc + s0), b2 = *(const LAS f32x4*)(wsc + s0 + 4); sc[0] = a[0]; sc[1] = a[1]; sc[2] = a[2]; sc[3] = a[3]; sc[4] = b2[0]; sc[5] = b2[1]; sc[6] = b2[2]; sc[7] = b2[3]; }
        bf16x8 bfr[4];
#pragma unroll
        for (int pt = 0; pt < 4; ++pt) { const u32x4 rawv = *(const u32x4*)(xsT + (size_t)(pt * 16 + r16) * 2048 + s0); float f[8]; unpack8(rawv, f);
#pragma unroll
            for (int j = 0; j < 8; ++j) f[j] *= sc[j];
            bfr[pt] = __builtin_bit_cast(bf16x8, pack8(f)); }
#pragma unroll
        for (int nt = 0; nt < 8; ++nt) { const bf16x8 afr = *(const LAS bf16x8*)(btl + (nt * 16 + r16) * 272 + s0 * 2);
#pragma unroll
            for (int pt = 0; pt < 4; ++pt) acc[nt][pt] = __builtin_amdgcn_mfma_f32_16x16x32_bf16(afr, bfr[pt], acc[nt][pt], 0, 0, 0); }
    }
    bf16_t* stp = (bf16_t*)((unsigned char*)P.out + OS_ST) + (((size_t)(b * 16 + c) * 16 + h) * 64) * 128;
#pragma unroll
    for (int nt = 0; nt < 8; ++nt)
#pragma unroll
        for (int pt = 0; pt < 4; ++pt) { u32x2 w; w.x = cvt_pk_bf16(acc[nt][pt][0], acc[nt][pt][1]); w.y = cvt_pk_bf16(acc[nt][pt][2], acc[nt][pt][3]);
            *(u32x2*)(stp + (size_t)(pt * 16 + r16) * 128 + nt * 16 + 4 * q) = w; }
    __syncthreads();
}

__device__ __forceinline__ void phase4(const Params& P) {
    const int tid = threadIdx.x, G = gridDim.x, bx = blockIdx.x;
    for (int idx = bx * 512 + tid; idx < 262144; idx += G * 512) {
        const int n4 = idx & 31, pp = (idx >> 5) & 63, h = (idx >> 11) & 15, b = idx >> 15;
        const float* acp = (const float*)(P.ws + WS_ACUM) + (size_t)(b * 16 + h) * 2048;
        f32x4 hs = (f32x4){0.f, 0.f, 0.f, 0.f};
        u32x2* ptr0 = (u32x2*)((bf16_t*)((unsigned char*)P.out + OS_ST) + ((((size_t)(b * 16) * 16 + h) * 64 + pp) * 128 + n4 * 4));
        u32x2 sv[16]; float dec[16];
#pragma unroll
        for (int c = 0; c < 16; ++c) { sv[c] = ptr0[(size_t)c * 32768]; dec[c] = acp[c * 128 + 127]; }
#pragma unroll
        for (int c = 0; c < 16; ++c) { u32x2 w; w.x = cvt_pk_bf16(hs[0], hs[1]); w.y = cvt_pk_bf16(hs[2], hs[3]); ptr0[(size_t)c * 32768] = w;
            const float d = __expf(dec[c]); const u32x2 sc = sv[c];
            hs[0] = d * hs[0] + bf_lo(sc.x); hs[1] = d * hs[1] + bf_hi(sc.x); hs[2] = d * hs[2] + bf_lo(sc.y); hs[3] = d * hs[3] + bf_hi(sc.y); }
        *(f32x4*)(P.out + O_PSSM + ((size_t)(b * 16 + h) * 64 + pp) * 128 + n4 * 4) = hs;
    }
}

__device__ __forceinline__ void p5_stage_load(const bf16_t* Hp, const bf16_t* xsT, u32x4 (&sr)[4]) {
    const int tid = threadIdx.x;
#pragma unroll
    for (int k = 0; k < 2; ++k) { const int i = tid + 512 * k, row = i >> 4, c16 = i & 15;
        sr[k] = *(const u32x4*)(Hp + (size_t)row * 128 + c16 * 8); sr[2 + k] = *(const u32x4*)(xsT + (size_t)row * 2048 + c16 * 8); }
}
__device__ __forceinline__ void p5_stage_write(LAS unsigned char* buf, const u32x4 (&sr)[4]) {
    const int tid = threadIdx.x;
#pragma unroll
    for (int k = 0; k < 2; ++k) { const int i = tid + 512 * k, row = i >> 4, c16 = i & 15;
        *(LAS u32x4*)(buf + row * 272 + c16 * 16) = sr[k]; *(LAS u32x4*)(buf + 17408 + row * 272 + c16 * 16) = sr[2 + k]; }
}
__device__ __forceinline__ void p5_item(const Params& P, LAS unsigned char* lds, int item) {
    const int tid = threadIdx.x, lane = tid & 63, w = __builtin_amdgcn_readfirstlane(tid >> 6), r16 = lane & 15, q = lane >> 4;
    const int b = item >> 5, c = (item >> 1) & 15, g = item & 1, t0 = c * 128, l0 = 16 * w;
    LAS float* acs = (LAS float*)lds;
    LAS float* dtl = acs + 1024;
    LAS unsigned char* sbuf = lds + 8192;
    LAS float* nwl = (LAS float*)(lds + 8192 + 69632);
    nwl[tid] = P.ssd_norm_w[g * 512 + tid];
    const bf16_t* Hbase = (const bf16_t*)((const unsigned char*)P.out + OS_ST) + (((size_t)(b * 16 + c) * 16 + g * 8) * 64) * 128;
    const bf16_t* Xbase = (const bf16_t*)(P.ws + WS_A1) + ((size_t)(b * 16 + g * 8) * 64) * 2048 + t0;
    u32x4 sr[4];
    p5_stage_load(Hbase, Xbase, sr);
    if (tid < 256) { const size_t o = (size_t)(b * 16 + g * 8 + (tid >> 5)) * 2048 + t0 + (tid & 31) * 4;
      *(LAS f32x4*)(acs + tid * 4) = *(const f32x4*)((const float*)(P.ws + WS_ACUM) + o); *(LAS f32x4*)(dtl + tid * 4) = *(const f32x4*)((const float*)(P.ws + WS_DT) + o); }
    const bf16_t* Bn = (const bf16_t*)((const unsigned char*)P.out + OS_BN) + ((size_t)(b * 2 + g) * 2048 + t0) * 128;
    const bf16_t* Cn = (const bf16_t*)((const unsigned char*)P.out + OS_CN) + ((size_t)(b * 2 + g) * 2048 + t0) * 128;
    bf16x8 cfr[4];
#pragma unroll
    for (int kk = 0; kk < 4; ++kk) cfr[kk] = *(const bf16x8*)(Cn + (size_t)(l0 + r16) * 128 + 32 * kk + 8 * q);
    f32x4 GT[8];
#pragma unroll
    for (int j = 0; j < 8; ++j) GT[j] = (f32x4){0.f, 0.f, 0.f, 0.f};
#pragma unroll
    for (int j0 = 0; j0 < 8; j0 += 4) if (j0 <= w) {
        bf16x8 bf[4][4];
#pragma unroll
        for (int j = 0; j < 4; ++j)
#pragma unroll
            for (int kk = 0; kk < 4; ++kk) bf[j][kk] = *(const bf16x8*)(Bn + (size_t)(16 * (j0 + j) + r16) * 128 + 32 * kk + 8 * q);
#pragma unroll
        for (int j = 0; j < 4; ++j)
#pragma unroll
            for (int kk = 0; kk < 4; ++kk) GT[j0 + j] = __builtin_amdgcn_mfma_f32_16x16x32_bf16(bf[j][kk], cfr[kk], GT[j0 + j], 0, 0, 0);
    }
    p5_stage_write(sbuf, sr);
    __syncthreads();
    const int lidx = l0 + r16;
    bf16_t* mixrow = (bf16_t*)(P.ws + WS_MIX) + (size_t)(b * 2048 + t0 + lidx) * 2048;
    float ssq = 0.f;
    if (PROBE_MASK && blockIdx.x == 0 && tid == 0) ((unsigned long long*)(P.ws + WS_BAR + 14336))[14] = __builtin_amdgcn_s_memrealtime();
#pragma unroll 1
    for (int r = 0; r < 8; ++r) {
        const int h = g * 8 + r;
        if (r < 7) p5_stage_load(Hbase + (size_t)(r + 1) * 8192, Xbase + (size_t)(r + 1) * 131072, sr);
        u32x2 zz[4];
#pragma unroll
        for (int pt = 0; pt < 4; ++pt) zz[pt] = *(const u32x2*)(mixrow + h * 64 + pt * 16 + 4 * q);
        const LAS unsigned char* Hb = sbuf + (r & 1) * 34816 + r16 * 272 + 16 * q;
        const LAS unsigned char* Xb = sbuf + (r & 1) * 34816 + 17408 + r16 * 272 + 8 * q;
        const float acl = acs[r * 128 + lidx], Dh = P.ssd_d[h];
        f32x4 acc[4];
#pragma unroll
        for (int pt = 0; pt < 4; ++pt) acc[pt] = (f32x4){0.f, 0.f, 0.f, 0.f};
#pragma unroll
        for (int kk = 0; kk < 4; ++kk)
#pragma unroll
            for (int pt = 0; pt < 4; ++pt) { const bf16x8 afr = *(const LAS bf16x8*)(Hb + pt * 4352 + kk * 64); acc[pt] = __builtin_amdgcn_mfma_f32_16x16x32_bf16(afr, cfr[kk], acc[pt], 0, 0, 0); }
        { const float el = __expf(acl);
#pragma unroll
          for (int pt = 0; pt < 4; ++pt) acc[pt] *= el; }
#pragma unroll
        for (int kk = 0; kk < 4; ++kk) if (2 * kk <= w) {
            const f32x4 asa = *(const LAS f32x4*)(acs + r * 128 + 32 * kk + 4 * q), dta = *(const LAS f32x4*)(dtl + r * 128 + 32 * kk + 4 * q);
            const f32x4 asb = *(const LAS f32x4*)(acs + r * 128 + 32 * kk + 16 + 4 * q), dtb = *(const LAS f32x4*)(dtl + r * 128 + 32 * kk + 16 + 4 * q);
            float m[8];
#pragma unroll
            for (int j = 0; j < 4; ++j) { const int s = 32 * kk + 4 * q + j; float v = GT[2 * kk][j] * __expf(fminf(acl - asa[j], 0.f)) * dta[j]; v = s > lidx ? 0.f : v; v = s == lidx ? v + Dh : v; m[j] = v; }
#pragma unroll
            for (int j = 0; j < 4; ++j) { const int s = 32 * kk + 16 + 4 * q + j; float v = GT[2 * kk + 1][j] * __expf(fminf(acl - asb[j], 0.f)) * dtb[j]; v = s > lidx ? 0.f : v; v = s == lidx ? v + Dh : v; m[4 + j] = v; }
            const bf16x8 bfr = __builtin_bit_cast(bf16x8, pack8(m));
#pragma unroll
            for (int pt = 0; pt < 4; ++pt) { const u32x2 lo = *(const LAS u32x2*)(Xb + pt * 4352 + kk * 64), hi = *(const LAS u32x2*)(Xb + pt * 4352 + kk * 64 + 32);
                u32x4 av; av.x = lo.x; av.y = lo.y; av.z = hi.x; av.w = hi.y;
                acc[pt] = __builtin_amdgcn_mfma_f32_16x16x32_bf16(__builtin_bit_cast(bf16x8, av), bfr, acc[pt], 0, 0, 0); }
        }
#pragma unroll
        for (int pt = 0; pt < 4; ++pt) {
            const float y0 = acc[pt][0] * silu_f(bf_lo(zz[pt].x)), y1 = acc[pt][1] * silu_f(bf_hi(zz[pt].x)), y2 = acc[pt][2] * silu_f(bf_lo(zz[pt].y)), y3 = acc[pt][3] * silu_f(bf_hi(zz[pt].y));
            ssq += y0 * y0 + y1 * y1 + y2 * y2 + y3 * y3;
            const f32x4 nw = *(const LAS f32x4*)(nwl + r * 64 + pt * 16 + 4 * q);
            u32x2 o; o.x = cvt_pk_bf16(y0 * nw[0], y1 * nw[1]); o.y = cvt_pk_bf16(y2 * nw[2], y3 * nw[3]); *(u32x2*)(mixrow + h * 64 + pt * 16 + 4 * q) = o; }
        if (r < 7) p5_stage_write(sbuf + ((r + 1) & 1) * 34816, sr);
        __syncthreads();
    }
    if (PROBE_MASK && blockIdx.x == 0 && tid == 0) ((unsigned long long*)(P.ws + WS_BAR + 14336))[15] = __builtin_amdgcn_s_memrealtime();
    ssq += __shfl_xor(ssq, 16); ssq += __shfl_xor(ssq, 32);
    const float rstd = rsqrtf(ssq * (1.0f / 512.0f) + EPS);
    if (q == 0) ((float*)(P.ws + WS_GRS))[(size_t)(b * 2048 + t0 + lidx) * 2 + g] = rstd;
    __syncthreads();
    if (PROBE_MASK && blockIdx.x == 0 && tid == 0) ((unsigned long long*)(P.ws + WS_BAR + 14336))[16] = __builtin_amdgcn_s_memrealtime();
}

__device__ __forceinline__ void rmsnorm_rows(float* srcf, const bf16_t* src16, const float* w, bf16_t* dstb, float* dstf, const float* slab, int nslab, const float* xs_base) {
    const int tid = threadIdx.x, lane = tid & 63, wid = tid >> 6;
    f32x4 wv[4];
#pragma unroll
    for (int i = 0; i < 4; ++i) wv[i] = *(const f32x4*)(w + lane * 4 + i * 256);
    for (int row = blockIdx.x * 8 + wid; row < TT; row += gridDim.x * 8) {
        f32x4 v[4];
        if (row < TPR) {
            u32x2 r[4];
#pragma unroll
            for (int i = 0; i < 4; ++i) r[i] = *(const u32x2*)(src16 + (size_t)row * 1024 + lane * 4 + i * 256);
#pragma unroll
            for (int i = 0; i < 4; ++i) v[i] = (f32x4){bf_lo(r[i].x), bf_hi(r[i].x), bf_lo(r[i].y), bf_hi(r[i].y)};
        } else {
            const float* s = (xs_base ? xs_base + (size_t)(row - TPR) * 1024 : srcf + (size_t)row * 1024) + lane * 4;
#pragma unroll
            for (int i = 0; i < 4; ++i) v[i] = *(const f32x4*)(s + i * 256);
            for (int k = 0; k < nslab; ++k) { const float* sp = slab + ((size_t)k * 128 + (row - TPR)) * 1024 + lane * 4;
#pragma unroll
                for (int i = 0; i < 4; ++i) v[i] += *(const f32x4*)(sp + i * 256); }
            if (xs_base) {
#pragma unroll
                for (int i = 0; i < 4; ++i) *(f32x4*)(srcf + (size_t)row * 1024 + lane * 4 + i * 256) = v[i]; }
        }
        float ss = 0.f;
#pragma unroll
        for (int i = 0; i < 4; ++i) ss += v[i][0] * v[i][0] + v[i][1] * v[i][1] + v[i][2] * v[i][2] + v[i][3] * v[i][3];
        ss += __shfl_xor(ss, 1); ss += __shfl_xor(ss, 2); ss += __shfl_xor(ss, 4); ss += __shfl_xor(ss, 8); ss += __shfl_xor(ss, 16); ss += __shfl_xor(ss, 32);
        const float rstd = rsqrtf(ss * (1.0f / 1024.0f) + EPS);
#pragma unroll
        for (int i = 0; i < 4; ++i) { const f32x4 o = v[i] * rstd * wv[i];
            if (dstb) { u32x2 pk; pk.x = cvt_pk_bf16(o[0], o[1]); pk.y = cvt_pk_bf16(o[2], o[3]); *(u32x2*)(dstb + (size_t)row * 1024 + lane * 4 + i * 256) = pk; }
            else __builtin_nontemporal_store(o, (f32x4*)(dstf + (size_t)row * 1024 + lane * 4 + i * 256)); }
    }
}

__device__ __forceinline__ void phase9_fix(const Params& P, int G, int bx) {
    const int tid = threadIdx.x;
    bf16_t* act = (bf16_t*)(P.ws + WS_UP);
    const float* gf = (const float*)(P.ws + WS_SBGF); const float* gl = (const float*)(P.ws + WS_SBGL); const float* uf = (const float*)(P.ws + WS_SBUF);
    pg8::StaticOrder S; S.init(TPR, 1024, G, bx); pg8::Unit u;
    for (int i = 0; S.next(i, u); ++i) {
        const int pm = u.pm;
        if ((pm & 7) == 0) continue;
        for (int idx = tid; idx < 704; idx += 512) { const int c4 = idx * 4;
            const f32x4 w0 = *(const f32x4*)(P.ffn_conv_w + c4), w1 = *(const f32x4*)(P.ffn_conv_w + DFF + c4), w2 = *(const f32x4*)(P.ffn_conv_w + 2 * DFF + c4), bb = *(const f32x4*)(P.ffn_conv_b + c4);
            const f32x4 gl0 = *(const f32x4*)(gl + (size_t)((pm - 1) * 2) * DFF + c4), gl1 = *(const f32x4*)(gl + (size_t)((pm - 1) * 2 + 1) * DFF + c4);
            const f32x4 gf0 = *(const f32x4*)(gf + (size_t)(pm * 2) * DFF + c4), gf1 = *(const f32x4*)(gf + (size_t)(pm * 2 + 1) * DFF + c4);
            const f32x4 u0 = *(const f32x4*)(uf + (size_t)(pm * 2) * DFF + c4), u1 = *(const f32x4*)(uf + (size_t)(pm * 2 + 1) * DFF + c4);
            const f32x4 c0 = gl0 * w0 + gl1 * w1 + gf0 * w2 + bb, c1 = gl1 * w0 + gf0 * w1 + gf1 * w2 + bb;
            u32x2 o0, o1;
            o0.x = cvt_pk_bf16(silu_f(c0[0]) * u0[0], silu_f(c0[1]) * u0[1]); o0.y = cvt_pk_bf16(silu_f(c0[2]) * u0[2], silu_f(c0[3]) * u0[3]);
            o1.x = cvt_pk_bf16(silu_f(c1[0]) * u1[0], silu_f(c1[1]) * u1[1]); o1.y = cvt_pk_bf16(silu_f(c1[2]) * u1[2], silu_f(c1[3]) * u1[3]);
            *(u32x2*)(act + (size_t)(pm * 256) * DFF + c4) = o0; *(u32x2*)(act + (size_t)(pm * 256 + 1) * DFF + c4) = o1; }
    }
    for (int idx = bx * 512 + tid; idx < 8 * 2 * 704; idx += G * 512) {
        const int b = idx / 1408, r = (idx / 704) & 1, c4 = (idx % 704) * 4;
        *(f32x4*)(P.out + O_PFFN + (size_t)(b * 2 + r) * DFF + c4) = *(const f32x4*)(gl + (size_t)((8 * b + 7) * 2 + r) * DFF + c4);
    }
    asm volatile("s_waitcnt vmcnt(0)" ::: "memory");
    __syncthreads();
}

__device__ __forceinline__ void phase6_fix(const Params& P, int G, int bx) {
    const int tid = threadIdx.x;
    bf16_t* mix = (bf16_t*)(P.ws + WS_MIX);
    const float* uf = (const float*)(P.ws + WS_SCUF); const float* ul = (const float*)(P.ws + WS_SCUL); const float* gbf = (const float*)(P.ws + WS_SCGF);
    pg8::StaticOrder S; S.init(TPR, 1024, G, bx); pg8::Unit u;
    for (int i = 0; S.next(i, u); ++i) {
        const int pm = u.pm;
        if ((pm & 7) == 0 || tid >= 256) continue;
        const int c4 = tid * 4;
        const f32x4 w0 = *(const f32x4*)(P.sc_conv_w + c4), w1 = *(const f32x4*)(P.sc_conv_w + 1024 + c4), w2 = *(const f32x4*)(P.sc_conv_w + 2048 + c4);
        const f32x4 ul0 = *(const f32x4*)(ul + (size_t)((pm - 1) * 2) * 1024 + c4), ul1 = *(const f32x4*)(ul + (size_t)((pm - 1) * 2 + 1) * 1024 + c4);
        const f32x4 uf0 = *(const f32x4*)(uf + (size_t)(pm * 2) * 1024 + c4), uf1 = *(const f32x4*)(uf + (size_t)(pm * 2 + 1) * 1024 + c4);
        const f32x4 g0 = *(const f32x4*)(gbf + (size_t)(pm * 2) * 1024 + c4), g1 = *(const f32x4*)(gbf + (size_t)(pm * 2 + 1) * 1024 + c4);
        const f32x4 y0 = g0 * (ul0 * w0 + ul1 * w1 + uf0 * w2), y1 = g1 * (ul1 * w0 + uf0 * w1 + uf1 * w2);
        u32x2 o0, o1; o0.x = cvt_pk_bf16(y0[0], y0[1]); o0.y = cvt_pk_bf16(y0[2], y0[3]); o1.x = cvt_pk_bf16(y1[0], y1[1]); o1.y = cvt_pk_bf16(y1[2], y1[3]);
        *(u32x2*)(mix + (size_t)(pm * 256) * 2048 + 1024 + c4) = o0; *(u32x2*)(mix + (size_t)(pm * 256 + 1) * 2048 + 1024 + c4) = o1;
    }
    for (int idx = bx * 512 + tid; idx < 8 * 2 * 256; idx += G * 512) {
        const int b = idx >> 9, r = (idx >> 8) & 1, c4 = (idx & 255) * 4;
        *(f32x4*)(P.out + O_PSC + (size_t)(b * 2 + r) * 1024 + c4) = *(const f32x4*)(ul + (size_t)((8 * b + 7) * 2 + r) * 1024 + c4);
    }
    asm volatile("s_waitcnt vmcnt(0)" ::: "memory");
    __syncthreads();
}

constexpr int NPHASE = 12;
static_assert(WS_END <= (size_t)256 * 1024 * 1024, "workspace map exceeds the guaranteed 256 MiB");
static_assert(WS_UP + (size_t)TPAD * 2816 * 2 <= WS_BAR, "act overlays only the dead xBC / MIX region");
__global__ void __launch_bounds__(512, 2) fwd_megakernel(Params P) {
    extern __shared__ __attribute__((aligned(16))) unsigned char lds_raw[];
    LAS unsigned char* lds = (LAS unsigned char*)lds_raw;
    volatile LAS unsigned* stw = (volatile LAS unsigned*)(lds + 131072);
    if (threadIdx.x < 4) stw[threadIdx.x] = 0u;
    __syncthreads();
    const XcdBarrier bar = xcd_barrier_post((unsigned*)(P.ws + WS_BAR), stw);
    const int lo = P.ph_lo, hi = P.ph_hi, G = gridDim.x, bx = blockIdx.x;
#define IN(k) (lo <= (k) && (k) < hi)
    unsigned long long* stamps = (unsigned long long*)(P.ws + WS_BAR + 14336);
#define STAMP(k) do { if (PROBE_MASK && bx == 0 && threadIdx.x == 0) stamps[k] = __builtin_amdgcn_s_memrealtime(); } while (0)
    STAMP(0);
#define SEAM(k) do { if (IN(k) && IN((k) + 1)) xcd_barrier(bar); STAMP((k) + 1); } while (0)
    if (IN(0)) phase0(P, lds);
    SEAM(0);
    if (IN(1)) { pg8::Gemm g{(const bf16_t*)(P.ws + WS_A1), (const bf16_t*)(P.ws + WS_WIN), TPAD, NIN, 1024, 1024, 1024}; pg8::StaticOrder S; S.init(TPAD, NIN, G, bx);
        EpiIn E{(bf16_t*)(P.ws + WS_MIX), (bf16_t*)(P.ws + WS_XBC), (const float*)(P.ws + WS_RSTD), (float*)(P.ws + WS_SCUF), (float*)(P.ws + WS_SCUL), (float*)(P.ws + WS_SCGF), P.sc_conv_w, P.state_sc, P.out + O_SSC, (LAS float*)(lds + LDS_XCH)}; pg8::gemm_phase<EpiIn>(lds, g, S, E);
        p1_late_tiles(P, lds); }
    SEAM(1);
    if (IN(2)) { { u32x4 pre[3]; if (bx < 3072) p2_conv_load(P, bx, pre);
          for (int it = bx; it < 3072; it += G) p2_conv_item(P, lds, it, it + G < 3072 ? it + G : -1, pre); }
        STAMP(13);
        for (int it = bx; it < 256; it += G) p2_sample_item(P, lds, it); }
    SEAM(2);
    if (IN(3)) { for (int it = bx; it < 256; it += G) p3_item(P, lds, it); }
    SEAM(3);
    if (IN(4)) phase4(P);
    SEAM(4);
    if (IN(5)) { for (int it = bx; it < 256; it += G) p5_item(P, lds, it); }
    SEAM(5);
    if (IN(6)) { phase6_fix(P, G, bx);
        { pg8::Gemm g{(const bf16_t*)(P.ws + WS_MIX), (const bf16_t*)(P.ws + WS_WOUT), TPR, 1024, 2048, 2048, 2048}; pg8::StaticOrder S; S.init(TPR, 1024, G, bx);
          LAS float* sct = (LAS float*)(lds + LDS_XCH);
          { pg8::Unit u0; if (S.next(0, u0) && threadIdx.x < 256) { const float* gr = (const float*)(P.ws + WS_GRS) + (size_t)(u0.pm * 256 + threadIdx.x) * 2; const float r0 = gr[0], r1 = gr[1];
                sct[threadIdx.x] = r0 / r1; sct[256 + threadIdx.x] = r1; } }
          __syncthreads();
          EpiRes E{P.x_prompt, nullptr, (bf16_t*)(P.ws + WS_X1B)};
          pg8::gemm_phase<EpiRes, pg8::StaticOrder, true>(lds, g, S, E, sct); }
        { pg8::Gemm g{(const bf16_t*)(P.ws + WS_MIX) + (size_t)TPR * 2048, (const bf16_t*)(P.ws + WS_WOUT), 256, 1024, 256, 2048, 2048}; pg8::SplitOrder S{32, bx, 256};
          EpiSlab E{(float*)(P.ws + WS_SLAB)}; pg8::gemm_phase<EpiSlab>(lds, g, S, E); } }
    SEAM(6);
    if (IN(7)) rmsnorm_rows(P.out, (const bf16_t*)(P.ws + WS_X1B), P.norm_ffn_w, (bf16_t*)(P.ws + WS_A1), nullptr, (const float*)(P.ws + WS_SLAB), 8, P.x_sample);
    SEAM(7);
    if (IN(8)) { pg8::Gemm g{(const bf16_t*)(P.ws + WS_A1), (const bf16_t*)(P.ws + WS_WFFN), TPAD, NIN, 1024, 1024, 1024}; pg8::StaticOrder S; S.init(TPAD, NIN, G, bx);
        EpiFfnAct E{(bf16_t*)(P.ws + WS_UP), (float*)(P.ws + WS_SBGF), (float*)(P.ws + WS_SBGL), (float*)(P.ws + WS_SBUF), P.ffn_conv_w, P.ffn_conv_b, P.state_ffn, P.out + O_SFFN, (LAS float*)(lds + LDS_XCH)};
        pg8::gemm_phase<EpiFfnAct>(lds, g, S, E); }
    SEAM(8);
    if (IN(10)) { phase9_fix(P, G, bx);
        { pg8::Gemm g{(const bf16_t*)(P.ws + WS_UP), (const bf16_t*)(P.ws + WS_WDOWN), TPR, 1024, DFF, DFF, DFF}; pg8::StaticOrder S; S.init(TPR, 1024, G, bx);
          EpiRes E{nullptr, (const bf16_t*)(P.ws + WS_X1B), (bf16_t*)(P.ws + WS_A1)}; pg8::gemm_phase<EpiRes>(lds, g, S, E); }
        { pg8::Gemm g{(const bf16_t*)(P.ws + WS_UP) + (size_t)TPR * DFF, (const bf16_t*)(P.ws + WS_WDOWN), 256, 1024, 256, DFF, DFF}; pg8::SplitOrder S{44, bx, 256};
          EpiSlab E{(float*)(P.ws + WS_SLAB)}; pg8::gemm_phase<EpiSlab>(lds, g, S, E); } }
    SEAM(10);
    if (IN(11)) rmsnorm_rows(P.out, (const bf16_t*)(P.ws + WS_A1), P.norm_final_w, nullptr, P.out, (const float*)(P.ws + WS_SLAB), 11, nullptr);
    if (PROBE_MASK && bx == 0 && threadIdx.x == 0) {
        const unsigned long long tend = __builtin_amdgcn_s_memrealtime(); stamps[12] = tend; unsigned long long extra = 0;
        asm volatile("s_waitcnt vmcnt(0)" ::: "memory");
        for (int k = 0; k < 12; ++k) if ((PROBE_MASK >> k) & 1) extra += stamps[k + 1] - stamps[k];
        if (PROBE_MASK & 0x1000) extra += stamps[13] - stamps[2];
        if (PROBE_MASK & 0x2000) extra += stamps[15] - stamps[14];
        if (PROBE_MASK & 0x4000) extra += stamps[14] - stamps[5];
        if (PROBE_MASK & 0x8000) extra += stamps[16] - stamps[15];
        if (PROBE_MASK & 0x10000) extra += stamps[6] - stamps[16];
        while (__builtin_amdgcn_s_memrealtime() - tend < extra) __builtin_amdgcn_s_sleep(8);
    }
#undef IN
#undef SEAM
}

#ifndef N_LAUNCHES
#define N_LAUNCHES 1
#endif
extern "C" void kernel_launch(void* const* d_in, const int* in_sizes, int n_in, void* d_out, int out_size, void* d_ws, size_t ws_size, hipStream_t stream) {
    static int grid_blocks = 0;
    if (!grid_blocks) {
        int dev = 0, cus = 0, per_cu = 0;
        (void)hipGetDevice(&dev);
        (void)hipDeviceGetAttribute(&cus, hipDeviceAttributeMultiprocessorCount, dev);
        (void)hipFuncSetAttribute((const void*)fwd_megakernel, hipFuncAttributeMaxDynamicSharedMemorySize, LDS_BYTES);
        (void)hipOccupancyMaxActiveBlocksPerMultiprocessor(&per_cu, (const void*)fwd_megakernel, 512, LDS_BYTES);
        if (per_cu < 1) { fprintf(stderr, "occupancy query says %d blocks per CU\n", per_cu); per_cu = 1; }
        if (per_cu > 1) per_cu = 1;
        grid_blocks = cus * per_cu;
        if (grid_blocks > 256) grid_blocks = 256;
        if (grid_blocks < 256) { fprintf(stderr, "this kernel is built for a 256-CU device (resident capacity reported: %d workgroups); nothing launched\n", grid_blocks); grid_blocks = -1; }
        if (ws_size < WS_END) fprintf(stderr, "workspace too small: %zu < %zu\n", ws_size, (size_t)WS_END);
    }
    if (grid_blocks < 0) return;
    if (N_LAUNCHES == 1) (void)hipMemsetAsync((unsigned char*)d_ws + WS_BAR, 0, XCD_BAR_WORDS * 4, stream);
    Params p{};
    const float** pp = (const float**)&p;
    for (int i = 0; i < 22; ++i) pp[i] = (const float*)d_in[i];
    p.out = (float*)d_out; p.ws = (unsigned char*)d_ws;
    for (int li = 0; li < N_LAUNCHES; ++li) {
        p.ph_lo = (N_LAUNCHES == 1) ? 0 : li; p.ph_hi = (N_LAUNCHES == 1) ? NPHASE : li + 1;
        void* args[] = {&p};
        hipError_t e = hipLaunchCooperativeKernel((const void*)fwd_megakernel, dim3(grid_blocks), dim3(512), args, LDS_BYTES, stream);
        if (e != hipSuccess) fprintf(stderr, "cooperative launch failed: %s (grid %d)\n", hipGetErrorString(e), grid_blocks);
    }
}
```

```cpp
#include <hip/hip_runtime.h>
#include <cstdio>

#define PROBE_MASK 0
#define LAS __attribute__((address_space(3)))
typedef unsigned short bf16_t;
typedef short bf16x8 __attribute__((ext_vector_type(8)));
typedef float f32x4 __attribute__((ext_vector_type(4)));
typedef unsigned u32x4 __attribute__((ext_vector_type(4)));
typedef unsigned u32x2 __attribute__((ext_vector_type(2)));

constexpr int TPR = 16384, TSM = 128, TT = 16512, TPAD = 16640;
constexpr int NIN = 5632, DINP = 5648, XBC = 1536, DFF = 2816;
constexpr float EPS = 1e-5f;
constexpr int LDS_BYTES = 131072 + 16 + 4096;
constexpr int LDS_XCH = 131072 + 16;

constexpr size_t WS_WIN = 0;
constexpr size_t WS_WOUT = WS_WIN + (size_t)NIN * 1024 * 2;
constexpr size_t WS_WFFN = WS_WOUT + (size_t)1024 * 2048 * 2;
constexpr size_t WS_WDOWN = WS_WFFN + (size_t)NIN * 1024 * 2;
constexpr size_t WS_A1 = WS_WDOWN + (size_t)1024 * 2816 * 2;
constexpr size_t WS_DT = WS_A1 + (size_t)TPAD * 1024 * 2;
constexpr size_t WS_ACUM = WS_DT + (size_t)8 * 16 * 2048 * 4;
constexpr size_t WS_DTS = WS_ACUM + (size_t)8 * 16 * 2048 * 4;
constexpr size_t WS_RSTD = WS_DTS + (size_t)128 * 16 * 4;
constexpr size_t WS_BIG = WS_RSTD + (size_t)TPAD * 4;
constexpr size_t WS_XBC = WS_BIG;
constexpr size_t WS_MIX = WS_XBC + (size_t)TPAD * 1536 * 2;
constexpr size_t WS_UP = WS_BIG;
constexpr size_t WS_BAR = WS_MIX + (size_t)TPAD * 2048 * 2;
constexpr size_t WS_SLAB = WS_BAR + 16384;
constexpr size_t WS_SBGF = WS_SLAB + (size_t)11 * 128 * 1024 * 4;
constexpr size_t WS_SBGL = WS_SBGF + (size_t)65 * 2 * 2816 * 4;
constexpr size_t WS_SBUF = WS_SBGL + (size_t)65 * 2 * 2816 * 4;
constexpr size_t WS_SCUF = WS_SBUF + (size_t)65 * 2 * 2816 * 4;
constexpr size_t WS_SCUL = WS_SCUF + (size_t)65 * 2 * 1024 * 4;
constexpr size_t WS_SCGF = WS_SCUL + (size_t)65 * 2 * 1024 * 4;
constexpr size_t WS_X1B = WS_SCGF + (size_t)65 * 2 * 1024 * 4;
constexpr size_t WS_GRS = WS_X1B + (size_t)TPAD * 1024 * 2;
constexpr size_t WS_END = WS_GRS + (size_t)TPR * 2 * 4;
constexpr size_t OS_BN = 0;
constexpr size_t OS_BT = OS_BN + (size_t)8 * 2 * 2048 * 128 * 2;
constexpr size_t OS_CN = OS_BT + (size_t)8 * 2 * 2048 * 128 * 2;
constexpr size_t OS_ST = OS_CN + (size_t)8 * 2 * 2048 * 128 * 2;
constexpr size_t O_YS = 16777216, O_PSSM = 16908288, O_PSSDC = 17956864, O_PSC = 17993728, O_PFFN = 18010112;
constexpr size_t O_SSSM = 18055168, O_SSSDC = 34832384, O_SSC = 35422208, O_SFFN = 35684352;

typedef float f32x2_t __attribute__((ext_vector_type(2)));
typedef __bf16 bf16x2_t __attribute__((ext_vector_type(2)));
__device__ __forceinline__ unsigned cvt_pk_bf16(float lo, float hi) { const f32x2_t v = {lo, hi}; return __builtin_bit_cast(unsigned, __builtin_convertvector(v, bf16x2_t)); }
__device__ __forceinline__ float bf_lo(unsigned u) { return __uint_as_float(u << 16); }
__device__ __forceinline__ float bf_hi(unsigned u) { return __uint_as_float(u & 0xffff0000u); }
__device__ __forceinline__ bf16_t f2bf(float f) { return (bf16_t)(cvt_pk_bf16(f, 0.f) & 0xffffu); }
__device__ __forceinline__ float bf2f(bf16_t b) { return __uint_as_float(((unsigned)b) << 16); }
__device__ __forceinline__ float silu_f(float v) { return v * __builtin_amdgcn_rcpf(1.0f + __expf(-v)); }
__device__ __forceinline__ float softplus_f(float v) { return v > 20.f ? v : log1pf(__expf(v)); }
__device__ __forceinline__ void unpack8(const u32x4 u, float (&f)[8]) { f[0] = bf_lo(u.x); f[1] = bf_hi(u.x); f[2] = bf_lo(u.y); f[3] = bf_hi(u.y); f[4] = bf_lo(u.z); f[5] = bf_hi(u.z); f[6] = bf_lo(u.w); f[7] = bf_hi(u.w); }
__device__ __forceinline__ u32x4 pack8(const float (&f)[8]) { u32x4 u; u.x = cvt_pk_bf16(f[0], f[1]); u.y = cvt_pk_bf16(f[2], f[3]); u.z = cvt_pk_bf16(f[4], f[5]); u.w = cvt_pk_bf16(f[6], f[7]); return u; }
__device__ __forceinline__ void ld8f(const float* p, float (&f)[8]) { const f32x4 a = *(const f32x4*)p, b = *(const f32x4*)(p + 4); f[0] = a[0]; f[1] = a[1]; f[2] = a[2]; f[3] = a[3]; f[4] = b[0]; f[5] = b[1]; f[6] = b[2]; f[7] = b[3]; }
__device__ __forceinline__ void st8f(float* p, const float (&f)[8]) { *(f32x4*)p = (f32x4){f[0], f[1], f[2], f[3]}; *(f32x4*)(p + 4) = (f32x4){f[4], f[5], f[6], f[7]}; }


#define XB_TMO      128
#define XB_XCNT(j)  (256  + 64 * (j))
#define XB_XSUB(j)  (1280 + 64 * (j))
#define XB_XGEN(j)  (2304 + 64 * (j))
#define XB_TOP      3328
#define XB_TOPGEN   3392
#define XCD_BAR_WORDS 3456
#define XB_SPIN_CAP (1u << 18)
__device__ __forceinline__ unsigned xb_ld(unsigned* p)              { return __hip_atomic_load(p, __ATOMIC_RELAXED, __HIP_MEMORY_SCOPE_AGENT); }
__device__ __forceinline__ unsigned xb_add(unsigned* p, unsigned v) { return __hip_atomic_fetch_add(p, v, __ATOMIC_RELAXED, __HIP_MEMORY_SCOPE_AGENT); }
__device__ __forceinline__ unsigned xb_xcc_id() { return (unsigned)__builtin_amdgcn_s_getreg((3 << 11) | 20) & 0xFu; }
#define XB_SPIN(cond, bar) do { unsigned _sp = 0; while (cond) { __builtin_amdgcn_s_sleep(1); \
    if ((++_sp & 255u) == 0u) { if (xb_ld(&(bar)[XB_TMO])) break; if (_sp > XB_SPIN_CAP) { atomicAdd(&(bar)[XB_TMO], 1u); break; } } } } while (0)
struct XcdBarrier { unsigned* bar; unsigned x; volatile LAS unsigned* st; };
__device__ __forceinline__ XcdBarrier xcd_barrier_post(unsigned* bar, volatile LAS unsigned* st) {
    XcdBarrier b; b.bar = bar; b.x = xb_xcc_id(); b.st = st;
    if (threadIdx.x == 0) (void)xb_add(&bar[XB_XCNT(b.x)], 1u);
    return b;
}
__device__ __forceinline__ void xcd_barrier_complete(unsigned* bar, unsigned x, unsigned& nloc, unsigned& nx) {
    const unsigned G = gridDim.x * gridDim.y * gridDim.z;
    unsigned sum, cnt, mine, sp = 0u;
    for (;;) {
        sum = 0u; cnt = 0u; mine = 0u;
#pragma unroll
        for (unsigned j = 0; j < 16; ++j) { const unsigned c = xb_ld(&bar[XB_XCNT(j)]); sum += c; cnt += (c > 0u) ? 1u : 0u; mine = (j == x) ? c : mine; }
        if (sum == G) break;
        __builtin_amdgcn_s_sleep(1);
        if ((++sp & 255u) == 0u) { if (xb_ld(&bar[XB_TMO])) break; if (sp > XB_SPIN_CAP) { atomicAdd(&bar[XB_TMO], 1u); break; } }
    }
    nloc = mine > 0u ? mine : 1u; nx = cnt > 0u ? cnt : 1u;
}
__device__ __forceinline__ void xcd_barrier(const XcdBarrier& b) {
    asm volatile("s_waitcnt vmcnt(0)" ::: "memory");
    __syncthreads();
    if (threadIdx.x == 0) {
        unsigned* bar = b.bar;
        __builtin_amdgcn_s_waitcnt(0);
        unsigned nloc = b.st[0], nx = b.st[1];
        if (nloc == 0u) { xcd_barrier_complete(bar, b.x, nloc, nx); b.st[0] = nloc; b.st[1] = nx; }
        const unsigned old = xb_add(&bar[XB_XSUB(b.x)], 1u);
        const unsigned gen = old / nloc;
        if (old + 1u == (gen + 1u) * nloc) {
            __builtin_amdgcn_fence(__ATOMIC_RELEASE, "agent");
            asm volatile("s_waitcnt vmcnt(0)" ::: "memory");
            const unsigned og = xb_add(&bar[XB_TOP], 1u);
            const unsigned tg = og / nx;
            if (og + 1u == (tg + 1u) * nx) xb_add(&bar[XB_TOPGEN], 1u);
            else XB_SPIN(xb_ld(&bar[XB_TOPGEN]) == tg, bar);
            __builtin_amdgcn_fence(__ATOMIC_ACQUIRE, "agent");
            xb_add(&bar[XB_XGEN(b.x)], 1u);
            asm volatile("s_waitcnt vmcnt(0)" ::: "memory");
        } else {
            XB_SPIN(xb_ld(&bar[XB_XGEN(b.x)]) == gen, bar);
            __builtin_amdgcn_fence(__ATOMIC_ACQUIRE, "agent");
            asm volatile("s_waitcnt vmcnt(0)" ::: "memory");
        }
    }
    __syncthreads();
}

namespace pg8 {
constexpr int BM = 256, BK = 64, HALF = 128, HTB = HALF * BK * 2, NXCD = 8, WGM = 8;
__device__ __forceinline__ int lds_byte(int r, int c) { const int st = (r >> 4) * 2 + (c >> 5), rr = r & 15, cc = c & 31, ob = rr * 64 + cc * 2; return st * 1024 + (ob ^ (((ob >> 9) & 1) << 5)); }
__device__ __forceinline__ void stage_rc(int b, int& R, int& C) { const int st = b / 1024, sb = b % 1024, swz = sb ^ (((sb >> 9) & 1) << 5); R = (st >> 1) * 16 + swz / 64; C = (st & 1) * 32 + (swz % 64) / 2; }
__device__ __forceinline__ int perm32(int rho) { const int n = rho >> 4, i = rho & 15; return 8 * (i >> 2) + 4 * n + (i & 3); }
struct Unit { int pm, pn, ko; };
struct Gemm { const bf16_t* A; const bf16_t* Bt; int M, N, K, lda, ldb; };
struct StaticOrder {
    int nM, nN, nwg, G, c;
    __device__ void init(int M, int N, int G_, int c_) { nM = M / BM; nN = N / BM; nwg = nM * nN; G = G_; c = c_; }
    __device__ bool next(int i, Unit& u) const {
        const long L = (long)i * G + c; if (L >= nwg) return false;
        int wgid = (int)L; { const int q = nwg / NXCD, r = nwg % NXCD, xcd = wgid % NXCD, off = wgid / NXCD; wgid = (xcd < r ? xcd * (q + 1) : r * (q + 1) + (xcd - r) * q) + off; }
        const int nig = WGM * nN, gid = wgid / nig, fm = gid * WGM, gsz = (nM - fm) < WGM ? (nM - fm) : WGM;
        u.pm = fm + ((wgid % nig) % gsz); u.pn = (wgid % nig) / gsz; u.ko = 0; return true;
    }
};
struct SplitOrder {
    int nu, c, K;
    __device__ bool next(int i, Unit& u) const { if (i != 0 || c >= nu) return false; u.pm = 0; u.pn = c & 3; u.ko = (c >> 2) * K; return true; }
};
template <class Epi, class Sched, bool SCALE = false>
__device__ __forceinline__ void gemm_phase(LAS unsigned char* lds, const Gemm g, const Sched& S, const Epi& E, const LAS float* sctab = nullptr) {
    const int tid = threadIdx.x, wid = __builtin_amdgcn_readfirstlane(tid >> 6), lane = tid & 63, wr = wid >> 2, wc = wid & 3, fr = lane & 15, fq = lane >> 4;
    const int K = g.K, nt = K / BK;
    unsigned voffA[2], voffB[2];
#pragma unroll
    for (int i = 0; i < 2; ++i) { int R, C; stage_rc(tid * 16 + i * 8192, R, C); const int Rb = Epi::PERM ? ((R & ~31) + perm32(R & 31)) : R;
        voffA[i] = (unsigned)(R * g.lda + C) * 2u; voffB[i] = (unsigned)(Rb * g.ldb + C) * 2u; }
    const size_t kstep = (size_t)(BK * 2);
    const size_t hstepA = (size_t)HALF * g.lda * 2, hstepB = (size_t)HALF * g.ldb * 2;
    const size_t tstepA = 2 * hstepA, tstepB = 2 * hstepB;
    const unsigned ldsw = (unsigned)wid * 1024u;
    const int aoff = lds_byte(wr * 64 + fr, fq * 8), boff = lds_byte(wc * 32 + fr, fq * 8);
#define PG8_SA(b, h) (((b) * 2 + (h)) * HTB)
#define PG8_SB(b, h) ((4 + (b) * 2 + (h)) * HTB)
#define PG8_STAGE(bufoff, gbase, voff) do { _Pragma("unroll") for (int _i = 0; _i < 2; ++_i) \
        __builtin_amdgcn_global_load_lds((const unsigned*)((const char*)(gbase) + (voff)[_i]), (LAS unsigned*)(lds + (bufoff) + ldsw + _i * 8192), 16, 0, 0); } while (0)
#define PG8_LDA(dst, b, h) do { _Pragma("unroll") for (int m = 0; m < 4; ++m) _Pragma("unroll") for (int k = 0; k < 2; ++k) dst[m][k] = *(const LAS bf16x8*)(lds + PG8_SA(b, h) + aoff + m * 2048 + k * 1024); } while (0)
#define PG8_LDB(dst, b, h) do { _Pragma("unroll") for (int n = 0; n < 2; ++n) _Pragma("unroll") for (int k = 0; k < 2; ++k) dst[n][k] = *(const LAS bf16x8*)(lds + PG8_SB(b, h) + boff + n * 2048 + k * 1024); } while (0)
#define PG8_MMA(ai, bj, At, Bt) do { __builtin_amdgcn_s_setprio(1); _Pragma("unroll") for (int m = 0; m < 4; ++m) _Pragma("unroll") for (int n = 0; n < 2; ++n) _Pragma("unroll") for (int k = 0; k < 2; ++k) \
        acc[ai][bj][m][n] = __builtin_amdgcn_mfma_f32_16x16x32_bf16(Bt[n][k], At[m][k], acc[ai][bj][m][n], 0, 0, 0); __builtin_amdgcn_s_setprio(0); } while (0)
#define PG8_WAIT_V(n) asm volatile("s_waitcnt vmcnt(" #n ")" ::: "memory")
#define PG8_WAIT_L(n) asm volatile("s_waitcnt lgkmcnt(" #n ")" ::: "memory")
#define PG8_BAR __builtin_amdgcn_s_barrier()
#define PG8_SCHED __builtin_amdgcn_sched_barrier(0)
    Unit cur, nxt; int ui = 0;
    if (!S.next(0, cur)) return;
    f32x4 acc[2][2][4][2];
#pragma unroll
    for (int a = 0; a < 2; ++a)
#pragma unroll
        for (int b = 0; b < 2; ++b)
#pragma unroll
            for (int m = 0; m < 4; ++m)
#pragma unroll
                for (int n = 0; n < 2; ++n) acc[a][b][m][n] = (f32x4){0.f, 0.f, 0.f, 0.f};
    bf16x8 At[4][2], B0[2][2], B1[2][2];
    const char* cA = (const char*)g.A + (size_t)cur.pm * tstepA + (size_t)cur.ko * 2; const char* cB = (const char*)g.Bt + (size_t)cur.pn * tstepB + (size_t)cur.ko * 2;
    PG8_STAGE(PG8_SB(0, 0), cB, voffB); PG8_STAGE(PG8_SA(0, 0), cA, voffA); PG8_STAGE(PG8_SB(0, 1), cB + hstepB, voffB); PG8_STAGE(PG8_SA(0, 1), cA + hstepA, voffA);
    if (wr == 1) PG8_BAR;
    PG8_WAIT_V(4); PG8_BAR;
    PG8_STAGE(PG8_SB(1, 0), cB + kstep, voffB); PG8_STAGE(PG8_SA(1, 0), cA + kstep, voffA); PG8_STAGE(PG8_SB(1, 1), cB + hstepB + kstep, voffB);
    PG8_WAIT_V(6); PG8_BAR;
    for (;;) {
        const bool has_next = S.next(ui + 1, nxt);
        const char* nA = has_next ? (const char*)g.A + (size_t)nxt.pm * tstepA + (size_t)nxt.ko * 2 : cA; const char* nB = has_next ? (const char*)g.Bt + (size_t)nxt.pn * tstepB + (size_t)nxt.ko * 2 : cB;
        for (int t = 0; t < nt; t += 2) {
            const bool last = (t == nt - 2);
            const char* a1 = cA + (size_t)(t + 1) * kstep;
            const char* a2 = last ? nA : cA + (size_t)(t + 2) * kstep; const char* b2 = last ? nB : cB + (size_t)(t + 2) * kstep;
            const char* a3 = a2 + kstep; const char* b3 = b2 + kstep;
            if (SCALE && (t == 8 || t == 16)) {
                const LAS float* tb = sctab + (t == 8 ? 0 : 256) + wr * 64 + fr;
#pragma unroll
                for (int ai = 0; ai < 2; ++ai)
#pragma unroll
                    for (int m = 0; m < 4; ++m) { const float sv = tb[ai * 128 + m * 16];
#pragma unroll
                        for (int bj = 0; bj < 2; ++bj)
#pragma unroll
                            for (int n = 0; n < 2; ++n) acc[ai][bj][m][n] *= sv; }
                PG8_WAIT_L(0); PG8_SCHED;
            }
            PG8_LDB(B0, 0, 0); PG8_SCHED; PG8_LDA(At, 0, 0); PG8_STAGE(PG8_SA(1, 1), a1 + hstepA, voffA);
            PG8_WAIT_L(8); PG8_BAR; PG8_WAIT_L(0); PG8_MMA(0, 0, At, B0); PG8_BAR; PG8_SCHED;
            PG8_LDB(B1, 0, 1); PG8_STAGE(PG8_SB(0, 0), b2, voffB);
            PG8_BAR; PG8_WAIT_L(0); PG8_MMA(0, 1, At, B1); PG8_BAR;
            PG8_LDA(At, 0, 1); PG8_STAGE(PG8_SA(0, 0), a2, voffA);
            PG8_BAR; PG8_WAIT_L(0); PG8_MMA(1, 0, At, B0); PG8_BAR; PG8_SCHED;
            PG8_STAGE(PG8_SB(0, 1), b2 + hstepB, voffB);
            PG8_WAIT_V(6); PG8_BAR; PG8_MMA(1, 1, At, B1); PG8_BAR;
            PG8_LDB(B0, 1, 0); PG8_SCHED; PG8_LDA(At, 1, 0); PG8_STAGE(PG8_SA(0, 1), a2 + hstepA, voffA);
            PG8_WAIT_L(8); PG8_BAR; PG8_WAIT_L(0); PG8_MMA(0, 0, At, B0); PG8_BAR; PG8_SCHED;
            PG8_LDB(B1, 1, 1); PG8_STAGE(PG8_SB(1, 0), b3, voffB);
            PG8_BAR; PG8_WAIT_L(0); PG8_MMA(0, 1, At, B1); PG8_BAR;
            PG8_LDA(At, 1, 1); PG8_STAGE(PG8_SA(1, 0), a3, voffA);
            PG8_BAR; PG8_WAIT_L(0); PG8_MMA(1, 0, At, B0); PG8_BAR; PG8_SCHED;
            PG8_STAGE(PG8_SB(1, 1), b3 + hstepB, voffB);
            PG8_WAIT_V(6); PG8_BAR; PG8_MMA(1, 1, At, B1); PG8_BAR;
        }
        E(acc, cur, wr, wc, fr, fq);
        if (!has_next) break;
#pragma unroll
        for (int a = 0; a < 2; ++a)
#pragma unroll
            for (int b = 0; b < 2; ++b)
#pragma unroll
                for (int m = 0; m < 4; ++m)
#pragma unroll
                    for (int n = 0; n < 2; ++n) acc[a][b][m][n] = (f32x4){0.f, 0.f, 0.f, 0.f};
        cur = nxt; cA = nA; cB = nB; ++ui;
    }
    PG8_WAIT_V(0);
    if (wr == 0) PG8_BAR;
    PG8_BAR;
#undef PG8_SA
#undef PG8_SB
#undef PG8_STAGE
#undef PG8_LDA
#undef PG8_LDB
#undef PG8_MMA
#undef PG8_WAIT_V
#undef PG8_WAIT_L
#undef PG8_BAR
#undef PG8_SCHED
}
}

__device__ __forceinline__ float dpp_ror1(float v) { return __builtin_bit_cast(float, __builtin_amdgcn_update_dpp(0, __builtin_bit_cast(int, v), 0x121, 0xF, 0xF, true)); }
__device__ __forceinline__ float dpp_ror2(float v) { return __builtin_bit_cast(float, __builtin_amdgcn_update_dpp(0, __builtin_bit_cast(int, v), 0x122, 0xF, 0xF, true)); }
struct EpiIn {
    static constexpr bool PERM = true;
    bf16_t* mix; bf16_t* xbc; const float* rstd; float* uf; float* ul; float* gbf; const float* cw; const float* st; float* sout; LAS float* xch;
    __device__ __forceinline__ void operator()(const f32x4 (&acc)[2][2][4][2], const pg8::Unit& u, int wr, int wc, int fr_, int fq_) const {
        int fr = fr_, fq = fq_; asm volatile("" : "+v"(fr), "+v"(fq));
        const int row0 = u.pm * 256 + wr * 64 + fr;
        float rs[2][4];
#pragma unroll
        for (int ai = 0; ai < 2; ++ai)
#pragma unroll
            for (int m = 0; m < 4; ++m) rs[ai][m] = rstd[row0 + ai * 128 + m * 16];
        if (u.pn >= 16) {
            bf16_t* base = xbc + (u.pn - 16) * 256 + wc * 32 + 8 * fq;
#pragma unroll
            for (int ai = 0; ai < 2; ++ai)
#pragma unroll
                for (int m = 0; m < 4; ++m) { bf16_t* rp = base + (size_t)(row0 + ai * 128 + m * 16) * XBC;
#pragma unroll
                    for (int bj = 0; bj < 2; ++bj) { const f32x4 v0 = acc[ai][bj][m][0] * rs[ai][m], v1 = acc[ai][bj][m][1] * rs[ai][m];
                        u32x4 w; w.x = cvt_pk_bf16(v0[0], v0[1]); w.y = cvt_pk_bf16(v0[2], v0[3]); w.z = cvt_pk_bf16(v1[0], v1[1]); w.w = cvt_pk_bf16(v1[2], v1[3]);
                        *(u32x4*)(rp + bj * 128) = w; } }
            return;
        }
        const int cl = wc * 16 + 4 * fq, jj = u.pn * 64 + cl;
        const f32x4 w0 = *(const f32x4*)(cw + jj), w1 = *(const f32x4*)(cw + 1024 + jj), w2 = *(const f32x4*)(cw + 2048 + jj);
        if (u.pm == 64) {
#pragma unroll
            for (int m = 0; m < 4; ++m) { const int bs = wr * 64 + m * 16 + fr; const float r = rs[0][m];
                const f32x4 s0 = *(const f32x4*)(st + (size_t)(bs * 2) * 1024 + jj), s1 = *(const f32x4*)(st + (size_t)(bs * 2 + 1) * 1024 + jj);
                const f32x4 gb = acc[0][0][m][0] * r, uu = acc[0][0][m][1] * acc[0][1][m][0] * (r * r), zz = acc[0][1][m][1] * r;
                const f32x4 ys = gb * (s0 * w0 + s1 * w1 + uu * w2);
                *(f32x4*)(sout + (size_t)(bs * 2) * 1024 + jj) = s1; *(f32x4*)(sout + (size_t)(bs * 2 + 1) * 1024 + jj) = uu;
                bf16_t* rp = mix + (size_t)(TPR + bs) * 2048 + jj;
                u32x2 oz, oy; oz.x = cvt_pk_bf16(zz[0], zz[1]); oz.y = cvt_pk_bf16(zz[2], zz[3]); oy.x = cvt_pk_bf16(ys[0], ys[1]); oy.y = cvt_pk_bf16(ys[2], ys[3]);
                *(u32x2*)rp = oz; *(u32x2*)(rp + 1024) = oy; }
            return;
        }
        if (fr >= 14) {
#pragma unroll
            for (int ai = 0; ai < 2; ++ai) { const float r = rs[ai][3]; *(LAS f32x4*)(xch + ((2 * ai + wr) * 2 + (fr - 14)) * 64 + cl) = acc[ai][0][3][1] * acc[ai][1][3][0] * (r * r); }
            if (wr == 1) { const float r = rs[1][3]; *(f32x4*)(ul + (size_t)(u.pm * 2 + (fr - 14)) * 1024 + jj) = acc[1][0][3][1] * acc[1][1][3][0] * (r * r); }
        }
        if (fr < 2 && wr == 0) { const float r = rs[0][0];
            *(f32x4*)(uf + (size_t)(u.pm * 2 + fr) * 1024 + jj) = acc[0][0][0][1] * acc[0][1][0][0] * (r * r); *(f32x4*)(gbf + (size_t)(u.pm * 2 + fr) * 1024 + jj) = acc[0][0][0][0] * r; }
        asm volatile("s_waitcnt lgkmcnt(0)" ::: "memory"); __builtin_amdgcn_s_barrier(); __builtin_amdgcn_s_barrier(); asm volatile("" ::: "memory");
        const bool f1 = fr >= 1, f2 = fr >= 2;
        bf16_t* mrow = mix + (size_t)row0 * 2048 + jj;
#pragma unroll
        for (int ai = 0; ai < 2; ++ai) {
            const int k = 2 * ai + wr;
            f32x4 p1, p2;
            if (k > 0) { const f32x4 X0 = *(const LAS f32x4*)(xch + ((k - 1) * 2 + 0) * 64 + cl), X1 = *(const LAS f32x4*)(xch + ((k - 1) * 2 + 1) * 64 + cl);
                p1 = X1;
#pragma unroll
                for (int e = 0; e < 4; ++e) p2[e] = fr == 1 ? X1[e] : X0[e]; }
            else { p1 = (f32x4){0.f, 0.f, 0.f, 0.f}; p2 = p1; }
#pragma unroll
            for (int m = 0; m < 4; ++m) { const float r = rs[ai][m];
                const f32x4 gb = acc[ai][0][m][0] * r, uu = acc[ai][0][m][1] * acc[ai][1][m][0] * (r * r), zz = acc[ai][1][m][1] * r;
                float ys[4];
#pragma unroll
                for (int e = 0; e < 4; ++e) { const float r1 = dpp_ror1(uu[e]), r2 = dpp_ror2(uu[e]);
                    const float um1 = f1 ? r1 : p1[e], um2 = f2 ? r2 : p2[e];
                    ys[e] = gb[e] * (um2 * w0[e] + um1 * w1[e] + uu[e] * w2[e]);
                    p1[e] = r1; p2[e] = r2; }
                u32x2 oz, oy; oz.x = cvt_pk_bf16(zz[0], zz[1]); oz.y = cvt_pk_bf16(zz[2], zz[3]); oy.x = cvt_pk_bf16(ys[0], ys[1]); oy.y = cvt_pk_bf16(ys[2], ys[3]);
                bf16_t* rp = mrow + (size_t)(ai * 128 + m * 16) * 2048;
                *(u32x2*)rp = oz; *(u32x2*)(rp + 1024) = oy; }
            asm volatile("" ::: "memory");
        }
    }
};
struct EpiFfnAct {
    static constexpr bool PERM = true;
    bf16_t* act; float* gfirst; float* glast; float* ufirst; const float* cw; const float* cb; const float* st; float* sout; LAS float* xch;
    __device__ __forceinline__ void operator()(const f32x4 (&acc)[2][2][4][2], const pg8::Unit& u, int wr, int wc, int fr_, int fq_) const {
        int fr = fr_, fq = fq_; asm volatile("" : "+v"(fr), "+v"(fq));
        const int cl = wc * 32 + 8 * fq, cg = u.pn * 128 + cl;
        if (u.pm == 64) {
#pragma unroll
            for (int n = 0; n < 2; ++n) { const f32x4 w0 = *(const f32x4*)(cw + cg + 4 * n), w1 = *(const f32x4*)(cw + DFF + cg + 4 * n), w2 = *(const f32x4*)(cw + 2 * DFF + cg + 4 * n), bb = *(const f32x4*)(cb + cg + 4 * n);
#pragma unroll
                for (int m = 0; m < 4; ++m) { const int bs = wr * 64 + m * 16 + fr;
                    const f32x4 s0 = *(const f32x4*)(st + (size_t)(bs * 2) * DFF + cg + 4 * n), s1 = *(const f32x4*)(st + (size_t)(bs * 2 + 1) * DFF + cg + 4 * n);
                    const f32x4 g = acc[0][0][m][n], up = acc[0][1][m][n]; const f32x4 cv = s0 * w0 + s1 * w1 + g * w2 + bb;
                    u32x2 o; o.x = cvt_pk_bf16(silu_f(cv[0]) * up[0], silu_f(cv[1]) * up[1]); o.y = cvt_pk_bf16(silu_f(cv[2]) * up[2], silu_f(cv[3]) * up[3]);
                    *(f32x4*)(sout + (size_t)(bs * 2) * DFF + cg + 4 * n) = s1; *(f32x4*)(sout + (size_t)(bs * 2 + 1) * DFF + cg + 4 * n) = g;
                    *(u32x2*)(act + (size_t)(TPR + bs) * DFF + cg + 4 * n) = o; } }
            return;
        }
        if (fr >= 14) {
#pragma unroll
            for (int ai = 0; ai < 2; ++ai)
#pragma unroll
                for (int n = 0; n < 2; ++n) *(LAS f32x4*)(xch + ((2 * ai + wr) * 2 + (fr - 14)) * 128 + cl + 4 * n) = acc[ai][0][3][n];
            if (wr == 1) {
#pragma unroll
                for (int n = 0; n < 2; ++n) *(f32x4*)(glast + (size_t)(u.pm * 2 + (fr - 14)) * DFF + cg + 4 * n) = acc[1][0][3][n]; }
        }
        if (fr < 2 && wr == 0) {
#pragma unroll
            for (int n = 0; n < 2; ++n) { *(f32x4*)(gfirst + (size_t)(u.pm * 2 + fr) * DFF + cg + 4 * n) = acc[0][0][0][n]; *(f32x4*)(ufirst + (size_t)(u.pm * 2 + fr) * DFF + cg + 4 * n) = acc[0][1][0][n]; }
        }
        f32x4 w0[2], w1[2], w2[2], bb[2];
#pragma unroll
        for (int n = 0; n < 2; ++n) { w0[n] = *(const f32x4*)(cw + cg + 4 * n); w1[n] = *(const f32x4*)(cw + DFF + cg + 4 * n); w2[n] = *(const f32x4*)(cw + 2 * DFF + cg + 4 * n); bb[n] = *(const f32x4*)(cb + cg + 4 * n); }
        asm volatile("s_waitcnt lgkmcnt(0)" ::: "memory"); __builtin_amdgcn_s_barrier(); __builtin_amdgcn_s_barrier(); asm volatile("" ::: "memory");
        const bool f1 = fr >= 1, f2 = fr >= 2;
        bf16_t* arow = act + (size_t)(u.pm * 256 + wr * 64 + fr) * DFF + cg;
#pragma unroll
        for (int ai = 0; ai < 2; ++ai) {
            const int k = 2 * ai + wr;
            u32x2 o0[4];
#pragma unroll
            for (int n = 0; n < 2; ++n) {
                f32x4 p1, p2;
                if (k > 0) { const f32x4 X0 = *(const LAS f32x4*)(xch + ((k - 1) * 2 + 0) * 128 + cl + 4 * n), X1 = *(const LAS f32x4*)(xch + ((k - 1) * 2 + 1) * 128 + cl + 4 * n);
                    p1 = X1;
#pragma unroll
                    for (int e = 0; e < 4; ++e) p2[e] = fr == 1 ? X1[e] : X0[e]; }
                else { p1 = (f32x4){0.f, 0.f, 0.f, 0.f}; p2 = p1; }
#pragma unroll
                for (int m = 0; m < 4; ++m) { const f32x4 g = acc[ai][0][m][n], up = acc[ai][1][m][n]; float a[4];
#pragma unroll
                    for (int e = 0; e < 4; ++e) { const float r1 = dpp_ror1(g[e]), r2 = dpp_ror2(g[e]);
                        const float gm1 = f1 ? r1 : p1[e], gm2 = f2 ? r2 : p2[e];
                        a[e] = silu_f(gm2 * w0[n][e] + gm1 * w1[n][e] + g[e] * w2[n][e] + bb[n][e]) * up[e];
                        p1[e] = r1; p2[e] = r2; }
                    u32x2 o; o.x = cvt_pk_bf16(a[0], a[1]); o.y = cvt_pk_bf16(a[2], a[3]);
                    if (n == 0) o0[m] = o;
                    else { u32x4 w; w.x = o0[m].x; w.y = o0[m].y; w.z = o.x; w.w = o.y; *(u32x4*)(arow + (size_t)(ai * 128 + m * 16) * DFF) = w; } }
            }
            asm volatile("" ::: "memory");
        }
    }
};
struct EpiRes {
    static constexpr bool PERM = false;
    const float* bf; const bf16_t* b16; bf16_t* o16;
    __device__ __forceinline__ void operator()(const f32x4 (&acc)[2][2][4][2], const pg8::Unit& u, int wr, int wc, int fr_, int fq_) const {
        int fr = fr_, fq = fq_; asm volatile("" : "+v"(fr), "+v"(fq));
        const size_t off0 = (size_t)(u.pm * 256 + wr * 64 + fr) * 1024 + u.pn * 256 + wc * 32 + 4 * fq;
#pragma unroll
        for (int ai = 0; ai < 2; ++ai) {
            f32x4 bv[4][2][2];
            if (bf) {
#pragma unroll
                for (int m = 0; m < 4; ++m)
#pragma unroll
                    for (int bj = 0; bj < 2; ++bj)
#pragma unroll
                        for (int n = 0; n < 2; ++n) bv[m][bj][n] = *(const f32x4*)(bf + off0 + (size_t)(ai * 128 + m * 16) * 1024 + bj * 128 + n * 16);
            } else {
                u32x2 br[4][2][2];
#pragma unroll
                for (int m = 0; m < 4; ++m)
#pragma unroll
                    for (int bj = 0; bj < 2; ++bj)
#pragma unroll
                        for (int n = 0; n < 2; ++n) br[m][bj][n] = *(const u32x2*)(b16 + off0 + (size_t)(ai * 128 + m * 16) * 1024 + bj * 128 + n * 16);
#pragma unroll
                for (int m = 0; m < 4; ++m)
#pragma unroll
                    for (int bj = 0; bj < 2; ++bj)
#pragma unroll
                        for (int n = 0; n < 2; ++n) bv[m][bj][n] = (f32x4){bf_lo(br[m][bj][n].x), bf_hi(br[m][bj][n].x), bf_lo(br[m][bj][n].y), bf_hi(br[m][bj][n].y)};
            }
#pragma unroll
            for (int m = 0; m < 4; ++m)
#pragma unroll
                for (int bj = 0; bj < 2; ++bj)
#pragma unroll
                    for (int n = 0; n < 2; ++n) { const f32x4 o = bv[m][bj][n] + acc[ai][bj][m][n]; u32x2 pk; pk.x = cvt_pk_bf16(o[0], o[1]); pk.y = cvt_pk_bf16(o[2], o[3]);
                        *(u32x2*)(o16 + off0 + (size_t)(ai * 128 + m * 16) * 1024 + bj * 128 + n * 16) = pk; }
            asm volatile("" ::: "memory");
        }
    }
};
struct EpiSlab {
    static constexpr bool PERM = false;
    float* slab;
    __device__ __forceinline__ void operator()(const f32x4 (&acc)[2][2][4][2], const pg8::Unit& u, int wr, int wc, int fr, int fq) const {
        const int col0 = u.pn * 256 + wc * 32 + 4 * fq;
        float* sb = slab + (size_t)(u.ko >> 8) * (128 * 1024);
#pragma unroll
        for (int m = 0; m < 4; ++m) { float* o = sb + (size_t)(wr * 64 + m * 16 + fr) * 1024 + col0;
#pragma unroll
            for (int bj = 0; bj < 2; ++bj)
#pragma unroll
                for (int n = 0; n < 2; ++n) *(f32x4*)(o + bj * 128 + n * 16) = acc[0][bj][m][n]; }
    }
};

struct Params {
    const float* x_prompt; const float* x_sample; const float* state_ssm; const float* state_ssd_conv; const float* state_sc; const float* state_ffn;
    const float* norm_mix_w; const float* w_in; const float* ssd_conv_w; const float* ssd_conv_b; const float* dt_bias; const float* a_log; const float* ssd_d; const float* ssd_norm_w;
    const float* sc_conv_w; const float* w_out; const float* norm_ffn_w; const float* w_ffn_in; const float* ffn_conv_w; const float* ffn_conv_b; const float* w_down; const float* norm_final_w;
    float* out; unsigned char* ws; int ph_lo, ph_hi;
};

__device__ __forceinline__ int map_in4(int jd) {
    const int T = jd >> 8, L = jd & 255;
    if (T >= 16) return 1024 + (T - 16) * 256 + L;
    const int bj = L >> 7, wc = (L >> 5) & 3, fq = (L >> 3) & 3, n = (L >> 2) & 1, jj = T * 64 + wc * 16 + fq * 4;
    return (bj == 0 ? (n == 0 ? 2576 : 3600) : (n == 0 ? 4624 : 0)) + jj;
}
__device__ __forceinline__ int map_in_old(int j0) {
    if (j0 < 2560) return j0;
    if (j0 < 3584) return 2576 + (j0 - 2560);
    const int k = (j0 - 3584) >> 8, w = (j0 - 3584) & 255;
    return w < 128 ? 3600 + k * 128 + w : 4624 + k * 128 + (w - 128);
}
__device__ __forceinline__ void p0_chunk(const Params& P, LAS unsigned char* lds, int ci) {
    const int tid = threadIdx.x, lane = tid & 63, wid = tid >> 6, r16 = lane & 15, q = lane >> 4;
    LAS bf16_t* wdt = (LAS bf16_t*)lds;
    LAS float* dts = (LAS float*)(lds + 33024);
    LAS float* segs = (LAS float*)(lds + 33024 + 8192);
    LAS float* nws = (LAS float*)(lds + 33024 + 8192 + 1024);
    *(LAS float*)(nws + tid) = P.norm_mix_w[tid]; *(LAS float*)(nws + 512 + tid) = P.norm_mix_w[512 + tid];
#pragma unroll
    for (int i = 0; i < 8; ++i) { const int k = (tid >> 2) + 128 * i, c4 = (tid & 3) * 4; const f32x4 v = *(const f32x4*)(P.w_in + (size_t)k * DINP + 2560 + c4);
        wdt[(c4 + 0) * 1032 + k] = f2bf(v[0]); wdt[(c4 + 1) * 1032 + k] = f2bf(v[1]); wdt[(c4 + 2) * 1032 + k] = f2bf(v[2]); wdt[(c4 + 3) * 1032 + k] = f2bf(v[3]); }
    __syncthreads();
    const int row = ci * 128 + wid * 16 + r16;
    const float* src = (row < TPR ? P.x_prompt + (size_t)row * 1024 : P.x_sample + (size_t)(row - TPR) * 1024) + 8 * q;
    bf16_t* dst = (bf16_t*)(P.ws + WS_A1) + (size_t)row * 1024 + 8 * q;
    const LAS float* nw = nws + 8 * q;
    f32x4 acc = (f32x4){0.f, 0.f, 0.f, 0.f};
    float ss = 0.f;
    f32x4 xa[2][8], xb[2][8];
#pragma unroll
    for (int u = 0; u < 8; ++u) { xa[0][u] = __builtin_nontemporal_load((const f32x4*)(src + 32 * u)); xb[0][u] = __builtin_nontemporal_load((const f32x4*)(src + 32 * u + 4)); }
#pragma unroll
    for (int bt = 0; bt < 4; ++bt) { const int s0 = 8 * bt;
        if (bt < 3) {
#pragma unroll
            for (int u = 0; u < 8; ++u) { xa[(bt + 1) & 1][u] = __builtin_nontemporal_load((const f32x4*)(src + 32 * (s0 + 8 + u))); xb[(bt + 1) & 1][u] = __builtin_nontemporal_load((const f32x4*)(src + 32 * (s0 + 8 + u) + 4)); } }
#pragma unroll
        for (int u = 0; u < 8; ++u) { const int sidx = s0 + u; const f32x4 wa = *(const LAS f32x4*)(nw + 32 * sidx), wb = *(const LAS f32x4*)(nw + 32 * sidx + 4);
            const f32x4 a = xa[bt & 1][u], b = xb[bt & 1][u];
            ss += a[0] * a[0] + a[1] * a[1] + a[2] * a[2] + a[3] * a[3] + b[0] * b[0] + b[1] * b[1] + b[2] * b[2] + b[3] * b[3];
            const f32x4 ya = a * wa, yb = b * wb;
            u32x4 pk; pk.x = cvt_pk_bf16(ya[0], ya[1]); pk.y = cvt_pk_bf16(ya[2], ya[3]); pk.z = cvt_pk_bf16(yb[0], yb[1]); pk.w = cvt_pk_bf16(yb[2], yb[3]);
            *(u32x4*)(dst + 32 * sidx) = pk;
            const bf16x8 bfr = *(const LAS bf16x8*)(wdt + r16 * 1032 + 32 * sidx + 8 * q);
            acc = __builtin_amdgcn_mfma_f32_16x16x32_bf16(__builtin_bit_cast(bf16x8, pk), bfr, acc, 0, 0, 0); }
    }
    ss += __shfl_xor(ss, 16); ss += __shfl_xor(ss, 32);
    const float rstd = rsqrtf(ss * (1.0f / 1024.0f) + EPS);
    if (q == 0) ((float*)(P.ws + WS_RSTD))[row] = rstd;
#pragma unroll
    for (int j = 0; j < 4; ++j) acc[j] *= __shfl(rstd, 4 * q + j);
    { const float bias = P.dt_bias[r16];
#pragma unroll
      for (int j = 0; j < 4; ++j) dts[(wid * 16 + 4 * q + j) * 16 + r16] = softplus_f(acc[j] + bias); }
    __syncthreads();
    if (ci < 128) {
        const int b = ci >> 4, c = ci & 15, h = tid & 15, seg = (tid >> 4) & 15;
        float d[8], cs[8];
        if (tid < 256) { const float a = -__expf(P.a_log[h]); float run = 0.f;
#pragma unroll
            for (int i = 0; i < 8; ++i) { d[i] = dts[(seg * 8 + i) * 16 + h]; run += d[i] * a; cs[i] = run; }
            segs[seg * 16 + h] = run; }
        __syncthreads();
        if (tid < 256) { float pre = 0.f;
#pragma unroll
            for (int s2 = 0; s2 < 16; ++s2) pre += (s2 < seg) ? segs[s2 * 16 + h] : 0.f;
#pragma unroll
            for (int i = 0; i < 8; ++i) cs[i] += pre;
            const size_t o = (size_t)(b * 16 + h) * 2048 + c * 128 + seg * 8;
            st8f((float*)(P.ws + WS_DT) + o, d); st8f((float*)(P.ws + WS_ACUM) + o, cs); }
    } else {
        float* dtsg = (float*)(P.ws + WS_DTS);
        for (int i = tid; i < 2048; i += 512) dtsg[i] = dts[i];
    }
    __syncthreads();
}
__device__ __forceinline__ void tile_decode(const Params& P, int t, const float*& src, bf16_t*& dst, int& K, int& Ns, int& k0, int& n0, int& c0) {
    int kt, nt;
    if (t < 1408) { src = P.w_in; dst = (bf16_t*)(P.ws + WS_WIN); K = 1024; Ns = DINP; kt = t / 88; nt = t % 88; c0 = -1; }
    else if (t < 1920) { t -= 1408; src = P.w_out; dst = (bf16_t*)(P.ws + WS_WOUT); K = 2048; Ns = 1024; kt = t >> 4; nt = t & 15; c0 = nt * 64; }
    else if (t < 3328) { t -= 1920; src = P.w_ffn_in; dst = (bf16_t*)(P.ws + WS_WFFN); K = 1024; Ns = NIN; kt = t / 88; nt = t % 88; { const int j0 = nt * 64, k = j0 >> 8, w = j0 & 255; c0 = w < 128 ? k * 128 + w : DFF + k * 128 + (w - 128); } }
    else { t -= 3328; src = P.w_down; dst = (bf16_t*)(P.ws + WS_WDOWN); K = 2816; Ns = 1024; kt = t >> 4; nt = t & 15; c0 = nt * 64; }
    k0 = kt * 64; n0 = nt * 64;
}
__device__ __forceinline__ void conv_tiles(const Params& P, LAS unsigned char* lds, int tb, int te, int stride) {
    const int tid = threadIdx.x;
    LAS float* tl = (LAS float*)lds;
    for (int t4 = tb; t4 < te; t4 += 4 * stride) {
        f32x4 v[4][2];
#pragma unroll
        for (int u = 0; u < 4; ++u) { const int t = t4 + u * stride; if (t < te) { const float* src; bf16_t* dst; int K, Ns, k0, n0, c0; tile_decode(P, t, src, dst, K, Ns, k0, n0, c0);
            const int col = c0 < 0 ? map_in4(n0 + (tid & 15) * 4) : c0 + (tid & 15) * 4;
#pragma unroll
            for (int i = 0; i < 2; ++i) v[u][i] = *(const f32x4*)(src + (size_t)(k0 + (tid >> 4) + 32 * i) * Ns + col); } }
#pragma unroll
        for (int u = 0; u < 4; ++u) { const int t = t4 + u * stride; if (t < te) {
#pragma unroll
            for (int i = 0; i < 2; ++i) { const int kr = (tid >> 4) + 32 * i, c4 = (tid & 15) * 4; LAS float* d = tl + u * 4160 + kr * 65 + c4; d[0] = v[u][i][0]; d[1] = v[u][i][1]; d[2] = v[u][i][2]; d[3] = v[u][i][3]; } } }
        __syncthreads();
#pragma unroll
        for (int u = 0; u < 4; ++u) { const int t = t4 + u * stride; if (t < te) { const float* src; bf16_t* dst; int K, Ns, k0, n0, c0; tile_decode(P, t, src, dst, K, Ns, k0, n0, c0);
            const int n = tid >> 3, k8 = (tid & 7) * 8; float f[8];
#pragma unroll
            for (int i = 0; i < 8; ++i) f[i] = tl[u * 4160 + (k8 + i) * 65 + n];
            *(u32x4*)(dst + (size_t)(n0 + n) * K + k0 + k8) = pack8(f); } }
        __syncthreads();
    }
}
__device__ __forceinline__ void phase0(const Params& P, LAS unsigned char* lds) {
    const int G = gridDim.x, bx = blockIdx.x, NCI = 129;
    for (int ci = bx; ci < NCI; ci += G) p0_chunk(P, lds, ci);
    if (G > NCI) { if (bx >= NCI) conv_tiles(P, lds, bx - NCI, 1408, G - NCI); }
    else conv_tiles(P, lds, bx, 1408, G);
}
__device__ __forceinline__ void p1_late_tiles(const Params& P, LAS unsigned char* lds) {
    const int G = gridDim.x, bx = blockIdx.x, nwg = (TPAD / 256) * (NIN / 256), nfull = nwg % G;
    if (nfull > 0 && nfull < G) { if (bx >= nfull) conv_tiles(P, lds, 1408 + bx - nfull, 4032, G - nfull); }
    else conv_tiles(P, lds, 1408 + bx, 4032, G);
}

__device__ __forceinline__ void p2_conv_load(const Params& P, int item, u32x4 (&pre)[3]) {
    const int tid = threadIdx.x;
    const int strip = item % 24, bc = item / 24, b = bc >> 4, c = bc & 15, t0 = c * 128;
    const int colg = strip < 16 ? strip * 64 : (strip < 20 ? 1024 + (strip - 16) * 64 : 1280 + (strip - 20) * 64);
    const bf16_t* xbc = (const bf16_t*)(P.ws + WS_XBC);
#pragma unroll
    for (int k = 0; k < 3; ++k) { const int i = tid + 512 * k; pre[k] = (u32x4){0u, 0u, 0u, 0u};
        if (i < 131 * 8) { const int rr = i >> 3, c8 = (i & 7) * 8, tl = t0 - 3 + rr; if (tl >= 0) pre[k] = *(const u32x4*)(xbc + (size_t)(b * 2048 + tl) * XBC + colg + c8); } }
}
__device__ __forceinline__ void p2_conv_item(const Params& P, LAS unsigned char* lds, int item, int next_item, u32x4 (&pre)[3]) {
    const int tid = threadIdx.x;
    const int strip = item % 24, bc = item / 24, b = bc >> 4, c = bc & 15, t0 = c * 128;
    const int colg = strip < 16 ? strip * 64 : (strip < 20 ? 1024 + (strip - 16) * 64 : 1280 + (strip - 20) * 64);
    LAS bf16_t* raw = (LAS bf16_t*)lds;
    LAS bf16_t* outn = (LAS bf16_t*)(lds + 16768);
#pragma unroll
    for (int k = 0; k < 3; ++k) { const int i = tid + 512 * k; if (i < 131 * 8) *(LAS u32x4*)(raw + (i >> 3) * 64 + (i & 7) * 8) = pre[k]; }
    __syncthreads();
    if (next_item >= 0) p2_conv_load(P, next_item, pre);
    const int col = tid & 63, rg = tid >> 6;
    const float w0 = P.ssd_conv_w[colg + col], w1 = P.ssd_conv_w[XBC + colg + col], w2 = P.ssd_conv_w[2 * XBC + colg + col], w3 = P.ssd_conv_w[3 * XBC + colg + col], bs = P.ssd_conv_b[colg + col];
    float o[16];
    { float x0 = bf2f(raw[(rg * 16 + 0) * 64 + col]), x1 = bf2f(raw[(rg * 16 + 1) * 64 + col]), x2 = bf2f(raw[(rg * 16 + 2) * 64 + col]);
#pragma unroll
      for (int i = 0; i < 16; ++i) { const float x3 = bf2f(raw[(rg * 16 + i + 3) * 64 + col]); o[i] = silu_f(x0 * w0 + x1 * w1 + x2 * w2 + x3 * w3 + bs); x0 = x1; x1 = x2; x2 = x3; } }
    u32x4 pk0, pk1;
    pk0.x = cvt_pk_bf16(o[0], o[1]); pk0.y = cvt_pk_bf16(o[2], o[3]); pk0.z = cvt_pk_bf16(o[4], o[5]); pk0.w = cvt_pk_bf16(o[6], o[7]);
    pk1.x = cvt_pk_bf16(o[8], o[9]); pk1.y = cvt_pk_bf16(o[10], o[11]); pk1.z = cvt_pk_bf16(o[12], o[13]); pk1.w = cvt_pk_bf16(o[14], o[15]);
    LAS unsigned char* outT = lds + 16768 + 16384;
    if (strip < 20) { *(LAS u32x4*)(outT + col * 272 + rg * 32) = pk0; *(LAS u32x4*)(outT + col * 272 + rg * 32 + 16) = pk1; }
    if (strip >= 16) {
#pragma unroll
        for (int i = 0; i < 16; ++i) outn[(rg * 16 + i) * 64 + col] = f2bf(o[i]); }
    __syncthreads();
    if (strip < 20) {
        bf16_t* dT = strip < 16 ? (bf16_t*)(P.ws + WS_A1) + ((size_t)(b * 16 + strip) * 64) * 2048 + t0
                                : (bf16_t*)((unsigned char*)P.out + OS_BT) + ((size_t)(b * 2 + ((strip - 16) >> 1)) * 128 + ((strip - 16) & 1) * 64) * 2048 + t0;
        for (int i = tid; i < 1024; i += 512) { const int rr = i >> 4, c16 = i & 15; *(u32x4*)(dT + (size_t)rr * 2048 + c16 * 8) = *(const LAS u32x4*)(outT + rr * 272 + c16 * 16); }
    }
    if (strip >= 16) {
        const int sb = (strip - 16) & 3, g = sb >> 1, n0 = (sb & 1) * 64;
        bf16_t* nat = (bf16_t*)((unsigned char*)P.out + (strip < 20 ? OS_BN : OS_CN)) + ((size_t)(b * 2 + g) * 2048 + t0) * 128 + n0;
        for (int i = tid; i < 1024; i += 512) { const int rr = i >> 3, c8 = (i & 7) * 8; *(u32x4*)(nat + (size_t)rr * 128 + c8) = *(const LAS u32x4*)(outn + rr * 64 + c8); }
    }
    if (c == 15 && tid < 192) { const int rr = tid >> 6; P.out[O_PSSDC + (size_t)(b * 3 + rr) * XBC + colg + col] = bf2f(raw[(128 + rr) * 64 + col]); }
    __syncthreads();
}
__device__ __forceinline__ void p2_state_load(const Params& P, int item, int i0, f32x4 (&hv)[16]) {
    const int lane = threadIdx.x & 63, wid = threadIdx.x >> 6, bs = item >> 1, g = item & 1;
    const float* hin = P.state_ssm + ((size_t)(bs * 16 + g * 8 + wid) * 64 + (lane >> 5)) * 128 + 4 * (lane & 31);
#pragma unroll
    for (int i = 0; i < 16; ++i) hv[i] = __builtin_nontemporal_load((const f32x4*)(hin + (size_t)(i0 + i) * 256));
}
__device__ __forceinline__ void p2_sample_item(const Params& P, LAS unsigned char* lds, int item) {
    const int tid = threadIdx.x, lane = tid & 63, wid = tid >> 6;
    const int bs = item >> 1, g = item & 1, row = TPR + bs;
    LAS float* sx = (LAS float*)lds;
    const int half = lane >> 5, l32 = lane & 31;
    float* hout = P.out + O_SSSM + ((size_t)(bs * 16 + g * 8 + wid) * 64 + half) * 128 + 4 * l32;
    f32x4 hva[16]; p2_state_load(P, item, 0, hva);
    LAS float* ssqs = sx + 768;
    const bf16_t* xbc = (const bf16_t*)(P.ws + WS_XBC) + (size_t)row * XBC;
    bf16_t* mix = (bf16_t*)(P.ws + WS_MIX) + (size_t)row * 2048;
    for (int i = tid; i < 768; i += 512) {
        const int j = i < 512 ? g * 512 + i : (i < 640 ? 1024 + g * 128 + (i - 512) : 1280 + g * 128 + (i - 640));
        const float* st = P.state_ssd_conv + (size_t)bs * 3 * XBC + j;
        const float s0 = st[0], s1 = st[XBC], s2 = st[2 * XBC], xr = bf2f(xbc[j]);
        const float v = s0 * P.ssd_conv_w[j] + s1 * P.ssd_conv_w[XBC + j] + s2 * P.ssd_conv_w[2 * XBC + j] + xr * P.ssd_conv_w[3 * XBC + j] + P.ssd_conv_b[j];
        sx[i] = silu_f(v);
        float* so = P.out + O_SSSDC + (size_t)bs * 3 * XBC + j; so[0] = s1; so[XBC] = s2; so[2 * XBC] = xr;
    }
    __syncthreads();
    const int h = g * 8 + wid;
    const float dt = ((const float*)(P.ws + WS_DTS))[bs * 16 + h], a = -__expf(P.a_log[h]), dA = __expf(dt * a);
    const f32x4 Bv = *(const LAS f32x4*)(sx + 512 + 4 * l32), Cv = *(const LAS f32x4*)(sx + 640 + 4 * l32);
    float v[32];
#pragma unroll
    for (int i0 = 0; i0 < 32; i0 += 16) {
        f32x4 hv[16];
        if (i0 == 0) {
#pragma unroll
            for (int i = 0; i < 16; ++i) hv[i] = hva[i]; }
        else p2_state_load(P, item, 16, hv);
#pragma unroll
        for (int i = 0; i < 16; ++i) { const float xd = dt * sx[wid * 64 + 2 * (i0 + i) + half]; const f32x4 hn = dA * hv[i] + xd * Bv;
            __builtin_nontemporal_store(hn, (f32x4*)(hout + (size_t)(i0 + i) * 256));
            v[i0 + i] = hn[0] * Cv[0] + hn[1] * Cv[1] + hn[2] * Cv[2] + hn[3] * Cv[3]; }
    }
#pragma unroll
    for (int m = 16; m >= 1; m >>= 1) {
#pragma unroll
        for (int i = 0; i < m; ++i) { const bool up = (l32 & m) != 0; const float keep = up ? v[i + m] : v[i], send = up ? v[i] : v[i + m]; v[i] = keep + __shfl_xor(send, m); } }
    const int pl = 2 * l32 + half;
    const float ymine = v[0];
    const float xsv = sx[wid * 64 + pl];
    float y = ymine + P.ssd_d[h] * xsv;
    y *= silu_f(bf2f(mix[h * 64 + pl]));
    float sq = y * y;
    sq += __shfl_xor(sq, 1); sq += __shfl_xor(sq, 2); sq += __shfl_xor(sq, 4); sq += __shfl_xor(sq, 8); sq += __shfl_xor(sq, 16); sq += __shfl_xor(sq, 32);
    if (lane == 0) ssqs[wid] = sq;
    __syncthreads();
    float tot = 0.f;
#pragma unroll
    for (int i = 0; i < 8; ++i) tot += ssqs[i];
    const float rstd = rsqrtf(tot * (1.0f / 512.0f) + EPS);
    mix[h * 64 + pl] = f2bf(y * rstd * P.ssd_norm_w[h * 64 + pl]);
    __syncthreads();
}

__device__ __forceinline__ void p3_item(const Params& P, LAS unsigned char* lds, int item) {
    const int tid = threadIdx.x, lane = tid & 63, wid = tid >> 6, r16 = lane & 15, q = lane >> 4;
    const int b = item >> 5, c = (item >> 1) & 15, g = item & 1, h = g * 8 + wid, t0 = c * 128;
    LAS float* wsc = (LAS float*)lds + wid * 128;
    LAS unsigned char* btl = lds + 4096;
    const bf16_t* BTp = (const bf16_t*)((const unsigned char*)P.out + OS_BT) + ((size_t)(b * 2 + g) * 128) * 2048 + t0;
    u32x4 btr[4];
#pragma unroll
    for (int k = 0; k < 4; ++k) { const int i = tid + 512 * k; btr[k] = *(const u32x4*)(BTp + (size_t)(i >> 4) * 2048 + (i & 15) * 8); }
    const float* dtp = (const float*)(P.ws + WS_DT) + (size_t)(b * 16 + h) * 2048 + t0;
    const float* acp = (const float*)(P.ws + WS_ACUM) + (size_t)(b * 16 + h) * 2048 + t0;
    const float alast = acp[127];
    wsc[lane] = dtp[lane] * __expf(alast - acp[lane]); wsc[lane + 64] = dtp[lane + 64] * __expf(alast - acp[lane + 64]);
#pragma unroll
    for (int k = 0; k < 4; ++k) { const int i = tid + 512 * k; *(LAS u32x4*)(btl + (i >> 4) * 272 + (i & 15) * 16) = btr[k]; }
    __syncthreads();
    const bf16_t* xsT = (const bf16_t*)(P.ws + WS_A1) + ((size_t)(b * 16 + h) * 64) * 2048 + t0;
    f32x4 acc[8][4];
#pragma unroll
    for (int i = 0; i < 8; ++i)
#pragma unroll
        for (int j = 0; j < 4; ++j) acc[i][j] = (f32x4){0.f, 0.f, 0.f, 0.f};
#pragma unroll 2
    for (int kk = 0; kk < 4; ++kk) { const int s0 = 32 * kk + 8 * q;
        float sc[8]; { const f32x4 a = *(const LAS f32x4*)(wsc + s0), b2 = *(const LAS f32x4*)(wsc + s0 + 4); sc[0] = a[0]; sc[1] = a[1]; sc[2] = a[2]; sc[3] = a[3]; sc[4] = b2[0]; sc[5] = b2[1]; sc[6] = b2[2]; sc[7] = b2[3]; }
        bf16x8 bfr[4];
#pragma unroll
        for (int pt = 0; pt < 4; ++pt) { const u32x4 rawv = *(const u32x4*)(xsT + (size_t)(pt * 16 + r16) * 2048 + s0); float f[8]; unpack8(rawv, f);
#pragma unroll
            for (int j = 0; j < 8; ++j) f[j] *= sc[j];
            bfr[pt] = __builtin_bit_cast(bf16x8, pack8(f)); }
#pragma unroll
        for (int nt = 0; nt < 8; ++nt) { const bf16x8 afr = *(const LAS bf16x8*)(btl + (nt * 16 + r16) * 272 + s0 * 2);
#pragma unroll
            for (int pt = 0; pt < 4; ++pt) acc[nt][pt] = __builtin_amdgcn_mfma_f32_16x16x32_bf16(afr, bfr[pt], acc[nt][pt], 0, 0, 0); }
    }
    bf16_t* stp = (bf16_t*)((unsigned char*)P.out + OS_ST) + (((size_t)(b * 16 + c) * 16 + h) * 64) * 128;
#pragma unroll
    for (int nt = 0; nt < 8; ++nt)
#pragma unroll
        for (int pt = 0; pt < 4; ++pt) { u32x2 w; w.x = cvt_pk_bf16(acc[nt][pt][0], acc[nt][pt][1]); w.y = cvt_pk_bf16(acc[nt][pt][2], acc[nt][pt][3]);
            *(u32x2*)(stp + (size_t)(pt * 16 + r16) * 128 + nt * 16 + 4 * q) = w; }
    __syncthreads();
}

__device__ __forceinline__ void phase4(const Params& P) {
    const int tid = threadIdx.x, G = gridDim.x, bx = blockIdx.x;
    for (int idx = bx * 512 + tid; idx < 262144; idx += G * 512) {
        const int n4 = idx & 31, pp = (idx >> 5) & 63, h = (idx >> 11) & 15, b = idx >> 15;
        const float* acp = (const float*)(P.ws + WS_ACUM) + (size_t)(b * 16 + h) * 2048;
        f32x4 hs = (f32x4){0.f, 0.f, 0.f, 0.f};
        u32x2* ptr0 = (u32x2*)((bf16_t*)((unsigned char*)P.out + OS_ST) + ((((size_t)(b * 16) * 16 + h) * 64 + pp) * 128 + n4 * 4));
        u32x2 sv[16]; float dec[16];
#pragma unroll
        for (int c = 0; c < 16; ++c) { sv[c] = ptr0[(size_t)c * 32768]; dec[c] = acp[c * 128 + 127]; }
#pragma unroll
        for (int c = 0; c < 16; ++c) { u32x2 w; w.x = cvt_pk_bf16(hs[0], hs[1]); w.y = cvt_pk_bf16(hs[2], hs[3]); ptr0[(size_t)c * 32768] = w;
            const float d = __expf(dec[c]); const u32x2 sc = sv[c];
            hs[0] = d * hs[0] + bf_lo(sc.x); hs[1] = d * hs[1] + bf_hi(sc.x); hs[2] = d * hs[2] + bf_lo(sc.y); hs[3] = d * hs[3] + bf_hi(sc.y); }
        *(f32x4*)(P.out + O_PSSM + ((size_t)(b * 16 + h) * 64 + pp) * 128 + n4 * 4) = hs;
    }
}

__device__ __forceinline__ void p5_stage_load(const bf16_t* Hp, const bf16_t* xsT, u32x4 (&sr)[4]) {
    const int tid = threadIdx.x;
#pragma unroll
    for (int k = 0; k < 2; ++k) { const int i = tid + 512 * k, row = i >> 4, c16 = i & 15;
        sr[k] = *(const u32x4*)(Hp + (size_t)row * 128 + c16 * 8); sr[2 + k] = *(const u32x4*)(xsT + (size_t)row * 2048 + c16 * 8); }
}
__device__ __forceinline__ void p5_stage_write(LAS unsigned char* buf, const u32x4 (&sr)[4]) {
    const int tid = threadIdx.x;
#pragma unroll
    for (int k = 0; k < 2; ++k) { const int i = tid + 512 * k, row = i >> 4, c16 = i & 15;
        *(LAS u32x4*)(buf + row * 272 + c16 * 16) = sr[k]; *(LAS u32x4*)(buf + 17408 + row * 272 + c16 * 16) = sr[2 + k]; }
}
__device__ __forceinline__ void p5_item(const Params& P, LAS unsigned char* lds, int item) {
    const int tid = threadIdx.x, lane = tid & 63, w = __builtin_amdgcn_readfirstlane(tid >> 6), r16 = lane & 15, q = lane >> 4;
    const int b = item >> 5, c = (item >> 1) & 15, g = item & 1, t0 = c * 128, l0 = 16 * w;
    LAS float* acs = (LAS float*)lds;
    LAS float* dtl = acs + 1024;
    LAS unsigned char* sbuf = lds + 8192;
    LAS float* nwl = (LAS float*)(lds + 8192 + 69632);
    nwl[tid] = P.ssd_norm_w[g * 512 + tid];
    const bf16_t* Hbase = (const bf16_t*)((const unsigned char*)P.out + OS_ST) + (((size_t)(b * 16 + c) * 16 + g * 8) * 64) * 128;
    const bf16_t* Xbase = (const bf16_t*)(P.ws + WS_A1) + ((size_t)(b * 16 + g * 8) * 64) * 2048 + t0;
    u32x4 sr[4];
    p5_stage_load(Hbase, Xbase, sr);
    const bf16_t* Bn = (const bf16_t*)((const unsigned char*)P.out + OS_BN) + ((size_t)(b * 2 + g) * 2048 + t0) * 128;
    u32x4 bnr[4];
#pragma unroll
    for (int k = 0; k < 4; ++k) { const int i = tid + 512 * k; bnr[k] = *(const u32x4*)(Bn + (size_t)(i >> 4) * 128 + (i & 15) * 8); }
    if (tid < 256) { const size_t o = (size_t)(b * 16 + g * 8 + (tid >> 5)) * 2048 + t0 + (tid & 31) * 4;
      *(LAS f32x4*)(acs + tid * 4) = *(const f32x4*)((const float*)(P.ws + WS_ACUM) + o); *(LAS f32x4*)(dtl + tid * 4) = *(const f32x4*)((const float*)(P.ws + WS_DT) + o); }
    const bf16_t* Cn = (const bf16_t*)((const unsigned char*)P.out + OS_CN) + ((size_t)(b * 2 + g) * 2048 + t0) * 128;
    bf16x8 cfr[4];
#pragma unroll
    for (int kk = 0; kk < 4; ++kk) cfr[kk] = *(const bf16x8*)(Cn + (size_t)(l0 + r16) * 128 + 32 * kk + 8 * q);
    LAS unsigned char* bnl = sbuf + 34816;
#pragma unroll
    for (int k = 0; k < 4; ++k) { const int i = tid + 512 * k; *(LAS u32x4*)(bnl + (i >> 4) * 272 + (i & 15) * 16) = bnr[k]; }
    p5_stage_write(sbuf, sr);
    __syncthreads();
    f32x4 GT[8];
#pragma unroll
    for (int j = 0; j < 8; ++j) GT[j] = (f32x4){0.f, 0.f, 0.f, 0.f};
#pragma unroll
    for (int j = 0; j < 8; ++j) if (j <= w) {
#pragma unroll
        for (int kk = 0; kk < 4; ++kk) { const bf16x8 afr = *(const LAS bf16x8*)(bnl + (16 * j + r16) * 272 + 64 * kk + 16 * q); GT[j] = __builtin_amdgcn_mfma_f32_16x16x32_bf16(afr, cfr[kk], GT[j], 0, 0, 0); } }
    __syncthreads();
    const int lidx = l0 + r16;
    bf16_t* mixrow = (bf16_t*)(P.ws + WS_MIX) + (size_t)(b * 2048 + t0 + lidx) * 2048;
    float ssq = 0.f;
    if (PROBE_MASK && blockIdx.x == 0 && tid == 0) ((unsigned long long*)(P.ws + WS_BAR + 14336))[14] = __builtin_amdgcn_s_memrealtime();
#pragma unroll 1
    for (int r = 0; r < 8; ++r) {
        const int h = g * 8 + r;
        if (r < 7) p5_stage_load(Hbase + (size_t)(r + 1) * 8192, Xbase + (size_t)(r + 1) * 131072, sr);
        u32x2 zz[4];
#pragma unroll
        for (int pt = 0; pt < 4; ++pt) zz[pt] = *(const u32x2*)(mixrow + h * 64 + pt * 16 + 4 * q);
        const LAS unsigned char* Hb = sbuf + (r & 1) * 34816 + r16 * 272 + 16 * q;
        const LAS unsigned char* Xb = sbuf + (r & 1) * 34816 + 17408 + r16 * 272 + 8 * q;
        const float acl = acs[r * 128 + lidx], Dh = P.ssd_d[h];
        f32x4 acc[4];
#pragma unroll
        for (int pt = 0; pt < 4; ++pt) acc[pt] = (f32x4){0.f, 0.f, 0.f, 0.f};
#pragma unroll
        for (int kk = 0; kk < 4; ++kk)
#pragma unroll
            for (int pt = 0; pt < 4; ++pt) { const bf16x8 afr = *(const LAS bf16x8*)(Hb + pt * 4352 + kk * 64); acc[pt] = __builtin_amdgcn_mfma_f32_16x16x32_bf16(afr, cfr[kk], acc[pt], 0, 0, 0); }
        { const float el = __expf(acl);
#pragma unroll
          for (int pt = 0; pt < 4; ++pt) acc[pt] *= el; }
#pragma unroll
        for (int kk = 0; kk < 4; ++kk) if (2 * kk <= w) {
            const f32x4 asa = *(const LAS f32x4*)(acs + r * 128 + 32 * kk + 4 * q), dta = *(const LAS f32x4*)(dtl + r * 128 + 32 * kk + 4 * q);
            const f32x4 asb = *(const LAS f32x4*)(acs + r * 128 + 32 * kk + 16 + 4 * q), dtb = *(const LAS f32x4*)(dtl + r * 128 + 32 * kk + 16 + 4 * q);
            float m[8];
#pragma unroll
            for (int j = 0; j < 4; ++j) { const int s = 32 * kk + 4 * q + j; float v = GT[2 * kk][j] * __expf(fminf(acl - asa[j], 0.f)) * dta[j]; v = s > lidx ? 0.f : v; v = s == lidx ? v + Dh : v; m[j] = v; }
#pragma unroll
            for (int j = 0; j < 4; ++j) { const int s = 32 * kk + 16 + 4 * q + j; float v = GT[2 * kk + 1][j] * __expf(fminf(acl - asb[j], 0.f)) * dtb[j]; v = s > lidx ? 0.f : v; v = s == lidx ? v + Dh : v; m[4 + j] = v; }
            const bf16x8 bfr = __builtin_bit_cast(bf16x8, pack8(m));
#pragma unroll
            for (int pt = 0; pt < 4; ++pt) { const u32x2 lo = *(const LAS u32x2*)(Xb + pt * 4352 + kk * 64), hi = *(const LAS u32x2*)(Xb + pt * 4352 + kk * 64 + 32);
                u32x4 av; av.x = lo.x; av.y = lo.y; av.z = hi.x; av.w = hi.y;
                acc[pt] = __builtin_amdgcn_mfma_f32_16x16x32_bf16(__builtin_bit_cast(bf16x8, av), bfr, acc[pt], 0, 0, 0); }
        }
#pragma unroll
        for (int pt = 0; pt < 4; ++pt) {
            const float y0 = acc[pt][0] * silu_f(bf_lo(zz[pt].x)), y1 = acc[pt][1] * silu_f(bf_hi(zz[pt].x)), y2 = acc[pt][2] * silu_f(bf_lo(zz[pt].y)), y3 = acc[pt][3] * silu_f(bf_hi(zz[pt].y));
            ssq += y0 * y0 + y1 * y1 + y2 * y2 + y3 * y3;
            const f32x4 nw = *(const LAS f32x4*)(nwl + r * 64 + pt * 16 + 4 * q);
            u32x2 o; o.x = cvt_pk_bf16(y0 * nw[0], y1 * nw[1]); o.y = cvt_pk_bf16(y2 * nw[2], y3 * nw[3]); *(u32x2*)(mixrow + h * 64 + pt * 16 + 4 * q) = o; }
        if (r < 7) p5_stage_write(sbuf + ((r + 1) & 1) * 34816, sr);
        __syncthreads();
    }
    if (PROBE_MASK && blockIdx.x == 0 && tid == 0) ((unsigned long long*)(P.ws + WS_BAR + 14336))[15] = __builtin_amdgcn_s_memrealtime();
    ssq += __shfl_xor(ssq, 16); ssq += __shfl_xor(ssq, 32);
    const float rstd = rsqrtf(ssq * (1.0f / 512.0f) + EPS);
    if (q == 0) ((float*)(P.ws + WS_GRS))[(size_t)(b * 2048 + t0 + lidx) * 2 + g] = rstd;
    __syncthreads();
    if (PROBE_MASK && blockIdx.x == 0 && tid == 0) ((unsigned long long*)(P.ws + WS_BAR + 14336))[16] = __builtin_amdgcn_s_memrealtime();
}

__device__ __forceinline__ void rmsnorm_rows(float* srcf, const bf16_t* src16, const float* w, bf16_t* dstb, float* dstf, const float* slab, int nslab, const float* xs_base) {
    const int tid = threadIdx.x, lane = tid & 63, wid = tid >> 6;
    f32x4 wv[4];
#pragma unroll
    for (int i = 0; i < 4; ++i) wv[i] = *(const f32x4*)(w + lane * 4 + i * 256);
    for (int row = blockIdx.x * 8 + wid; row < TT; row += gridDim.x * 8) {
        f32x4 v[4];
        if (row < TPR) {
            u32x2 r[4];
#pragma unroll
            for (int i = 0; i < 4; ++i) r[i] = *(const u32x2*)(src16 + (size_t)row * 1024 + lane * 4 + i * 256);
#pragma unroll
            for (int i = 0; i < 4; ++i) v[i] = (f32x4){bf_lo(r[i].x), bf_hi(r[i].x), bf_lo(r[i].y), bf_hi(r[i].y)};
        } else {
            const float* s = (xs_base ? xs_base + (size_t)(row - TPR) * 1024 : srcf + (size_t)row * 1024) + lane * 4;
#pragma unroll
            for (int i = 0; i < 4; ++i) v[i] = *(const f32x4*)(s + i * 256);
            for (int k = 0; k < nslab; ++k) { const float* sp = slab + ((size_t)k * 128 + (row - TPR)) * 1024 + lane * 4;
#pragma unroll
                for (int i = 0; i < 4; ++i) v[i] += *(const f32x4*)(sp + i * 256); }
            if (xs_base) {
#pragma unroll
                for (int i = 0; i < 4; ++i) *(f32x4*)(srcf + (size_t)row * 1024 + lane * 4 + i * 256) = v[i]; }
        }
        float ss = 0.f;
#pragma unroll
        for (int i = 0; i < 4; ++i) ss += v[i][0] * v[i][0] + v[i][1] * v[i][1] + v[i][2] * v[i][2] + v[i][3] * v[i][3];
        ss += __shfl_xor(ss, 1); ss += __shfl_xor(ss, 2); ss += __shfl_xor(ss, 4); ss += __shfl_xor(ss, 8); ss += __shfl_xor(ss, 16); ss += __shfl_xor(ss, 32);
        const float rstd = rsqrtf(ss * (1.0f / 1024.0f) + EPS);
#pragma unroll
        for (int i = 0; i < 4; ++i) { const f32x4 o = v[i] * rstd * wv[i];
            if (dstb) { u32x2 pk; pk.x = cvt_pk_bf16(o[0], o[1]); pk.y = cvt_pk_bf16(o[2], o[3]); *(u32x2*)(dstb + (size_t)row * 1024 + lane * 4 + i * 256) = pk; }
            else __builtin_nontemporal_store(o, (f32x4*)(dstf + (size_t)row * 1024 + lane * 4 + i * 256)); }
    }
}

__device__ __forceinline__ void phase9_fix(const Params& P, int G, int bx) {
    const int tid = threadIdx.x;
    bf16_t* act = (bf16_t*)(P.ws + WS_UP);
    const float* gf = (const float*)(P.ws + WS_SBGF); const float* gl = (const float*)(P.ws + WS_SBGL); const float* uf = (const float*)(P.ws + WS_SBUF);
    pg8::StaticOrder S; S.init(TPR, 1024, G, bx); pg8::Unit u;
    for (int i = 0; S.next(i, u); ++i) {
        const int pm = u.pm;
        if ((pm & 7) == 0) continue;
        for (int idx = tid; idx < 704; idx += 512) { const int c4 = idx * 4;
            const f32x4 w0 = *(const f32x4*)(P.ffn_conv_w + c4), w1 = *(const f32x4*)(P.ffn_conv_w + DFF + c4), w2 = *(const f32x4*)(P.ffn_conv_w + 2 * DFF + c4), bb = *(const f32x4*)(P.ffn_conv_b + c4);
            const f32x4 gl0 = *(const f32x4*)(gl + (size_t)((pm - 1) * 2) * DFF + c4), gl1 = *(const f32x4*)(gl + (size_t)((pm - 1) * 2 + 1) * DFF + c4);
            const f32x4 gf0 = *(const f32x4*)(gf + (size_t)(pm * 2) * DFF + c4), gf1 = *(const f32x4*)(gf + (size_t)(pm * 2 + 1) * DFF + c4);
            const f32x4 u0 = *(const f32x4*)(uf + (size_t)(pm * 2) * DFF + c4), u1 = *(const f32x4*)(uf + (size_t)(pm * 2 + 1) * DFF + c4);
            const f32x4 c0 = gl0 * w0 + gl1 * w1 + gf0 * w2 + bb, c1 = gl1 * w0 + gf0 * w1 + gf1 * w2 + bb;
            u32x2 o0, o1;
            o0.x = cvt_pk_bf16(silu_f(c0[0]) * u0[0], silu_f(c0[1]) * u0[1]); o0.y = cvt_pk_bf16(silu_f(c0[2]) * u0[2], silu_f(c0[3]) * u0[3]);
            o1.x = cvt_pk_bf16(silu_f(c1[0]) * u1[0], silu_f(c1[1]) * u1[1]); o1.y = cvt_pk_bf16(silu_f(c1[2]) * u1[2], silu_f(c1[3]) * u1[3]);
            *(u32x2*)(act + (size_t)(pm * 256) * DFF + c4) = o0; *(u32x2*)(act + (size_t)(pm * 256 + 1) * DFF + c4) = o1; }
    }
    for (int idx = bx * 512 + tid; idx < 8 * 2 * 704; idx += G * 512) {
        const int b = idx / 1408, r = (idx / 704) & 1, c4 = (idx % 704) * 4;
        *(f32x4*)(P.out + O_PFFN + (size_t)(b * 2 + r) * DFF + c4) = *(const f32x4*)(gl + (size_t)((8 * b + 7) * 2 + r) * DFF + c4);
    }
    asm volatile("s_waitcnt vmcnt(0)" ::: "memory");
    __syncthreads();
}

__device__ __forceinline__ void phase6_fix(const Params& P, int G, int bx) {
    const int tid = threadIdx.x;
    bf16_t* mix = (bf16_t*)(P.ws + WS_MIX);
    const float* uf = (const float*)(P.ws + WS_SCUF); const float* ul = (const float*)(P.ws + WS_SCUL); const float* gbf = (const float*)(P.ws + WS_SCGF);
    pg8::StaticOrder S; S.init(TPR, 1024, G, bx); pg8::Unit u;
    for (int i = 0; S.next(i, u); ++i) {
        const int pm = u.pm;
        if ((pm & 7) == 0 || tid >= 256) continue;
        const int c4 = tid * 4;
        const f32x4 w0 = *(const f32x4*)(P.sc_conv_w + c4), w1 = *(const f32x4*)(P.sc_conv_w + 1024 + c4), w2 = *(const f32x4*)(P.sc_conv_w + 2048 + c4);
        const f32x4 ul0 = *(const f32x4*)(ul + (size_t)((pm - 1) * 2) * 1024 + c4), ul1 = *(const f32x4*)(ul + (size_t)((pm - 1) * 2 + 1) * 1024 + c4);
        const f32x4 uf0 = *(const f32x4*)(uf + (size_t)(pm * 2) * 1024 + c4), uf1 = *(const f32x4*)(uf + (size_t)(pm * 2 + 1) * 1024 + c4);
        const f32x4 g0 = *(const f32x4*)(gbf + (size_t)(pm * 2) * 1024 + c4), g1 = *(const f32x4*)(gbf + (size_t)(pm * 2 + 1) * 1024 + c4);
        const f32x4 y0 = g0 * (ul0 * w0 + ul1 * w1 + uf0 * w2), y1 = g1 * (ul1 * w0 + uf0 * w1 + uf1 * w2);
        u32x2 o0, o1; o0.x = cvt_pk_bf16(y0[0], y0[1]); o0.y = cvt_pk_bf16(y0[2], y0[3]); o1.x = cvt_pk_bf16(y1[0], y1[1]); o1.y = cvt_pk_bf16(y1[2], y1[3]);
        *(u32x2*)(mix + (size_t)(pm * 256) * 2048 + 1024 + c4) = o0; *(u32x2*)(mix + (size_t)(pm * 256 + 1) * 2048 + 1024 + c4) = o1;
    }
    for (int idx = bx * 512 + tid; idx < 8 * 2 * 256; idx += G * 512) {
        const int b = idx >> 9, r = (idx >> 8) & 1, c4 = (idx & 255) * 4;
        *(f32x4*)(P.out + O_PSC + (size_t)(b * 2 + r) * 1024 + c4) = *(const f32x4*)(ul + (size_t)((8 * b + 7) * 2 + r) * 1024 + c4);
    }
    asm volatile("s_waitcnt vmcnt(0)" ::: "memory");
    __syncthreads();
}

constexpr int NPHASE = 12;
static_assert(WS_END <= (size_t)256 * 1024 * 1024, "workspace map exceeds the guaranteed 256 MiB");
static_assert(WS_UP + (size_t)TPAD * 2816 * 2 <= WS_BAR, "act overlays only the dead xBC / MIX region");
__global__ void __launch_bounds__(512, 2) fwd_megakernel(Params P) {
    extern __shared__ __attribute__((aligned(16))) unsigned char lds_raw[];
    LAS unsigned char* lds = (LAS unsigned char*)lds_raw;
    volatile LAS unsigned* stw = (volatile LAS unsigned*)(lds + 131072);
    if (threadIdx.x < 4) stw[threadIdx.x] = 0u;
    __syncthreads();
    const XcdBarrier bar = xcd_barrier_post((unsigned*)(P.ws + WS_BAR), stw);
    const int lo = P.ph_lo, hi = P.ph_hi, G = gridDim.x, bx = blockIdx.x;
#define IN(k) (lo <= (k) && (k) < hi)
    unsigned long long* stamps = (unsigned long long*)(P.ws + WS_BAR + 14336);
#define STAMP(k) do { if (PROBE_MASK && bx == 0 && threadIdx.x == 0) stamps[k] = __builtin_amdgcn_s_memrealtime(); } while (0)
    STAMP(0);
#define SEAM(k) do { if (IN(k) && IN((k) + 1)) xcd_barrier(bar); STAMP((k) + 1); } while (0)
    if (IN(0)) phase0(P, lds);
    SEAM(0);
    if (IN(1)) { pg8::Gemm g{(const bf16_t*)(P.ws + WS_A1), (const bf16_t*)(P.ws + WS_WIN), TPAD, NIN, 1024, 1024, 1024}; pg8::StaticOrder S; S.init(TPAD, NIN, G, bx);
        EpiIn E{(bf16_t*)(P.ws + WS_MIX), (bf16_t*)(P.ws + WS_XBC), (const float*)(P.ws + WS_RSTD), (float*)(P.ws + WS_SCUF), (float*)(P.ws + WS_SCUL), (float*)(P.ws + WS_SCGF), P.sc_conv_w, P.state_sc, P.out + O_SSC, (LAS float*)(lds + LDS_XCH)}; pg8::gemm_phase<EpiIn>(lds, g, S, E);
        p1_late_tiles(P, lds); }
    SEAM(1);
    if (IN(2)) { { u32x4 pre[3]; if (bx < 3072) p2_conv_load(P, bx, pre);
          for (int it = bx; it < 3072; it += G) p2_conv_item(P, lds, it, it + G < 3072 ? it + G : -1, pre); }
        STAMP(13);
        for (int it = bx; it < 256; it += G) p2_sample_item(P, lds, it); }
    SEAM(2);
    if (IN(3)) { for (int it = bx; it < 256; it += G) p3_item(P, lds, it); }
    SEAM(3);
    if (IN(4)) phase4(P);
    SEAM(4);
    if (IN(5)) { for (int it = bx; it < 256; it += G) p5_item(P, lds, it); }
    SEAM(5);
    if (IN(6)) { phase6_fix(P, G, bx);
        { pg8::Gemm g{(const bf16_t*)(P.ws + WS_MIX), (const bf16_t*)(P.ws + WS_WOUT), TPR, 1024, 2048, 2048, 2048}; pg8::StaticOrder S; S.init(TPR, 1024, G, bx);
          LAS float* sct = (LAS float*)(lds + LDS_XCH);
          { pg8::Unit u0; if (S.next(0, u0) && threadIdx.x < 256) { const float* gr = (const float*)(P.ws + WS_GRS) + (size_t)(u0.pm * 256 + threadIdx.x) * 2; const float r0 = gr[0], r1 = gr[1];
                sct[threadIdx.x] = r0 / r1; sct[256 + threadIdx.x] = r1; } }
          __syncthreads();
          EpiRes E{P.x_prompt, nullptr, (bf16_t*)(P.ws + WS_X1B)};
          pg8::gemm_phase<EpiRes, pg8::StaticOrder, true>(lds, g, S, E, sct); }
        { pg8::Gemm g{(const bf16_t*)(P.ws + WS_MIX) + (size_t)TPR * 2048, (const bf16_t*)(P.ws + WS_WOUT), 256, 1024, 256, 2048, 2048}; pg8::SplitOrder S{32, bx, 256};
          EpiSlab E{(float*)(P.ws + WS_SLAB)}; pg8::gemm_phase<EpiSlab>(lds, g, S, E); } }
    SEAM(6);
    if (IN(7)) rmsnorm_rows(P.out, (const bf16_t*)(P.ws + WS_X1B), P.norm_ffn_w, (bf16_t*)(P.ws + WS_A1), nullptr, (const float*)(P.ws + WS_SLAB), 8, P.x_sample);
    SEAM(7);
    if (IN(8)) { pg8::Gemm g{(const bf16_t*)(P.ws + WS_A1), (const bf16_t*)(P.ws + WS_WFFN), TPAD, NIN, 1024, 1024, 1024}; pg8::StaticOrder S; S.init(TPAD, NIN, G, bx);
        EpiFfnAct E{(bf16_t*)(P.ws + WS_UP), (float*)(P.ws + WS_SBGF), (float*)(P.ws + WS_SBGL), (float*)(P.ws + WS_SBUF), P.ffn_conv_w, P.ffn_conv_b, P.state_ffn, P.out + O_SFFN, (LAS float*)(lds + LDS_XCH)};
        pg8::gemm_phase<EpiFfnAct>(lds, g, S, E); }
    SEAM(8);
    if (IN(10)) { phase9_fix(P, G, bx);
        { pg8::Gemm g{(const bf16_t*)(P.ws + WS_UP), (const bf16_t*)(P.ws + WS_WDOWN), TPR, 1024, DFF, DFF, DFF}; pg8::StaticOrder S; S.init(TPR, 1024, G, bx);
          EpiRes E{nullptr, (const bf16_t*)(P.ws + WS_X1B), (bf16_t*)(P.ws + WS_A1)}; pg8::gemm_phase<EpiRes>(lds, g, S, E); }
        { pg8::Gemm g{(const bf16_t*)(P.ws + WS_UP) + (size_t)TPR * DFF, (const bf16_t*)(P.ws + WS_WDOWN), 256, 1024, 256, DFF, DFF}; pg8::SplitOrder S{44, bx, 256};
          EpiSlab E{(float*)(P.ws + WS_SLAB)}; pg8::gemm_phase<EpiSlab>(lds, g, S, E); } }
    SEAM(10);
    if (IN(11)) rmsnorm_rows(P.out, (const bf16_t*)(P.ws + WS_A1), P.norm_final_w, nullptr, P.out, (const float*)(P.ws + WS_SLAB), 11, nullptr);
    if (PROBE_MASK && bx == 0 && threadIdx.x == 0) {
        const unsigned long long tend = __builtin_amdgcn_s_memrealtime(); stamps[12] = tend; unsigned long long extra = 0;
        asm volatile("s_waitcnt vmcnt(0)" ::: "memory");
        for (int k = 0; k < 12; ++k) if ((PROBE_MASK >> k) & 1) extra += stamps[k + 1] - stamps[k];
        if (PROBE_MASK & 0x1000) extra += stamps[13] - stamps[2];
        if (PROBE_MASK & 0x2000) extra += stamps[15] - stamps[14];
        if (PROBE_MASK & 0x4000) extra += stamps[14] - stamps[5];
        if (PROBE_MASK & 0x8000) extra += stamps[16] - stamps[15];
        if (PROBE_MASK & 0x10000) extra += stamps[6] - stamps[16];
        while (__builtin_amdgcn_s_memrealtime() - tend < extra) __builtin_amdgcn_s_sleep(8);
    }
#undef IN
#undef SEAM
}

#ifndef N_LAUNCHES
#define N_LAUNCHES 1
#endif
extern "C" void kernel_launch(void* const* d_in, const int* in_sizes, int n_in, void* d_out, int out_size, void* d_ws, size_t ws_size, hipStream_t stream) {
    static int grid_blocks = 0;
    if (!grid_blocks) {
        int dev = 0, cus = 0, per_cu = 0;
        (void)hipGetDevice(&dev);
        (void)hipDeviceGetAttribute(&cus, hipDeviceAttributeMultiprocessorCount, dev);
        (void)hipFuncSetAttribute((const void*)fwd_megakernel, hipFuncAttributeMaxDynamicSharedMemorySize, LDS_BYTES);
        (void)hipOccupancyMaxActiveBlocksPerMultiprocessor(&per_cu, (const void*)fwd_megakernel, 512, LDS_BYTES);
        if (per_cu < 1) { fprintf(stderr, "occupancy query says %d blocks per CU\n", per_cu); per_cu = 1; }
        if (per_cu > 1) per_cu = 1;
        grid_blocks = cus * per_cu;
        if (grid_blocks > 256) grid_blocks = 256;
        if (grid_blocks < 256) { fprintf(stderr, "this kernel is built for a 256-CU device (resident capacity reported: %d workgroups); nothing launched\n", grid_blocks); grid_blocks = -1; }
        if (ws_size < WS_END) fprintf(stderr, "workspace too small: %zu < %zu\n", ws_size, (size_t)WS_END);
    }
    if (grid_blocks < 0) return;
    if (N_LAUNCHES == 1) (void)hipMemsetAsync((unsigned char*)d_ws + WS_BAR, 0, XCD_BAR_WORDS * 4, stream);
    Params p{};
    const float** pp = (const float**)&p;
    for (int i = 0; i < 22; ++i) pp[i] = (const float*)d_in[i];
    p.out = (float*)d_out; p.ws = (unsigned char*)d_ws;
    for (int li = 0; li < N_LAUNCHES; ++li) {
        p.ph_lo = (N_LAUNCHES == 1) ? 0 : li; p.ph_hi = (N_LAUNCHES == 1) ? NPHASE : li + 1;
        void* args[] = {&p};
        hipError_t e = hipLaunchCooperativeKernel((const void*)fwd_megakernel, dim3(grid_blocks), dim3(512), args, LDS_BYTES, stream);
        if (e != hipSuccess) fprintf(stderr, "cooperative launch failed: %s (grid %d)\n", hipGetErrorString(e), grid_blocks);
    }
}
```

```cpp
#include <hip/hip_runtime.h>
#include <cstdio>

#define PROBE_MASK 0
#define LAS __attribute__((address_space(3)))
typedef unsigned short bf16_t;
typedef short bf16x8 __attribute__((ext_vector_type(8)));
typedef float f32x4 __attribute__((ext_vector_type(4)));
typedef unsigned u32x4 __attribute__((ext_vector_type(4)));
typedef unsigned u32x2 __attribute__((ext_vector_type(2)));

constexpr int TPR = 16384, TSM = 128, TT = 16512, TPAD = 16640;
constexpr int NIN = 5632, DINP = 5648, XBC = 1536, DFF = 2816;
constexpr float EPS = 1e-5f;
constexpr int LDS_BYTES = 131072 + 16 + 4096;
constexpr int LDS_XCH = 131072 + 16;

constexpr size_t WS_WIN = 0;
constexpr size_t WS_WOUT = WS_WIN + (size_t)NIN * 1024 * 2;
constexpr size_t WS_WFFN = WS_WOUT + (size_t)1024 * 2048 * 2;
constexpr size_t WS_WDOWN = WS_WFFN + (size_t)NIN * 1024 * 2;
constexpr size_t WS_A1 = WS_WDOWN + (size_t)1024 * 2816 * 2;
constexpr size_t WS_DT = WS_A1 + (size_t)TPAD * 1024 * 2;
constexpr size_t WS_ACUM = WS_DT + (size_t)8 * 16 * 2048 * 4;
constexpr size_t WS_DTS = WS_ACUM + (size_t)8 * 16 * 2048 * 4;
constexpr size_t WS_RSTD = WS_DTS + (size_t)128 * 16 * 4;
constexpr size_t WS_BIG = WS_RSTD + (size_t)TPAD * 4;
constexpr size_t WS_XBC = WS_BIG;
constexpr size_t WS_MIX = WS_XBC + (size_t)TPAD * 1536 * 2;
constexpr size_t WS_UP = WS_BIG;
constexpr size_t WS_BAR = WS_MIX + (size_t)TPAD * 2048 * 2;
constexpr size_t WS_SLAB = WS_BAR + 16384;
constexpr size_t WS_SBGF = WS_SLAB + (size_t)11 * 128 * 1024 * 4;
constexpr size_t WS_SBGL = WS_SBGF + (size_t)65 * 2 * 2816 * 4;
constexpr size_t WS_SBUF = WS_SBGL + (size_t)65 * 2 * 2816 * 4;
constexpr size_t WS_SCUF = WS_SBUF + (size_t)65 * 2 * 2816 * 4;
constexpr size_t WS_SCUL = WS_SCUF + (size_t)65 * 2 * 1024 * 4;
constexpr size_t WS_SCGF = WS_SCUL + (size_t)65 * 2 * 1024 * 4;
constexpr size_t WS_X1B = WS_SCGF + (size_t)65 * 2 * 1024 * 4;
constexpr size_t WS_GRS = WS_X1B + (size_t)TPAD * 1024 * 2;
constexpr size_t WS_END = WS_GRS + (size_t)TPR * 2 * 4;
constexpr size_t OS_BN = 0;
constexpr size_t OS_BT = OS_BN + (size_t)8 * 2 * 2048 * 128 * 2;
constexpr size_t OS_CN = OS_BT + (size_t)8 * 2 * 2048 * 128 * 2;
constexpr size_t OS_ST = OS_CN + (size_t)8 * 2 * 2048 * 128 * 2;
constexpr size_t O_YS = 16777216, O_PSSM = 16908288, O_PSSDC = 17956864, O_PSC = 17993728, O_PFFN = 18010112;
constexpr size_t O_SSSM = 18055168, O_SSSDC = 34832384, O_SSC = 35422208, O_SFFN = 35684352;

typedef float f32x2_t __attribute__((ext_vector_type(2)));
typedef __bf16 bf16x2_t __attribute__((ext_vector_type(2)));
__device__ __forceinline__ unsigned cvt_pk_bf16(float lo, float hi) { const f32x2_t v = {lo, hi}; return __builtin_bit_cast(unsigned, __builtin_convertvector(v, bf16x2_t)); }
__device__ __forceinline__ float bf_lo(unsigned u) { return __uint_as_float(u << 16); }
__device__ __forceinline__ float bf_hi(unsigned u) { return __uint_as_float(u & 0xffff0000u); }
__device__ __forceinline__ bf16_t f2bf(float f) { return (bf16_t)(cvt_pk_bf16(f, 0.f) & 0xffffu); }
__device__ __forceinline__ float bf2f(bf16_t b) { return __uint_as_float(((unsigned)b) << 16); }
__device__ __forceinline__ float silu_f(float v) { return v * __builtin_amdgcn_rcpf(1.0f + __expf(-v)); }
__device__ __forceinline__ float softplus_f(float v) { return v > 20.f ? v : log1pf(__expf(v)); }
__device__ __forceinline__ void unpack8(const u32x4 u, float (&f)[8]) { f[0] = bf_lo(u.x); f[1] = bf_hi(u.x); f[2] = bf_lo(u.y); f[3] = bf_hi(u.y); f[4] = bf_lo(u.z); f[5] = bf_hi(u.z); f[6] = bf_lo(u.w); f[7] = bf_hi(u.w); }
__device__ __forceinline__ u32x4 pack8(const float (&f)[8]) { u32x4 u; u.x = cvt_pk_bf16(f[0], f[1]); u.y = cvt_pk_bf16(f[2], f[3]); u.z = cvt_pk_bf16(f[4], f[5]); u.w = cvt_pk_bf16(f[6], f[7]); return u; }
__device__ __forceinline__ void ld8f(const float* p, float (&f)[8]) { const f32x4 a = *(const f32x4*)p, b = *(const f32x4*)(p + 4); f[0] = a[0]; f[1] = a[1]; f[2] = a[2]; f[3] = a[3]; f[4] = b[0]; f[5] = b[1]; f[6] = b[2]; f[7] = b[3]; }
__device__ __forceinline__ void st8f(float* p, const float (&f)[8]) { *(f32x4*)p = (f32x4){f[0], f[1], f[2], f[3]}; *(f32x4*)(p + 4) = (f32x4){f[4], f[5], f[6], f[7]}; }


#define XB_TMO      128
#define XB_XCNT(j)  (256  + 64 * (j))
#define XB_XSUB(j)  (1280 + 64 * (j))
#define XB_XGEN(j)  (2304 + 64 * (j))
#define XB_TOP      3328
#define XB_TOPGEN   3392
#define XCD_BAR_WORDS 3456
#define XB_SPIN_CAP (1u << 18)
__device__ __forceinline__ unsigned xb_ld(unsigned* p)              { return __hip_atomic_load(p, __ATOMIC_RELAXED, __HIP_MEMORY_SCOPE_AGENT); }
__device__ __forceinline__ unsigned xb_add(unsigned* p, unsigned v) { return __hip_atomic_fetch_add(p, v, __ATOMIC_RELAXED, __HIP_MEMORY_SCOPE_AGENT); }
__device__ __forceinline__ unsigned xb_xcc_id() { return (unsigned)__builtin_amdgcn_s_getreg((3 << 11) | 20) & 0xFu; }
#define XB_SPIN(cond, bar) do { unsigned _sp = 0; while (cond) { __builtin_amdgcn_s_sleep(1); \
    if ((++_sp & 255u) == 0u) { if (xb_ld(&(bar)[XB_TMO])) break; if (_sp > XB_SPIN_CAP) { atomicAdd(&(bar)[XB_TMO], 1u); break; } } } } while (0)
struct XcdBarrier { unsigned* bar; unsigned x; volatile LAS unsigned* st; };
__device__ __forceinline__ XcdBarrier xcd_barrier_post(unsigned* bar, volatile LAS unsigned* st) {
    XcdBarrier b; b.bar = bar; b.x = xb_xcc_id(); b.st = st;
    if (threadIdx.x == 0) (void)xb_add(&bar[XB_XCNT(b.x)], 1u);
    return b;
}
__device__ __forceinline__ void xcd_barrier_complete(unsigned* bar, unsigned x, unsigned& nloc, unsigned& nx) {
    const unsigned G = gridDim.x * gridDim.y * gridDim.z;
    unsigned sum, cnt, mine, sp = 0u;
    for (;;) {
        sum = 0u; cnt = 0u; mine = 0u;
#pragma unroll
        for (unsigned j = 0; j < 16; ++j) { const unsigned c = xb_ld(&bar[XB_XCNT(j)]); sum += c; cnt += (c > 0u) ? 1u : 0u; mine = (j == x) ? c : mine; }
        if (sum == G) break;
        __builtin_amdgcn_s_sleep(1);
        if ((++sp & 255u) == 0u) { if (xb_ld(&bar[XB_TMO])) break; if (sp > XB_SPIN_CAP) { atomicAdd(&bar[XB_TMO], 1u); break; } }
    }
    nloc = mine > 0u ? mine : 1u; nx = cnt > 0u ? cnt : 1u;
}
__device__ __forceinline__ void xcd_barrier(const XcdBarrier& b) {
    asm volatile("s_waitcnt vmcnt(0)" ::: "memory");
    __syncthreads();
    if (threadIdx.x == 0) {
        unsigned* bar = b.bar;
        __builtin_amdgcn_s_waitcnt(0);
        unsigned nloc = b.st[0], nx = b.st[1];
        if (nloc == 0u) { xcd_barrier_complete(bar, b.x, nloc, nx); b.st[0] = nloc; b.st[1] = nx; }
        const unsigned old = xb_add(&bar[XB_XSUB(b.x)], 1u);
        const unsigned gen = old / nloc;
        if (old + 1u == (gen + 1u) * nloc) {
            __builtin_amdgcn_fence(__ATOMIC_RELEASE, "agent");
            asm volatile("s_waitcnt vmcnt(0)" ::: "memory");
            const unsigned og = xb_add(&bar[XB_TOP], 1u);
            const unsigned tg = og / nx;
            if (og + 1u == (tg + 1u) * nx) xb_add(&bar[XB_TOPGEN], 1u);
            else XB_SPIN(xb_ld(&bar[XB_TOPGEN]) == tg, bar);
            __builtin_amdgcn_fence(__ATOMIC_ACQUIRE, "agent");
            xb_add(&bar[XB_XGEN(b.x)], 1u);
            asm volatile("s_waitcnt vmcnt(0)" ::: "memory");
        } else {
            XB_SPIN(xb_ld(&bar[XB_XGEN(b.x)]) == gen, bar);
            __builtin_amdgcn_fence(__ATOMIC_ACQUIRE, "agent");
            asm volatile("s_waitcnt vmcnt(0)" ::: "memory");
        }
    }
    __syncthreads();
}

namespace pg8 {
constexpr int BM = 256, BK = 64, HALF = 128, HTB = HALF * BK * 2, NXCD = 8, WGM = 8;
__device__ __forceinline__ int lds_byte(int r, int c) { const int st = (r >> 4) * 2 + (c >> 5), rr = r & 15, cc = c & 31, ob = rr * 64 + cc * 2; return st * 1024 + (ob ^ (((ob >> 9) & 1) << 5)); }
__device__ __forceinline__ void stage_rc(int b, int& R, int& C) { const int st = b / 1024, sb = b % 1024, swz = sb ^ (((sb >> 9) & 1) << 5); R = (st >> 1) * 16 + swz / 64; C = (st & 1) * 32 + (swz % 64) / 2; }
__device__ __forceinline__ int perm32(int rho) { const int n = rho >> 4, i = rho & 15; return 8 * (i >> 2) + 4 * n + (i & 3); }
struct Unit { int pm, pn, ko; };
struct Gemm { const bf16_t* A; const bf16_t* Bt; int M, N, K, lda, ldb; };
struct StaticOrder {
    int nM, nN, nwg, G, c;
    __device__ void init(int M, int N, int G_, int c_) { nM = M / BM; nN = N / BM; nwg = nM * nN; G = G_; c = c_; }
    __device__ bool next(int i, Unit& u) const {
        const long L = (long)i * G + c; if (L >= nwg) return false;
        int wgid = (int)L; { const int q = nwg / NXCD, r = nwg % NXCD, xcd = wgid % NXCD, off = wgid / NXCD; wgid = (xcd < r ? xcd * (q + 1) : r * (q + 1) + (xcd - r) * q) + off; }
        const int nig = WGM * nN, gid = wgid / nig, fm = gid * WGM, gsz = (nM - fm) < WGM ? (nM - fm) : WGM;
        u.pm = fm + ((wgid % nig) % gsz); u.pn = (wgid % nig) / gsz; u.ko = 0; return true;
    }
};
struct SplitOrder {
    int nu, c, K;
    __device__ bool next(int i, Unit& u) const { if (i != 0 || c >= nu) return false; u.pm = 0; u.pn = c & 3; u.ko = (c >> 2) * K; return true; }
};
template <class Epi, class Sched, bool SCALE = false>
__device__ __forceinline__ void gemm_phase(LAS unsigned char* lds, const Gemm g, const Sched& S, const Epi& E, const LAS float* sctab = nullptr) {
    const int tid = threadIdx.x, wid = __builtin_amdgcn_readfirstlane(tid >> 6), lane = tid & 63, wr = wid >> 2, wc = wid & 3, fr = lane & 15, fq = lane >> 4;
    const int K = g.K, nt = K / BK;
    unsigned voffA[2], voffB[2];
#pragma unroll
    for (int i = 0; i < 2; ++i) { int R, C; stage_rc(tid * 16 + i * 8192, R, C); const int Rb = Epi::PERM ? ((R & ~31) + perm32(R & 31)) : R;
        voffA[i] = (unsigned)(R * g.lda + C) * 2u; voffB[i] = (unsigned)(Rb * g.ldb + C) * 2u; }
    const size_t kstep = (size_t)(BK * 2);
    const size_t hstepA = (size_t)HALF * g.lda * 2, hstepB = (size_t)HALF * g.ldb * 2;
    const size_t tstepA = 2 * hstepA, tstepB = 2 * hstepB;
    const unsigned ldsw = (unsigned)wid * 1024u;
    const int aoff = lds_byte(wr * 64 + fr, fq * 8), boff = lds_byte(wc * 32 + fr, fq * 8);
#define PG8_SA(b, h) (((b) * 2 + (h)) * HTB)
#define PG8_SB(b, h) ((4 + (b) * 2 + (h)) * HTB)
#define PG8_STAGE(bufoff, gbase, voff) do { _Pragma("unroll") for (int _i = 0; _i < 2; ++_i) \
        __builtin_amdgcn_global_load_lds((const unsigned*)((const char*)(gbase) + (voff)[_i]), (LAS unsigned*)(lds + (bufoff) + ldsw + _i * 8192), 16, 0, 0); } while (0)
#define PG8_LDA(dst, b, h) do { _Pragma("unroll") for (int m = 0; m < 4; ++m) _Pragma("unroll") for (int k = 0; k < 2; ++k) dst[m][k] = *(const LAS bf16x8*)(lds + PG8_SA(b, h) + aoff + m * 2048 + k * 1024); } while (0)
#define PG8_LDB(dst, b, h) do { _Pragma("unroll") for (int n = 0; n < 2; ++n) _Pragma("unroll") for (int k = 0; k < 2; ++k) dst[n][k] = *(const LAS bf16x8*)(lds + PG8_SB(b, h) + boff + n * 2048 + k * 1024); } while (0)
#define PG8_MMA(ai, bj, At, Bt) do { __builtin_amdgcn_s_setprio(1); _Pragma("unroll") for (int m = 0; m < 4; ++m) _Pragma("unroll") for (int n = 0; n < 2; ++n) _Pragma("unroll") for (int k = 0; k < 2; ++k) \
        acc[ai][bj][m][n] = __builtin_amdgcn_mfma_f32_16x16x32_bf16(Bt[n][k], At[m][k], acc[ai][bj][m][n], 0, 0, 0); __builtin_amdgcn_s_setprio(0); } while (0)
#define PG8_WAIT_V(n) asm volatile("s_waitcnt vmcnt(" #n ")" ::: "memory")
#define PG8_WAIT_L(n) asm volatile("s_waitcnt lgkmcnt(" #n ")" ::: "memory")
#define PG8_BAR __builtin_amdgcn_s_barrier()
#define PG8_SCHED __builtin_amdgcn_sched_barrier(0)
    Unit cur, nxt; int ui = 0;
    if (!S.next(0, cur)) return;
    f32x4 acc[2][2][4][2];
#pragma unroll
    for (int a = 0; a < 2; ++a)
#pragma unroll
        for (int b = 0; b < 2; ++b)
#pragma unroll
            for (int m = 0; m < 4; ++m)
#pragma unroll
                for (int n = 0; n < 2; ++n) acc[a][b][m][n] = (f32x4){0.f, 0.f, 0.f, 0.f};
    bf16x8 At[4][2], B0[2][2], B1[2][2];
    const char* cA = (const char*)g.A + (size_t)cur.pm * tstepA + (size_t)cur.ko * 2; const char* cB = (const char*)g.Bt + (size_t)cur.pn * tstepB + (size_t)cur.ko * 2;
    PG8_STAGE(PG8_SB(0, 0), cB, voffB); PG8_STAGE(PG8_SA(0, 0), cA, voffA); PG8_STAGE(PG8_SB(0, 1), cB + hstepB, voffB); PG8_STAGE(PG8_SA(0, 1), cA + hstepA, voffA);
    if (wr == 1) PG8_BAR;
    PG8_WAIT_V(4); PG8_BAR;
    PG8_STAGE(PG8_SB(1, 0), cB + kstep, voffB); PG8_STAGE(PG8_SA(1, 0), cA + kstep, voffA); PG8_STAGE(PG8_SB(1, 1), cB + hstepB + kstep, voffB);
    PG8_WAIT_V(6); PG8_BAR;
    for (;;) {
        const bool has_next = S.next(ui + 1, nxt);
        const char* nA = has_next ? (const char*)g.A + (size_t)nxt.pm * tstepA + (size_t)nxt.ko * 2 : cA; const char* nB = has_next ? (const char*)g.Bt + (size_t)nxt.pn * tstepB + (size_t)nxt.ko * 2 : cB;
        for (int t = 0; t < nt; t += 2) {
            const bool last = (t == nt - 2);
            const char* a1 = cA + (size_t)(t + 1) * kstep;
            const char* a2 = last ? nA : cA + (size_t)(t + 2) * kstep; const char* b2 = last ? nB : cB + (size_t)(t + 2) * kstep;
            const char* a3 = a2 + kstep; const char* b3 = b2 + kstep;
            if (SCALE && (t == 8 || t == 16)) {
                const LAS float* tb = sctab + (t == 8 ? 0 : 256) + wr * 64 + fr;
#pragma unroll
                for (int ai = 0; ai < 2; ++ai)
#pragma unroll
                    for (int m = 0; m < 4; ++m) { const float sv = tb[ai * 128 + m * 16];
#pragma unroll
                        for (int bj = 0; bj < 2; ++bj)
#pragma unroll
                            for (int n = 0; n < 2; ++n) acc[ai][bj][m][n] *= sv; }
                PG8_WAIT_L(0); PG8_SCHED;
            }
            PG8_LDB(B0, 0, 0); PG8_SCHED; PG8_LDA(At, 0, 0); PG8_STAGE(PG8_SA(1, 1), a1 + hstepA, voffA);
            PG8_WAIT_L(8); PG8_BAR; PG8_WAIT_L(0); PG8_MMA(0, 0, At, B0); PG8_BAR; PG8_SCHED;
            PG8_LDB(B1, 0, 1); PG8_STAGE(PG8_SB(0, 0), b2, voffB);
            PG8_BAR; PG8_WAIT_L(0); PG8_MMA(0, 1, At, B1); PG8_BAR;
            PG8_LDA(At, 0, 1); PG8_STAGE(PG8_SA(0, 0), a2, voffA);
            PG8_BAR; PG8_WAIT_L(0); PG8_MMA(1, 0, At, B0); PG8_BAR; PG8_SCHED;
            PG8_STAGE(PG8_SB(0, 1), b2 + hstepB, voffB);
            PG8_WAIT_V(6); PG8_BAR; PG8_MMA(1, 1, At, B1); PG8_BAR;
            PG8_LDB(B0, 1, 0); PG8_SCHED; PG8_LDA(At, 1, 0); PG8_STAGE(PG8_SA(0, 1), a2 + hstepA, voffA);
            PG8_WAIT_L(8); PG8_BAR; PG8_WAIT_L(0); PG8_MMA(0, 0, At, B0); PG8_BAR; PG8_SCHED;
            PG8_LDB(B1, 1, 1); PG8_STAGE(PG8_SB(1, 0), b3, voffB);
            PG8_BAR; PG8_WAIT_L(0); PG8_MMA(0, 1, At, B1); PG8_BAR;
            PG8_LDA(At, 1, 1); PG8_STAGE(PG8_SA(1, 0), a3, voffA);
            PG8_BAR; PG8_WAIT_L(0); PG8_MMA(1, 0, At, B0); PG8_BAR; PG8_SCHED;
            PG8_STAGE(PG8_SB(1, 1), b3 + hstepB, voffB);
            PG8_WAIT_V(6); PG8_BAR; PG8_MMA(1, 1, At, B1); PG8_BAR;
        }
        E(acc, cur, wr, wc, fr, fq);
        if (!has_next) break;
#pragma unroll
        for (int a = 0; a < 2; ++a)
#pragma unroll
            for (int b = 0; b < 2; ++b)
#pragma unroll
                for (int m = 0; m < 4; ++m)
#pragma unroll
                    for (int n = 0; n < 2; ++n) acc[a][b][m][n] = (f32x4){0.f, 0.f, 0.f, 0.f};
        cur = nxt; cA = nA; cB = nB; ++ui;
    }
    PG8_WAIT_V(0);
    if (wr == 0) PG8_BAR;
    PG8_BAR;
#undef PG8_SA
#undef PG8_SB
#undef PG8_STAGE
#undef PG8_LDA
#undef PG8_LDB
#undef PG8_MMA
#undef PG8_WAIT_V
#undef PG8_WAIT_L
#undef PG8_BAR
#undef PG8_SCHED
}
}

__device__ __forceinline__ float dpp_ror1(float v) { return __builtin_bit_cast(float, __builtin_amdgcn_update_dpp(0, __builtin_bit_cast(int, v), 0x121, 0xF, 0xF, true)); }
__device__ __forceinline__ float dpp_ror2(float v) { return __builtin_bit_cast(float, __builtin_amdgcn_update_dpp(0, __builtin_bit_cast(int, v), 0x122, 0xF, 0xF, true)); }
struct EpiIn {
    static constexpr bool PERM = true;
    bf16_t* mix; bf16_t* xbc; const float* rstd; float* uf; float* ul; float* gbf; const float* cw; const float* st; float* sout; LAS float* xch;
    __device__ __forceinline__ void operator()(const f32x4 (&acc)[2][2][4][2], const pg8::Unit& u, int wr, int wc, int fr_, int fq_) const {
        int fr = fr_, fq = fq_; asm volatile("" : "+v"(fr), "+v"(fq));
        const int row0 = u.pm * 256 + wr * 64 + fr;
        float rs[2][4];
#pragma unroll
        for (int ai = 0; ai < 2; ++ai)
#pragma unroll
            for (int m = 0; m < 4; ++m) rs[ai][m] = rstd[row0 + ai * 128 + m * 16];
        if (u.pn >= 16) {
            bf16_t* base = xbc + (u.pn - 16) * 256 + wc * 32 + 8 * fq;
#pragma unroll
            for (int ai = 0; ai < 2; ++ai)
#pragma unroll
                for (int m = 0; m < 4; ++m) { bf16_t* rp = base + (size_t)(row0 + ai * 128 + m * 16) * XBC;
#pragma unroll
                    for (int bj = 0; bj < 2; ++bj) { const f32x4 v0 = acc[ai][bj][m][0] * rs[ai][m], v1 = acc[ai][bj][m][1] * rs[ai][m];
                        u32x4 w; w.x = cvt_pk_bf16(v0[0], v0[1]); w.y = cvt_pk_bf16(v0[2], v0[3]); w.z = cvt_pk_bf16(v1[0], v1[1]); w.w = cvt_pk_bf16(v1[2], v1[3]);
                        *(u32x4*)(rp + bj * 128) = w; } }
            return;
        }
        const int cl = wc * 16 + 4 * fq, jj = u.pn * 64 + cl;
        const f32x4 w0 = *(const f32x4*)(cw + jj), w1 = *(const f32x4*)(cw + 1024 + jj), w2 = *(const f32x4*)(cw + 2048 + jj);
        if (u.pm == 64) {
#pragma unroll
            for (int m = 0; m < 4; ++m) { const int bs = wr * 64 + m * 16 + fr; const float r = rs[0][m];
                const f32x4 s0 = *(const f32x4*)(st + (size_t)(bs * 2) * 1024 + jj), s1 = *(const f32x4*)(st + (size_t)(bs * 2 + 1) * 1024 + jj);
                const f32x4 gb = acc[0][0][m][0] * r, uu = acc[0][0][m][1] * acc[0][1][m][0] * (r * r), zz = acc[0][1][m][1] * r;
                const f32x4 ys = gb * (s0 * w0 + s1 * w1 + uu * w2);
                *(f32x4*)(sout + (size_t)(bs * 2) * 1024 + jj) = s1; *(f32x4*)(sout + (size_t)(bs * 2 + 1) * 1024 + jj) = uu;
                bf16_t* rp = mix + (size_t)(TPR + bs) * 2048 + jj;
                u32x2 oz, oy; oz.x = cvt_pk_bf16(zz[0], zz[1]); oz.y = cvt_pk_bf16(zz[2], zz[3]); oy.x = cvt_pk_bf16(ys[0], ys[1]); oy.y = cvt_pk_bf16(ys[2], ys[3]);
                *(u32x2*)rp = oz; *(u32x2*)(rp + 1024) = oy; }
            return;
        }
        if (fr >= 14) {
#pragma unroll
            for (int ai = 0; ai < 2; ++ai) { const float r = rs[ai][3]; *(LAS f32x4*)(xch + ((2 * ai + wr) * 2 + (fr - 14)) * 64 + cl) = acc[ai][0][3][1] * acc[ai][1][3][0] * (r * r); }
            if (wr == 1) { const float r = rs[1][3]; *(f32x4*)(ul + (size_t)(u.pm * 2 + (fr - 14)) * 1024 + jj) = acc[1][0][3][1] * acc[1][1][3][0] * (r * r); }
        }
        if (fr < 2 && wr == 0) { const float r = rs[0][0];
            *(f32x4*)(uf + (size_t)(u.pm * 2 + fr) * 1024 + jj) = acc[0][0][0][1] * acc[0][1][0][0] * (r * r); *(f32x4*)(gbf + (size_t)(u.pm * 2 + fr) * 1024 + jj) = acc[0][0][0][0] * r; }
        asm volatile("s_waitcnt lgkmcnt(0)" ::: "memory"); __builtin_amdgcn_s_barrier(); __builtin_amdgcn_s_barrier(); asm volatile("" ::: "memory");
        const bool f1 = fr >= 1, f2 = fr >= 2;
        bf16_t* mrow = mix + (size_t)row0 * 2048 + jj;
#pragma unroll
        for (int ai = 0; ai < 2; ++ai) {
            const int k = 2 * ai + wr;
            f32x4 p1, p2;
            if (k > 0) { const f32x4 X0 = *(const LAS f32x4*)(xch + ((k - 1) * 2 + 0) * 64 + cl), X1 = *(const LAS f32x4*)(xch + ((k - 1) * 2 + 1) * 64 + cl);
                p1 = X1;
#pragma unroll
                for (int e = 0; e < 4; ++e) p2[e] = fr == 1 ? X1[e] : X0[e]; }
            else { p1 = (f32x4){0.f, 0.f, 0.f, 0.f}; p2 = p1; }
#pragma unroll
            for (int m = 0; m < 4; ++m) { const float r = rs[ai][m];
                const f32x4 gb = acc[ai][0][m][0] * r, uu = acc[ai][0][m][1] * acc[ai][1][m][0] * (r * r), zz = acc[ai][1][m][1] * r;
                float ys[4];
#pragma unroll
                for (int e = 0; e < 4; ++e) { const float r1 = dpp_ror1(uu[e]), r2 = dpp_ror2(uu[e]);
                    const float um1 = f1 ? r1 : p1[e], um2 = f2 ? r2 : p2[e];
                    ys[e] = gb[e] * (um2 * w0[e] + um1 * w1[e] + uu[e] * w2[e]);
                    p1[e] = r1; p2[e] = r2; }
                u32x2 oz, oy; oz.x = cvt_pk_bf16(zz[0], zz[1]); oz.y = cvt_pk_bf16(zz[2], zz[3]); oy.x = cvt_pk_bf16(ys[0], ys[1]); oy.y = cvt_pk_bf16(ys[2], ys[3]);
                bf16_t* rp = mrow + (size_t)(ai * 128 + m * 16) * 2048;
                *(u32x2*)rp = oz; *(u32x2*)(rp + 1024) = oy; }
            asm volatile("" ::: "memory");
        }
    }
};
struct EpiFfnAct {
    static constexpr bool PERM = true;
    bf16_t* act; float* gfirst; float* glast; float* ufirst; const float* cw; const float* cb; const float* st; float* sout; LAS float* xch;
    __device__ __forceinline__ void operator()(const f32x4 (&acc)[2][2][4][2], const pg8::Unit& u, int wr, int wc, int fr_, int fq_) const {
        int fr = fr_, fq = fq_; asm volatile("" : "+v"(fr), "+v"(fq));
        const int cl = wc * 32 + 8 * fq, cg = u.pn * 128 + cl;
        if (u.pm == 64) {
#pragma unroll
            for (int n = 0; n < 2; ++n) { const f32x4 w0 = *(const f32x4*)(cw + cg + 4 * n), w1 = *(const f32x4*)(cw + DFF + cg + 4 * n), w2 = *(const f32x4*)(cw + 2 * DFF + cg + 4 * n), bb = *(const f32x4*)(cb + cg + 4 * n);
#pragma unroll
                for (int m = 0; m < 4; ++m) { const int bs = wr * 64 + m * 16 + fr;
                    const f32x4 s0 = *(const f32x4*)(st + (size_t)(bs * 2) * DFF + cg + 4 * n), s1 = *(const f32x4*)(st + (size_t)(bs * 2 + 1) * DFF + cg + 4 * n);
                    const f32x4 g = acc[0][0][m][n], up = acc[0][1][m][n]; const f32x4 cv = s0 * w0 + s1 * w1 + g * w2 + bb;
                    u32x2 o; o.x = cvt_pk_bf16(silu_f(cv[0]) * up[0], silu_f(cv[1]) * up[1]); o.y = cvt_pk_bf16(silu_f(cv[2]) * up[2], silu_f(cv[3]) * up[3]);
                    *(f32x4*)(sout + (size_t)(bs * 2) * DFF + cg + 4 * n) = s1; *(f32x4*)(sout + (size_t)(bs * 2 + 1) * DFF + cg + 4 * n) = g;
                    *(u32x2*)(act + (size_t)(TPR + bs) * DFF + cg + 4 * n) = o; } }
            return;
        }
        if (fr >= 14) {
#pragma unroll
            for (int ai = 0; ai < 2; ++ai)
#pragma unroll
                for (int n = 0; n < 2; ++n) *(LAS f32x4*)(xch + ((2 * ai + wr) * 2 + (fr - 14)) * 128 + cl + 4 * n) = acc[ai][0][3][n];
            if (wr == 1) {
#pragma unroll
                for (int n = 0; n < 2; ++n) *(f32x4*)(glast + (size_t)(u.pm * 2 + (fr - 14)) * DFF + cg + 4 * n) = acc[1][0][3][n]; }
        }
        if (fr < 2 && wr == 0) {
#pragma unroll
            for (int n = 0; n < 2; ++n) { *(f32x4*)(gfirst + (size_t)(u.pm * 2 + fr) * DFF + cg + 4 * n) = acc[0][0][0][n]; *(f32x4*)(ufirst + (size_t)(u.pm * 2 + fr) * DFF + cg + 4 * n) = acc[0][1][0][n]; }
        }
        f32x4 w0[2], w1[2], w2[2], bb[2];
#pragma unroll
        for (int n = 0; n < 2; ++n) { w0[n] = *(const f32x4*)(cw + cg + 4 * n); w1[n] = *(const f32x4*)(cw + DFF + cg + 4 * n); w2[n] = *(const f32x4*)(cw + 2 * DFF + cg + 4 * n); bb[n] = *(const f32x4*)(cb + cg + 4 * n); }
        asm volatile("s_waitcnt lgkmcnt(0)" ::: "memory"); __builtin_amdgcn_s_barrier(); __builtin_amdgcn_s_barrier(); asm volatile("" ::: "memory");
        const bool f1 = fr >= 1, f2 = fr >= 2;
        bf16_t* arow = act + (size_t)(u.pm * 256 + wr * 64 + fr) * DFF + cg;
#pragma unroll
        for (int ai = 0; ai < 2; ++ai) {
            const int k = 2 * ai + wr;
            u32x2 o0[4];
#pragma unroll
            for (int n = 0; n < 2; ++n) {
                f32x4 p1, p2;
                if (k > 0) { const f32x4 X0 = *(const LAS f32x4*)(xch + ((k - 1) * 2 + 0) * 128 + cl + 4 * n), X1 = *(const LAS f32x4*)(xch + ((k - 1) * 2 + 1) * 128 + cl + 4 * n);
                    p1 = X1;
#pragma unroll
                    for (int e = 0; e < 4; ++e) p2[e] = fr == 1 ? X1[e] : X0[e]; }
                else { p1 = (f32x4){0.f, 0.f, 0.f, 0.f}; p2 = p1; }
#pragma unroll
                for (int m = 0; m < 4; ++m) { const f32x4 g = acc[ai][0][m][n], up = acc[ai][1][m][n]; float a[4];
#pragma unroll
                    for (int e = 0; e < 4; ++e) { const float r1 = dpp_ror1(g[e]), r2 = dpp_ror2(g[e]);
                        const float gm1 = f1 ? r1 : p1[e], gm2 = f2 ? r2 : p2[e];
                        a[e] = silu_f(gm2 * w0[n][e] + gm1 * w1[n][e] + g[e] * w2[n][e] + bb[n][e]) * up[e];
                        p1[e] = r1; p2[e] = r2; }
                    u32x2 o; o.x = cvt_pk_bf16(a[0], a[1]); o.y = cvt_pk_bf16(a[2], a[3]);
                    if (n == 0) o0[m] = o;
                    else { u32x4 w; w.x = o0[m].x; w.y = o0[m].y; w.z = o.x; w.w = o.y; *(u32x4*)(arow + (size_t)(ai * 128 + m * 16) * DFF) = w; } }
            }
            asm volatile("" ::: "memory");
        }
    }
};
struct EpiRes {
    static constexpr bool PERM = false;
    const float* bf; const bf16_t* b16; bf16_t* o16;
    __device__ __forceinline__ void operator()(const f32x4 (&acc)[2][2][4][2], const pg8::Unit& u, int wr, int wc, int fr_, int fq_) const {
        int fr = fr_, fq = fq_; asm volatile("" : "+v"(fr), "+v"(fq));
        const size_t off0 = (size_t)(u.pm * 256 + wr * 64 + fr) * 1024 + u.pn * 256 + wc * 32 + 4 * fq;
#pragma unroll
        for (int ai = 0; ai < 2; ++ai) {
            f32x4 bv[4][2][2];
            if (bf) {
#pragma unroll
                for (int m = 0; m < 4; ++m)
#pragma unroll
                    for (int bj = 0; bj < 2; ++bj)
#pragma unroll
                        for (int n = 0; n < 2; ++n) bv[m][bj][n] = *(const f32x4*)(bf + off0 + (size_t)(ai * 128 + m * 16) * 1024 + bj * 128 + n * 16);
            } else {
                u32x2 br[4][2][2];
#pragma unroll
                for (int m = 0; m < 4; ++m)
#pragma unroll
                    for (int bj = 0; bj < 2; ++bj)
#pragma unroll
                        for (int n = 0; n < 2; ++n) br[m][bj][n] = *(const u32x2*)(b16 + off0 + (size_t)(ai * 128 + m * 16) * 1024 + bj * 128 + n * 16);
#pragma unroll
                for (int m = 0; m < 4; ++m)
#pragma unroll
                    for (int bj = 0; bj < 2; ++bj)
#pragma unroll
                        for (int n = 0; n < 2; ++n) bv[m][bj][n] = (f32x4){bf_lo(br[m][bj][n].x), bf_hi(br[m][bj][n].x), bf_lo(br[m][bj][n].y), bf_hi(br[m][bj][n].y)};
            }
#pragma unroll
            for (int m = 0; m < 4; ++m)
#pragma unroll
                for (int bj = 0; bj < 2; ++bj)
#pragma unroll
                    for (int n = 0; n < 2; ++n) { const f32x4 o = bv[m][bj][n] + acc[ai][bj][m][n]; u32x2 pk; pk.x = cvt_pk_bf16(o[0], o[1]); pk.y = cvt_pk_bf16(o[2], o[3]);
                        *(u32x2*)(o16 + off0 + (size_t)(ai * 128 + m * 16) * 1024 + bj * 128 + n * 16) = pk; }
            asm volatile("" ::: "memory");
        }
    }
};
struct EpiSlab {
    static constexpr bool PERM = false;
    float* slab;
    __device__ __forceinline__ void operator()(const f32x4 (&acc)[2][2][4][2], const pg8::Unit& u, int wr, int wc, int fr, int fq) const {
        const int col0 = u.pn * 256 + wc * 32 + 4 * fq;
        float* sb = slab + (size_t)(u.ko >> 8) * (128 * 1024);
#pragma unroll
        for (int m = 0; m < 4; ++m) { float* o = sb + (size_t)(wr * 64 + m * 16 + fr) * 1024 + col0;
#pragma unroll
            for (int bj = 0; bj < 2; ++bj)
#pragma unroll
                for (int n = 0; n < 2; ++n) *(f32x4*)(o + bj * 128 + n * 16) = acc[0][bj][m][n]; }
    }
};

struct Params {
    const float* x_prompt; const float* x_sample; const float* state_ssm; const float* state_ssd_conv; const float* state_sc; const float* state_ffn;
    const float* norm_mix_w; const float* w_in; const float* ssd_conv_w; const float* ssd_conv_b; const float* dt_bias; const float* a_log; const float* ssd_d; const float* ssd_norm_w;
    const float* sc_conv_w; const float* w_out; const float* norm_ffn_w; const float* w_ffn_in; const float* ffn_conv_w; const float* ffn_conv_b; const float* w_down; const float* norm_final_w;
    float* out; unsigned char* ws; int ph_lo, ph_hi;
};

__device__ __forceinline__ int map_in4(int jd) {
    const int T = jd >> 8, L = jd & 255;
    if (T >= 16) return 1024 + (T - 16) * 256 + L;
    const int bj = L >> 7, wc = (L >> 5) & 3, fq = (L >> 3) & 3, n = (L >> 2) & 1, jj = T * 64 + wc * 16 + fq * 4;
    return (bj == 0 ? (n == 0 ? 2576 : 3600) : (n == 0 ? 4624 : 0)) + jj;
}
__device__ __forceinline__ int map_in_old(int j0) {
    if (j0 < 2560) return j0;
    if (j0 < 3584) return 2576 + (j0 - 2560);
    const int k = (j0 - 3584) >> 8, w = (j0 - 3584) & 255;
    return w < 128 ? 3600 + k * 128 + w : 4624 + k * 128 + (w - 128);
}
__device__ __forceinline__ void p0_chunk(const Params& P, LAS unsigned char* lds, int ci) {
    const int tid = threadIdx.x, lane = tid & 63, wid = tid >> 6, r16 = lane & 15, q = lane >> 4;
    LAS bf16_t* wdt = (LAS bf16_t*)lds;
    LAS float* dts = (LAS float*)(lds + 33024);
    LAS float* segs = (LAS float*)(lds + 33024 + 8192);
    LAS float* nws = (LAS float*)(lds + 33024 + 8192 + 1024);
    *(LAS float*)(nws + tid) = P.norm_mix_w[tid]; *(LAS float*)(nws + 512 + tid) = P.norm_mix_w[512 + tid];
#pragma unroll
    for (int i = 0; i < 8; ++i) { const int k = (tid >> 2) + 128 * i, c4 = (tid & 3) * 4; const f32x4 v = *(const f32x4*)(P.w_in + (size_t)k * DINP + 2560 + c4);
        wdt[(c4 + 0) * 1032 + k] = f2bf(v[0]); wdt[(c4 + 1) * 1032 + k] = f2bf(v[1]); wdt[(c4 + 2) * 1032 + k] = f2bf(v[2]); wdt[(c4 + 3) * 1032 + k] = f2bf(v[3]); }
    __syncthreads();
    const int row = ci * 128 + wid * 16 + r16;
    const float* src = (row < TPR ? P.x_prompt + (size_t)row * 1024 : P.x_sample + (size_t)(row - TPR) * 1024) + 8 * q;
    bf16_t* dst = (bf16_t*)(P.ws + WS_A1) + (size_t)row * 1024 + 8 * q;
    const LAS float* nw = nws + 8 * q;
    f32x4 acc = (f32x4){0.f, 0.f, 0.f, 0.f};
    float ss = 0.f;
    f32x4 xa[2][8], xb[2][8];
#pragma unroll
    for (int u = 0; u < 8; ++u) { xa[0][u] = __builtin_nontemporal_load((const f32x4*)(src + 32 * u)); xb[0][u] = __builtin_nontemporal_load((const f32x4*)(src + 32 * u + 4)); }
#pragma unroll
    for (int bt = 0; bt < 4; ++bt) { const int s0 = 8 * bt;
        if (bt < 3) {
#pragma unroll
            for (int u = 0; u < 8; ++u) { xa[(bt + 1) & 1][u] = __builtin_nontemporal_load((const f32x4*)(src + 32 * (s0 + 8 + u))); xb[(bt + 1) & 1][u] = __builtin_nontemporal_load((const f32x4*)(src + 32 * (s0 + 8 + u) + 4)); } }
#pragma unroll
        for (int u = 0; u < 8; ++u) { const int sidx = s0 + u; const f32x4 wa = *(const LAS f32x4*)(nw + 32 * sidx), wb = *(const LAS f32x4*)(nw + 32 * sidx + 4);
            const f32x4 a = xa[bt & 1][u], b = xb[bt & 1][u];
            ss += a[0] * a[0] + a[1] * a[1] + a[2] * a[2] + a[3] * a[3] + b[0] * b[0] + b[1] * b[1] + b[2] * b[2] + b[3] * b[3];
            const f32x4 ya = a * wa, yb = b * wb;
            u32x4 pk; pk.x = cvt_pk_bf16(ya[0], ya[1]); pk.y = cvt_pk_bf16(ya[2], ya[3]); pk.z = cvt_pk_bf16(yb[0], yb[1]); pk.w = cvt_pk_bf16(yb[2], yb[3]);
            *(u32x4*)(dst + 32 * sidx) = pk;
            const bf16x8 bfr = *(const LAS bf16x8*)(wdt + r16 * 1032 + 32 * sidx + 8 * q);
            acc = __builtin_amdgcn_mfma_f32_16x16x32_bf16(__builtin_bit_cast(bf16x8, pk), bfr, acc, 0, 0, 0); }
    }
    ss += __shfl_xor(ss, 16); ss += __shfl_xor(ss, 32);
    const float rstd = rsqrtf(ss * (1.0f / 1024.0f) + EPS);
    if (q == 0) ((float*)(P.ws + WS_RSTD))[row] = rstd;
#pragma unroll
    for (int j = 0; j < 4; ++j) acc[j] *= __shfl(rstd, 4 * q + j);
    { const float bias = P.dt_bias[r16];
#pragma unroll
      for (int j = 0; j < 4; ++j) dts[(wid * 16 + 4 * q + j) * 16 + r16] = softplus_f(acc[j] + bias); }
    __syncthreads();
    if (ci < 128) {
        const int b = ci >> 4, c = ci & 15, h = tid & 15, seg = (tid >> 4) & 15;
        float d[8], cs[8];
        if (tid < 256) { const float a = -__expf(P.a_log[h]); float run = 0.f;
#pragma unroll
            for (int i = 0; i < 8; ++i) { d[i] = dts[(seg * 8 + i) * 16 + h]; run += d[i] * a; cs[i] = run; }
            segs[seg * 16 + h] = run; }
        __syncthreads();
        if (tid < 256) { float pre = 0.f;
#pragma unroll
            for (int s2 = 0; s2 < 16; ++s2) pre += (s2 < seg) ? segs[s2 * 16 + h] : 0.f;
#pragma unroll
            for (int i = 0; i < 8; ++i) cs[i] += pre;
            const size_t o = (size_t)(b * 16 + h) * 2048 + c * 128 + seg * 8;
            st8f((float*)(P.ws + WS_DT) + o, d); st8f((float*)(P.ws + WS_ACUM) + o, cs); }
    } else {
        float* dtsg = (float*)(P.ws + WS_DTS);
        for (int i = tid; i < 2048; i += 512) dtsg[i] = dts[i];
    }
    __syncthreads();
}
__device__ __forceinline__ void tile_decode(const Params& P, int t, const float*& src, bf16_t*& dst, int& K, int& Ns, int& k0, int& n0, int& c0) {
    int kt, nt;
    if (t < 1408) { src = P.w_in; dst = (bf16_t*)(P.ws + WS_WIN); K = 1024; Ns = DINP; kt = t / 88; nt = t % 88; c0 = -1; }
    else if (t < 1920) { t -= 1408; src = P.w_out; dst = (bf16_t*)(P.ws + WS_WOUT); K = 2048; Ns = 1024; kt = t >> 4; nt = t & 15; c0 = nt * 64; }
    else if (t < 3328) { t -= 1920; src = P.w_ffn_in; dst = (bf16_t*)(P.ws + WS_WFFN); K = 1024; Ns = NIN; kt = t / 88; nt = t % 88; { const int j0 = nt * 64, k = j0 >> 8, w = j0 & 255; c0 = w < 128 ? k * 128 + w : DFF + k * 128 + (w - 128); } }
    else { t -= 3328; src = P.w_down; dst = (bf16_t*)(P.ws + WS_WDOWN); K = 2816; Ns = 1024; kt = t >> 4; nt = t & 15; c0 = nt * 64; }
    k0 = kt * 64; n0 = nt * 64;
}
__device__ __forceinline__ void conv_tiles(const Params& P, LAS unsigned char* lds, int tb, int te, int stride) {
    const int tid = threadIdx.x;
    LAS float* tl = (LAS float*)lds;
    for (int t4 = tb; t4 < te; t4 += 4 * stride) {
        f32x4 v[4][2];
#pragma unroll
        for (int u = 0; u < 4; ++u) { const int t = t4 + u * stride; if (t < te) { const float* src; bf16_t* dst; int K, Ns, k0, n0, c0; tile_decode(P, t, src, dst, K, Ns, k0, n0, c0);
            const int col = c0 < 0 ? map_in4(n0 + (tid & 15) * 4) : c0 + (tid & 15) * 4;
#pragma unroll
            for (int i = 0; i < 2; ++i) v[u][i] = *(const f32x4*)(src + (size_t)(k0 + (tid >> 4) + 32 * i) * Ns + col); } }
#pragma unroll
        for (int u = 0; u < 4; ++u) { const int t = t4 + u * stride; if (t < te) {
#pragma unroll
            for (int i = 0; i < 2; ++i) { const int kr = (tid >> 4) + 32 * i, c4 = (tid & 15) * 4; LAS float* d = tl + u * 4160 + kr * 65 + c4; d[0] = v[u][i][0]; d[1] = v[u][i][1]; d[2] = v[u][i][2]; d[3] = v[u][i][3]; } } }
        __syncthreads();
#pragma unroll
        for (int u = 0; u < 4; ++u) { const int t = t4 + u * stride; if (t < te) { const float* src; bf16_t* dst; int K, Ns, k0, n0, c0; tile_decode(P, t, src, dst, K, Ns, k0, n0, c0);
            const int n = tid >> 3, k8 = (tid & 7) * 8; float f[8];
#pragma unroll
            for (int i = 0; i < 8; ++i) f[i] = tl[u * 4160 + (k8 + i) * 65 + n];
            *(u32x4*)(dst + (size_t)(n0 + n) * K + k0 + k8) = pack8(f); } }
        __syncthreads();
    }
}
__device__ __forceinline__ void phase0(const Params& P, LAS unsigned char* lds) {
    const int G = gridDim.x, bx = blockIdx.x, NCI = 129;
    for (int ci = bx; ci < NCI; ci += G) p0_chunk(P, lds, ci);
    if (G > NCI) { if (bx >= NCI) conv_tiles(P, lds, bx - NCI, 1408, G - NCI); }
    else conv_tiles(P, lds, bx, 1408, G);
}
__device__ __forceinline__ void p1_late_tiles(const Params& P, LAS unsigned char* lds) {
    const int G = gridDim.x, bx = blockIdx.x, nwg = (TPAD / 256) * (NIN / 256), nfull = nwg % G;
    if (nfull > 0 && nfull < G) { if (bx >= nfull) conv_tiles(P, lds, 1408 + bx - nfull, 4032, G - nfull); }
    else conv_tiles(P, lds, 1408 + bx, 4032, G);
}

__device__ __forceinline__ void p2_conv_load(const Params& P, int item, u32x4 (&pre)[3]) {
    const int tid = threadIdx.x;
    const int strip = item % 24, bc = item / 24, b = bc >> 4, c = bc & 15, t0 = c * 128;
    const int colg = strip < 16 ? strip * 64 : (strip < 20 ? 1024 + (strip - 16) * 64 : 1280 + (strip - 20) * 64);
    const bf16_t* xbc = (const bf16_t*)(P.ws + WS_XBC);
#pragma unroll
    for (int k = 0; k < 3; ++k) { const int i = tid + 512 * k; pre[k] = (u32x4){0u, 0u, 0u, 0u};
        if (i < 131 * 8) { const int rr = i >> 3, c8 = (i & 7) * 8, tl = t0 - 3 + rr; if (tl >= 0) pre[k] = *(const u32x4*)(xbc + (size_t)(b * 2048 + tl) * XBC + colg + c8); } }
}
__device__ __forceinline__ void p2_conv_item(const Params& P, LAS unsigned char* lds, int item, int next_item, u32x4 (&pre)[3]) {
    const int tid = threadIdx.x;
    const int strip = item % 24, bc = item / 24, b = bc >> 4, c = bc & 15, t0 = c * 128;
    const int colg = strip < 16 ? strip * 64 : (strip < 20 ? 1024 + (strip - 16) * 64 : 1280 + (strip - 20) * 64);
    LAS bf16_t* raw = (LAS bf16_t*)lds;
    LAS bf16_t* outn = (LAS bf16_t*)(lds + 16768);
#pragma unroll
    for (int k = 0; k < 3; ++k) { const int i = tid + 512 * k; if (i < 131 * 8) *(LAS u32x4*)(raw + (i >> 3) * 64 + (i & 7) * 8) = pre[k]; }
    __syncthreads();
    if (next_item >= 0) p2_conv_load(P, next_item, pre);
    const int col = tid & 63, rg = tid >> 6;
    const float w0 = P.ssd_conv_w[colg + col], w1 = P.ssd_conv_w[XBC + colg + col], w2 = P.ssd_conv_w[2 * XBC + colg + col], w3 = P.ssd_conv_w[3 * XBC + colg + col], bs = P.ssd_conv_b[colg + col];
    float o[16];
    { float x0 = bf2f(raw[(rg * 16 + 0) * 64 + col]), x1 = bf2f(raw[(rg * 16 + 1) * 64 + col]), x2 = bf2f(raw[(rg * 16 + 2) * 64 + col]);
#pragma unroll
      for (int i = 0; i < 16; ++i) { const float x3 = bf2f(raw[(rg * 16 + i + 3) * 64 + col]); o[i] = silu_f(x0 * w0 + x1 * w1 + x2 * w2 + x3 * w3 + bs); x0 = x1; x1 = x2; x2 = x3; } }
    u32x4 pk0, pk1;
    pk0.x = cvt_pk_bf16(o[0], o[1]); pk0.y = cvt_pk_bf16(o[2], o[3]); pk0.z = cvt_pk_bf16(o[4], o[5]); pk0.w = cvt_pk_bf16(o[6], o[7]);
    pk1.x = cvt_pk_bf16(o[8], o[9]); pk1.y = cvt_pk_bf16(o[10], o[11]); pk1.z = cvt_pk_bf16(o[12], o[13]); pk1.w = cvt_pk_bf16(o[14], o[15]);
    LAS unsigned char* outT = lds + 16768 + 16384;
    if (strip < 20) { *(LAS u32x4*)(outT + col * 272 + rg * 32) = pk0; *(LAS u32x4*)(outT + col * 272 + rg * 32 + 16) = pk1; }
    if (strip >= 16) {
#pragma unroll
        for (int i = 0; i < 16; ++i) outn[(rg * 16 + i) * 64 + col] = f2bf(o[i]); }
    __syncthreads();
    if (strip < 20) {
        bf16_t* dT = strip < 16 ? (bf16_t*)(P.ws + WS_A1) + ((size_t)(b * 16 + strip) * 64) * 2048 + t0
                                : (bf16_t*)((unsigned char*)P.out + OS_BT) + ((size_t)(b * 2 + ((strip - 16) >> 1)) * 128 + ((strip - 16) & 1) * 64) * 2048 + t0;
        for (int i = tid; i < 1024; i += 512) { const int rr = i >> 4, c16 = i & 15; *(u32x4*)(dT + (size_t)rr * 2048 + c16 * 8) = *(const LAS u32x4*)(outT + rr * 272 + c16 * 16); }
    }
    if (strip >= 16) {
        const int sb = (strip - 16) & 3, g = sb >> 1, n0 = (sb & 1) * 64;
        bf16_t* nat = (bf16_t*)((unsigned char*)P.out + (strip < 20 ? OS_BN : OS_CN)) + ((size_t)(b * 2 + g) * 2048 + t0) * 128 + n0;
        for (int i = tid; i < 1024; i += 512) { const int rr = i >> 3, c8 = (i & 7) * 8; *(u32x4*)(nat + (size_t)rr * 128 + c8) = *(const LAS u32x4*)(outn + rr * 64 + c8); }
    }
    if (c == 15 && tid < 192) { const int rr = tid >> 6; P.out[O_PSSDC + (size_t)(b * 3 + rr) * XBC + colg + col] = bf2f(raw[(128 + rr) * 64 + col]); }
    __syncthreads();
}
__device__ __forceinline__ void p2_state_load(const Params& P, int item, int i0, f32x4 (&hv)[16]) {
    const int lane = threadIdx.x & 63, wid = threadIdx.x >> 6, bs = item >> 1, g = item & 1;
    const float* hin = P.state_ssm + ((size_t)(bs * 16 + g * 8 + wid) * 64 + (lane >> 5)) * 128 + 4 * (lane & 31);
#pragma unroll
    for (int i = 0; i < 16; ++i) hv[i] = __builtin_nontemporal_load((const f32x4*)(hin + (size_t)(i0 + i) * 256));
}
__device__ __forceinline__ void p2_sample_item(const Params& P, LAS unsigned char* lds, int item) {
    const int tid = threadIdx.x, lane = tid & 63, wid = tid >> 6;
    const int bs = item >> 1, g = item & 1, row = TPR + bs;
    LAS float* sx = (LAS float*)lds;
    const int half = lane >> 5, l32 = lane & 31;
    float* hout = P.out + O_SSSM + ((size_t)(bs * 16 + g * 8 + wid) * 64 + half) * 128 + 4 * l32;
    f32x4 hva[16]; p2_state_load(P, item, 0, hva);
    LAS float* ssqs = sx + 768;
    const bf16_t* xbc = (const bf16_t*)(P.ws + WS_XBC) + (size_t)row * XBC;
    bf16_t* mix = (bf16_t*)(P.ws + WS_MIX) + (size_t)row * 2048;
    for (int i = tid; i < 768; i += 512) {
        const int j = i < 512 ? g * 512 + i : (i < 640 ? 1024 + g * 128 + (i - 512) : 1280 + g * 128 + (i - 640));
        const float* st = P.state_ssd_conv + (size_t)bs * 3 * XBC + j;
        const float s0 = st[0], s1 = st[XBC], s2 = st[2 * XBC], xr = bf2f(xbc[j]);
        const float v = s0 * P.ssd_conv_w[j] + s1 * P.ssd_conv_w[XBC + j] + s2 * P.ssd_conv_w[2 * XBC + j] + xr * P.ssd_conv_w[3 * XBC + j] + P.ssd_conv_b[j];
        sx[i] = silu_f(v);
        float* so = P.out + O_SSSDC + (size_t)bs * 3 * XBC + j; so[0] = s1; so[XBC] = s2; so[2 * XBC] = xr;
    }
    __syncthreads();
    const int h = g * 8 + wid;
    const float dt = ((const float*)(P.ws + WS_DTS))[bs * 16 + h], a = -__expf(P.a_log[h]), dA = __expf(dt * a);
    const f32x4 Bv = *(const LAS f32x4*)(sx + 512 + 4 * l32), Cv = *(const LAS f32x4*)(sx + 640 + 4 * l32);
    float v[32];
#pragma unroll
    for (int i0 = 0; i0 < 32; i0 += 16) {
        f32x4 hv[16];
        if (i0 == 0) {
#pragma unroll
            for (int i = 0; i < 16; ++i) hv[i] = hva[i]; }
        else p2_state_load(P, item, 16, hv);
#pragma unroll
        for (int i = 0; i < 16; ++i) { const float xd = dt * sx[wid * 64 + 2 * (i0 + i) + half]; const f32x4 hn = dA * hv[i] + xd * Bv;
            __builtin_nontemporal_store(hn, (f32x4*)(hout + (size_t)(i0 + i) * 256));
            v[i0 + i] = hn[0] * Cv[0] + hn[1] * Cv[1] + hn[2] * Cv[2] + hn[3] * Cv[3]; }
    }
#pragma unroll
    for (int m = 16; m >= 1; m >>= 1) {
#pragma unroll
        for (int i = 0; i < m; ++i) { const bool up = (l32 & m) != 0; const float keep = up ? v[i + m] : v[i], send = up ? v[i] : v[i + m]; v[i] = keep + __shfl_xor(send, m); } }
    const int pl = 2 * l32 + half;
    const float ymine = v[0];
    const float xsv = sx[wid * 64 + pl];
    float y = ymine + P.ssd_d[h] * xsv;
    y *= silu_f(bf2f(mix[h * 64 + pl]));
    float sq = y * y;
    sq += __shfl_xor(sq, 1); sq += __shfl_xor(sq, 2); sq += __shfl_xor(sq, 4); sq += __shfl_xor(sq, 8); sq += __shfl_xor(sq, 16); sq += __shfl_xor(sq, 32);
    if (lane == 0) ssqs[wid] = sq;
    __syncthreads();
    float tot = 0.f;
#pragma unroll
    for (int i = 0; i < 8; ++i) tot += ssqs[i];
    const float rstd = rsqrtf(tot * (1.0f / 512.0f) + EPS);
    mix[h * 64 + pl] = f2bf(y * rstd * P.ssd_norm_w[h * 64 + pl]);
    __syncthreads();
}

__device__ __forceinline__ void p3_item(const Params& P, LAS unsigned char* lds, int item) {
    const int tid = threadIdx.x, lane = tid & 63, wid = tid >> 6, r16 = lane & 15, q = lane >> 4;
    const int b = item >> 5, c = (item >> 1) & 15, g = item & 1, h = g * 8 + wid, t0 = c * 128;
    LAS float* wsc = (LAS float*)lds + wid * 128;
    LAS unsigned char* btl = lds + 4096;
    const bf16_t* BTp = (const bf16_t*)((const unsigned char*)P.out + OS_BT) + ((size_t)(b * 2 + g) * 128) * 2048 + t0;
    u32x4 btr[4];
#pragma unroll
    for (int k = 0; k < 4; ++k) { const int i = tid + 512 * k; btr[k] = *(const u32x4*)(BTp + (size_t)(i >> 4) * 2048 + (i & 15) * 8); }
    const float* dtp = (const float*)(P.ws + WS_DT) + (size_t)(b * 16 + h) * 2048 + t0;
    const float* acp = (const float*)(P.ws + WS_ACUM) + (size_t)(b * 16 + h) * 2048 + t0;
    const float alast = acp[127];
    wsc[lane] = dtp[lane] * __expf(alast - acp[lane]); wsc[lane + 64] = dtp[lane + 64] * __expf(alast - acp[lane + 64]);
#pragma unroll
    for (int k = 0; k < 4; ++k) { const int i = tid + 512 * k; *(LAS u32x4*)(btl + (i >> 4) * 272 + (i & 15) * 16) = btr[k]; }
    __syncthreads();
    const bf16_t* xsT = (const bf16_t*)(P.ws + WS_A1) + ((size_t)(b * 16 + h) * 64) * 2048 + t0;
    f32x4 acc[8][4];
#pragma unroll
    for (int i = 0; i < 8; ++i)
#pragma unroll
        for (int j = 0; j < 4; ++j) acc[i][j] = (f32x4){0.f, 0.f, 0.f, 0.f};
#pragma unroll 2
    for (int kk = 0; kk < 4; ++kk) { const int s0 = 32 * kk + 8 * q;
        float sc[8]; { const f32x4 a = *(const LAS f32x4*)(wsc + s0), b2 = *(const LAS f32x4*)(wsc + s0 + 4); sc[0] = a[0]; sc[1] = a[1]; sc[2] = a[2]; sc[3] = a[3]; sc[4] = b2[0]; sc[5] = b2[1]; sc[6] = b2[2]; sc[7] = b2[3]; }
        bf16x8 bfr[4];
#pragma unroll
        for (int pt = 0; pt < 4; ++pt) { const u32x4 rawv = *(const u32x4*)(xsT + (size_t)(pt * 16 + r16) * 2048 + s0); float f[8]; unpack8(rawv, f);
#pragma unroll
            for (int j = 0; j < 8; ++j) f[j] *= sc[j];
            bfr[pt] = __builtin_bit_cast(bf16x8, pack8(f)); }
#pragma unroll
        for (int nt = 0; nt < 8; ++nt) { const bf16x8 afr = *(const LAS bf16x8*)(btl + (nt * 16 + r16) * 272 + s0 * 2);
#pragma unroll
            for (int pt = 0; pt < 4; ++pt) acc[nt][pt] = __builtin_amdgcn_mfma_f32_16x16x32_bf16(afr, bfr[pt], acc[nt][pt], 0, 0, 0); }
    }
    bf16_t* stp = (bf16_t*)((unsigned char*)P.out + OS_ST) + (((size_t)(b * 16 + c) * 16 + h) * 64) * 128;
#pragma unroll
    for (int nt = 0; nt < 8; ++nt)
#pragma unroll
        for (int pt = 0; pt < 4; ++pt) { u32x2 w; w.x = cvt_pk_bf16(acc[nt][pt][0], acc[nt][pt][1]); w.y = cvt_pk_bf16(acc[nt][pt][2], acc[nt][pt][3]);
            *(u32x2*)(stp + (size_t)(((nt * 4 + pt) * 4 + q) * 16 + r16) * 4) = w; }
    __syncthreads();
}

__device__ __forceinline__ void phase4(const Params& P) {
    const int tid = threadIdx.x, G = gridDim.x, bx = blockIdx.x;
    for (int idx = bx * 512 + tid; idx < 262144; idx += G * 512) {
        const int n4 = idx & 31, pp = (idx >> 5) & 63, h = (idx >> 11) & 15, b = idx >> 15;
        const float* acp = (const float*)(P.ws + WS_ACUM) + (size_t)(b * 16 + h) * 2048;
        f32x4 hs = (f32x4){0.f, 0.f, 0.f, 0.f};
        u32x2* ptr0 = (u32x2*)((bf16_t*)((unsigned char*)P.out + OS_ST) + ((((size_t)(b * 16) * 16 + h) * 64 + pp) * 128 + n4 * 4));
        u32x2 sv[16]; float dec[16];
#pragma unroll
        for (int c = 0; c < 16; ++c) { sv[c] = ptr0[(size_t)c * 32768]; dec[c] = acp[c * 128 + 127]; }
#pragma unroll
        for (int c = 0; c < 16; ++c) { u32x2 w; w.x = cvt_pk_bf16(hs[0], hs[1]); w.y = cvt_pk_bf16(hs[2], hs[3]); ptr0[(size_t)c * 32768] = w;
            const float d = __expf(dec[c]); const u32x2 sc = sv[c];
            hs[0] = d * hs[0] + bf_lo(sc.x); hs[1] = d * hs[1] + bf_hi(sc.x); hs[2] = d * hs[2] + bf_lo(sc.y); hs[3] = d * hs[3] + bf_hi(sc.y); }
        { const int e = idx & 2047, er = e & 15, eq = (e >> 4) & 3, ept = (e >> 6) & 3, ent = e >> 8;
          *(f32x4*)(P.out + O_PSSM + ((size_t)(b * 16 + h) * 64 + ept * 16 + er) * 128 + ent * 16 + 4 * eq) = hs; }
    }
}

__device__ __forceinline__ void p5_stage_load(const bf16_t* Hp, const bf16_t* xsT, u32x4 (&sr)[4]) {
    const int tid = threadIdx.x;
#pragma unroll
    for (int k = 0; k < 2; ++k) { const int i = tid + 512 * k, row = i >> 4, c16 = i & 15;
        sr[k] = *(const u32x4*)(Hp + (size_t)row * 128 + c16 * 8); sr[2 + k] = *(const u32x4*)(xsT + (size_t)row * 2048 + c16 * 8); }
}
__device__ __forceinline__ void p5_stage_write(LAS unsigned char* buf, const u32x4 (&sr)[4]) {
    const int tid = threadIdx.x;
#pragma unroll
    for (int k = 0; k < 2; ++k) { const int i = tid + 512 * k, row = i >> 4, c16 = i & 15;
        { const int e = 2 * i, er = e & 15, eq = (e >> 4) & 3, ept = (e >> 6) & 3, ent = e >> 8;
          LAS unsigned char* d = buf + (ept * 16 + er) * 272 + (ent * 16 + 4 * eq) * 2; u32x2 lo, hi; lo.x = sr[k].x; lo.y = sr[k].y; hi.x = sr[k].z; hi.y = sr[k].w;
          *(LAS u32x2*)d = lo; *(LAS u32x2*)(d + 272) = hi; }
        *(LAS u32x4*)(buf + 17408 + row * 272 + c16 * 16) = sr[2 + k]; }
}
__device__ __forceinline__ void p5_item(const Params& P, LAS unsigned char* lds, int item) {
    const int tid = threadIdx.x, lane = tid & 63, w = __builtin_amdgcn_readfirstlane(tid >> 6), r16 = lane & 15, q = lane >> 4;
    const int b = item >> 5, c = (item >> 1) & 15, g = item & 1, t0 = c * 128, l0 = 16 * w;
    LAS float* acs = (LAS float*)lds;
    LAS float* dtl = acs + 1024;
    LAS unsigned char* sbuf = lds + 8192;
    LAS float* nwl = (LAS float*)(lds + 8192 + 69632);
    nwl[tid] = P.ssd_norm_w[g * 512 + tid];
    const bf16_t* Hbase = (const bf16_t*)((const unsigned char*)P.out + OS_ST) + (((size_t)(b * 16 + c) * 16 + g * 8) * 64) * 128;
    const bf16_t* Xbase = (const bf16_t*)(P.ws + WS_A1) + ((size_t)(b * 16 + g * 8) * 64) * 2048 + t0;
    u32x4 sr[4];
    p5_stage_load(Hbase, Xbase, sr);
    const bf16_t* Bn = (const bf16_t*)((const unsigned char*)P.out + OS_BN) + ((size_t)(b * 2 + g) * 2048 + t0) * 128;
    u32x4 bnr[4];
#pragma unroll
    for (int k = 0; k < 4; ++k) { const int i = tid + 512 * k; bnr[k] = *(const u32x4*)(Bn + (size_t)(i >> 4) * 128 + (i & 15) * 8); }
    if (tid < 256) { const size_t o = (size_t)(b * 16 + g * 8 + (tid >> 5)) * 2048 + t0 + (tid & 31) * 4;
      *(LAS f32x4*)(acs + tid * 4) = *(const f32x4*)((const float*)(P.ws + WS_ACUM) + o); *(LAS f32x4*)(dtl + tid * 4) = *(const f32x4*)((const float*)(P.ws + WS_DT) + o); }
    const bf16_t* Cn = (const bf16_t*)((const unsigned char*)P.out + OS_CN) + ((size_t)(b * 2 + g) * 2048 + t0) * 128;
    bf16x8 cfr[4];
#pragma unroll
    for (int kk = 0; kk < 4; ++kk) cfr[kk] = *(const bf16x8*)(Cn + (size_t)(l0 + r16) * 128 + 32 * kk + 8 * q);
    LAS unsigned char* bnl = sbuf + 34816;
#pragma unroll
    for (int k = 0; k < 4; ++k) { const int i = tid + 512 * k; *(LAS u32x4*)(bnl + (i >> 4) * 272 + (i & 15) * 16) = bnr[k]; }
    p5_stage_write(sbuf, sr);
    __syncthreads();
    f32x4 GT[8];
#pragma unroll
    for (int j = 0; j < 8; ++j) GT[j] = (f32x4){0.f, 0.f, 0.f, 0.f};
#pragma unroll
    for (int j = 0; j < 8; ++j) if (j <= w) {
#pragma unroll
        for (int kk = 0; kk < 4; ++kk) { const bf16x8 afr = *(const LAS bf16x8*)(bnl + (16 * j + r16) * 272 + 64 * kk + 16 * q); GT[j] = __builtin_amdgcn_mfma_f32_16x16x32_bf16(afr, cfr[kk], GT[j], 0, 0, 0); } }
    __syncthreads();
    const int lidx = l0 + r16;
    bf16_t* mixrow = (bf16_t*)(P.ws + WS_MIX) + (size_t)(b * 2048 + t0 + lidx) * 2048;
    float ssq = 0.f;
    if (PROBE_MASK && blockIdx.x == 0 && tid == 0) ((unsigned long long*)(P.ws + WS_BAR + 14336))[14] = __builtin_amdgcn_s_memrealtime();
#pragma unroll 1
    for (int r = 0; r < 8; ++r) {
        const int h = g * 8 + r;
        if (r < 7) p5_stage_load(Hbase + (size_t)(r + 1) * 8192, Xbase + (size_t)(r + 1) * 131072, sr);
        u32x2 zz[4];
#pragma unroll
        for (int pt = 0; pt < 4; ++pt) zz[pt] = *(const u32x2*)(mixrow + h * 64 + pt * 16 + 4 * q);
        const LAS unsigned char* Hb = sbuf + (r & 1) * 34816 + r16 * 272 + 16 * q;
        const LAS unsigned char* Xb = sbuf + (r & 1) * 34816 + 17408 + r16 * 272 + 8 * q;
        const float acl = acs[r * 128 + lidx], Dh = P.ssd_d[h];
        f32x4 acc[4];
#pragma unroll
        for (int pt = 0; pt < 4; ++pt) acc[pt] = (f32x4){0.f, 0.f, 0.f, 0.f};
#pragma unroll
        for (int kk = 0; kk < 4; ++kk)
#pragma unroll
            for (int pt = 0; pt < 4; ++pt) { const bf16x8 afr = *(const LAS bf16x8*)(Hb + pt * 4352 + kk * 64); acc[pt] = __builtin_amdgcn_mfma_f32_16x16x32_bf16(afr, cfr[kk], acc[pt], 0, 0, 0); }
        { const float el = __expf(acl);
#pragma unroll
          for (int pt = 0; pt < 4; ++pt) acc[pt] *= el; }
#pragma unroll
        for (int kk = 0; kk < 4; ++kk) if (2 * kk <= w) {
            const f32x4 asa = *(const LAS f32x4*)(acs + r * 128 + 32 * kk + 4 * q), dta = *(const LAS f32x4*)(dtl + r * 128 + 32 * kk + 4 * q);
            const f32x4 asb = *(const LAS f32x4*)(acs + r * 128 + 32 * kk + 16 + 4 * q), dtb = *(const LAS f32x4*)(dtl + r * 128 + 32 * kk + 16 + 4 * q);
            float m[8];
#pragma unroll
            for (int j = 0; j < 4; ++j) { const int s = 32 * kk + 4 * q + j; float v = GT[2 * kk][j] * __expf(fminf(acl - asa[j], 0.f)) * dta[j]; v = s > lidx ? 0.f : v; v = s == lidx ? v + Dh : v; m[j] = v; }
#pragma unroll
            for (int j = 0; j < 4; ++j) { const int s = 32 * kk + 16 + 4 * q + j; float v = GT[2 * kk + 1][j] * __expf(fminf(acl - asb[j], 0.f)) * dtb[j]; v = s > lidx ? 0.f : v; v = s == lidx ? v + Dh : v; m[4 + j] = v; }
            const bf16x8 bfr = __builtin_bit_cast(bf16x8, pack8(m));
#pragma unroll
            for (int pt = 0; pt < 4; ++pt) { const u32x2 lo = *(const LAS u32x2*)(Xb + pt * 4352 + kk * 64), hi = *(const LAS u32x2*)(Xb + pt * 4352 + kk * 64 + 32);
                u32x4 av; av.x = lo.x; av.y = lo.y; av.z = hi.x; av.w = hi.y;
                acc[pt] = __builtin_amdgcn_mfma_f32_16x16x32_bf16(__builtin_bit_cast(bf16x8, av), bfr, acc[pt], 0, 0, 0); }
        }
#pragma unroll
        for (int pt = 0; pt < 4; ++pt) {
            const float y0 = acc[pt][0] * silu_f(bf_lo(zz[pt].x)), y1 = acc[pt][1] * silu_f(bf_hi(zz[pt].x)), y2 = acc[pt][2] * silu_f(bf_lo(zz[pt].y)), y3 = acc[pt][3] * silu_f(bf_hi(zz[pt].y));
            ssq += y0 * y0 + y1 * y1 + y2 * y2 + y3 * y3;
            const f32x4 nw = *(const LAS f32x4*)(nwl + r * 64 + pt * 16 + 4 * q);
            u32x2 o; o.x = cvt_pk_bf16(y0 * nw[0], y1 * nw[1]); o.y = cvt_pk_bf16(y2 * nw[2], y3 * nw[3]); *(u32x2*)(mixrow + h * 64 + pt * 16 + 4 * q) = o; }
        if (r < 7) p5_stage_write(sbuf + ((r + 1) & 1) * 34816, sr);
        __syncthreads();
    }
    if (PROBE_MASK && blockIdx.x == 0 && tid == 0) ((unsigned long long*)(P.ws + WS_BAR + 14336))[15] = __builtin_amdgcn_s_memrealtime();
    ssq += __shfl_xor(ssq, 16); ssq += __shfl_xor(ssq, 32);
    const float rstd = rsqrtf(ssq * (1.0f / 512.0f) + EPS);
    if (q == 0) ((float*)(P.ws + WS_GRS))[(size_t)(b * 2048 + t0 + lidx) * 2 + g] = rstd;
    __syncthreads();
    if (PROBE_MASK && blockIdx.x == 0 && tid == 0) ((unsigned long long*)(P.ws + WS_BAR + 14336))[16] = __builtin_amdgcn_s_memrealtime();
}

__device__ __forceinline__ void rmsnorm_rows(float* srcf, const bf16_t* src16, const float* w, bf16_t* dstb, float* dstf, const float* slab, int nslab, const float* xs_base) {
    const int tid = threadIdx.x, lane = tid & 63, wid = tid >> 6;
    f32x4 wv[4];
#pragma unroll
    for (int i = 0; i < 4; ++i) wv[i] = *(const f32x4*)(w + lane * 4 + i * 256);
    for (int row = blockIdx.x * 8 + wid; row < TT; row += gridDim.x * 8) {
        f32x4 v[4];
        if (row < TPR) {
            u32x2 r[4];
#pragma unroll
            for (int i = 0; i < 4; ++i) r[i] = *(const u32x2*)(src16 + (size_t)row * 1024 + lane * 4 + i * 256);
#pragma unroll
            for (int i = 0; i < 4; ++i) v[i] = (f32x4){bf_lo(r[i].x), bf_hi(r[i].x), bf_lo(r[i].y), bf_hi(r[i].y)};
        } else {
            const float* s = (xs_base ? xs_base + (size_t)(row - TPR) * 1024 : srcf + (size_t)row * 1024) + lane * 4;
#pragma unroll
            for (int i = 0; i < 4; ++i) v[i] = *(const f32x4*)(s + i * 256);
            for (int k = 0; k < nslab; ++k) { const float* sp = slab + ((size_t)k * 128 + (row - TPR)) * 1024 + lane * 4;
#pragma unroll
                for (int i = 0; i < 4; ++i) v[i] += *(const f32x4*)(sp + i * 256); }
            if (xs_base) {
#pragma unroll
                for (int i = 0; i < 4; ++i) *(f32x4*)(srcf + (size_t)row * 1024 + lane * 4 + i * 256) = v[i]; }
        }
        float ss = 0.f;
#pragma unroll
        for (int i = 0; i < 4; ++i) ss += v[i][0] * v[i][0] + v[i][1] * v[i][1] + v[i][2] * v[i][2] + v[i][3] * v[i][3];
        ss += __shfl_xor(ss, 1); ss += __shfl_xor(ss, 2); ss += __shfl_xor(ss, 4); ss += __shfl_xor(ss, 8); ss += __shfl_xor(ss, 16); ss += __shfl_xor(ss, 32);
        const float rstd = rsqrtf(ss * (1.0f / 1024.0f) + EPS);
#pragma unroll
        for (int i = 0; i < 4; ++i) { const f32x4 o = v[i] * rstd * wv[i];
            if (dstb) { u32x2 pk; pk.x = cvt_pk_bf16(o[0], o[1]); pk.y = cvt_pk_bf16(o[2], o[3]); *(u32x2*)(dstb + (size_t)row * 1024 + lane * 4 + i * 256) = pk; }
            else __builtin_nontemporal_store(o, (f32x4*)(dstf + (size_t)row * 1024 + lane * 4 + i * 256)); }
    }
}

__device__ __forceinline__ void phase9_fix(const Params& P, int G, int bx) {
    const int tid = threadIdx.x;
    bf16_t* act = (bf16_t*)(P.ws + WS_UP);
    const float* gf = (const float*)(P.ws + WS_SBGF); const float* gl = (const float*)(P.ws + WS_SBGL); const float* uf = (const float*)(P.ws + WS_SBUF);
    pg8::StaticOrder S; S.init(TPR, 1024, G, bx); pg8::Unit u;
    for (int i = 0; S.next(i, u); ++i) {
        const int pm = u.pm;
        if ((pm & 7) == 0) continue;
        for (int idx = tid; idx < 704; idx += 512) { const int c4 = idx * 4;
            const f32x4 w0 = *(const f32x4*)(P.ffn_conv_w + c4), w1 = *(const f32x4*)(P.ffn_conv_w + DFF + c4), w2 = *(const f32x4*)(P.ffn_conv_w + 2 * DFF + c4), bb = *(const f32x4*)(P.ffn_conv_b + c4);
            const f32x4 gl0 = *(const f32x4*)(gl + (size_t)((pm - 1) * 2) * DFF + c4), gl1 = *(const f32x4*)(gl + (size_t)((pm - 1) * 2 + 1) * DFF + c4);
            const f32x4 gf0 = *(const f32x4*)(gf + (size_t)(pm * 2) * DFF + c4), gf1 = *(const f32x4*)(gf + (size_t)(pm * 2 + 1) * DFF + c4);
            const f32x4 u0 = *(const f32x4*)(uf + (size_t)(pm * 2) * DFF + c4), u1 = *(const f32x4*)(uf + (size_t)(pm * 2 + 1) * DFF + c4);
            const f32x4 c0 = gl0 * w0 + gl1 * w1 + gf0 * w2 + bb, c1 = gl1 * w0 + gf0 * w1 + gf1 * w2 + bb;
            u32x2 o0, o1;
            o0.x = cvt_pk_bf16(silu_f(c0[0]) * u0[0], silu_f(c0[1]) * u0[1]); o0.y = cvt_pk_bf16(silu_f(c0[2]) * u0[2], silu_f(c0[3]) * u0[3]);
            o1.x = cvt_pk_bf16(silu_f(c1[0]) * u1[0], silu_f(c1[1]) * u1[1]); o1.y = cvt_pk_bf16(silu_f(c1[2]) * u1[2], silu_f(c1[3]) * u1[3]);
            *(u32x2*)(act + (size_t)(pm * 256) * DFF + c4) = o0; *(u32x2*)(act + (size_t)(pm * 256 + 1) * DFF + c4) = o1; }
    }
    for (int idx = bx * 512 + tid; idx < 8 * 2 * 704; idx += G * 512) {
        const int b = idx / 1408, r = (idx / 704) & 1, c4 = (idx % 704) * 4;
        *(f32x4*)(P.out + O_PFFN + (size_t)(b * 2 + r) * DFF + c4) = *(const f32x4*)(gl + (size_t)((8 * b + 7) * 2 + r) * DFF + c4);
    }
    asm volatile("s_waitcnt vmcnt(0)" ::: "memory");
    __syncthreads();
}

__device__ __forceinline__ void phase6_fix(const Params& P, int G, int bx) {
    const int tid = threadIdx.x;
    bf16_t* mix = (bf16_t*)(P.ws + WS_MIX);
    const float* uf = (const float*)(P.ws + WS_SCUF); const float* ul = (const float*)(P.ws + WS_SCUL); const float* gbf = (const float*)(P.ws + WS_SCGF);
    pg8::StaticOrder S; S.init(TPR, 1024, G, bx); pg8::Unit u;
    for (int i = 0; S.next(i, u); ++i) {
        const int pm = u.pm;
        if ((pm & 7) == 0 || tid >= 256) continue;
        const int c4 = tid * 4;
        const f32x4 w0 = *(const f32x4*)(P.sc_conv_w + c4), w1 = *(const f32x4*)(P.sc_conv_w + 1024 + c4), w2 = *(const f32x4*)(P.sc_conv_w + 2048 + c4);
        const f32x4 ul0 = *(const f32x4*)(ul + (size_t)((pm - 1) * 2) * 1024 + c4), ul1 = *(const f32x4*)(ul + (size_t)((pm - 1) * 2 + 1) * 1024 + c4);
        const f32x4 uf0 = *(const f32x4*)(uf + (size_t)(pm * 2) * 1024 + c4), uf1 = *(const f32x4*)(uf + (size_t)(pm * 2 + 1) * 1024 + c4);
        const f32x4 g0 = *(const f32x4*)(gbf + (size_t)(pm * 2) * 1024 + c4), g1 = *(const f32x4*)(gbf + (size_t)(pm * 2 + 1) * 1024 + c4);
        const f32x4 y0 = g0 * (ul0 * w0 + ul1 * w1 + uf0 * w2), y1 = g1 * (ul1 * w0 + uf0 * w1 + uf1 * w2);
        u32x2 o0, o1; o0.x = cvt_pk_bf16(y0[0], y0[1]); o0.y = cvt_pk_bf16(y0[2], y0[3]); o1.x = cvt_pk_bf16(y1[0], y1[1]); o1.y = cvt_pk_bf16(y1[2], y1[3]);
        *(u32x2*)(mix + (size_t)(pm * 256) * 2048 + 1024 + c4) = o0; *(u32x2*)(mix + (size_t)(pm * 256 + 1) * 2048 + 1024 + c4) = o1;
    }
    for (int idx = bx * 512 + tid; idx < 8 * 2 * 256; idx += G * 512) {
        const int b = idx >> 9, r = (idx >> 8) & 1, c4 = (idx & 255) * 4;
        *(f32x4*)(P.out + O_PSC + (size_t)(b * 2 + r) * 1024 + c4) = *(const f32x4*)(ul + (size_t)((8 * b + 7) * 2 + r) * 1024 + c4);
    }
    asm volatile("s_waitcnt vmcnt(0)" ::: "memory");
    __syncthreads();
}

constexpr int NPHASE = 12;
static_assert(WS_END <= (size_t)256 * 1024 * 1024, "workspace map exceeds the guaranteed 256 MiB");
static_assert(WS_UP + (size_t)TPAD * 2816 * 2 <= WS_BAR, "act overlays only the dead xBC / MIX region");
__global__ void __launch_bounds__(512, 2) fwd_megakernel(Params P) {
    extern __shared__ __attribute__((aligned(16))) unsigned char lds_raw[];
    LAS unsigned char* lds = (LAS unsigned char*)lds_raw;
    volatile LAS unsigned* stw = (volatile LAS unsigned*)(lds + 131072);
    if (threadIdx.x < 4) stw[threadIdx.x] = 0u;
    __syncthreads();
    const XcdBarrier bar = xcd_barrier_post((unsigned*)(P.ws + WS_BAR), stw);
    const int lo = P.ph_lo, hi = P.ph_hi, G = gridDim.x, bx = blockIdx.x;
#define IN(k) (lo <= (k) && (k) < hi)
    unsigned long long* stamps = (unsigned long long*)(P.ws + WS_BAR + 14336);
#define STAMP(k) do { if (PROBE_MASK && bx == 0 && threadIdx.x == 0) stamps[k] = __builtin_amdgcn_s_memrealtime(); } while (0)
    STAMP(0);
#define SEAM(k) do { if (IN(k) && IN((k) + 1)) xcd_barrier(bar); STAMP((k) + 1); } while (0)
    if (IN(0)) phase0(P, lds);
    SEAM(0);
    if (IN(1)) { pg8::Gemm g{(const bf16_t*)(P.ws + WS_A1), (const bf16_t*)(P.ws + WS_WIN), TPAD, NIN, 1024, 1024, 1024}; pg8::StaticOrder S; S.init(TPAD, NIN, G, bx);
        EpiIn E{(bf16_t*)(P.ws + WS_MIX), (bf16_t*)(P.ws + WS_XBC), (const float*)(P.ws + WS_RSTD), (float*)(P.ws + WS_SCUF), (float*)(P.ws + WS_SCUL), (float*)(P.ws + WS_SCGF), P.sc_conv_w, P.state_sc, P.out + O_SSC, (LAS float*)(lds + LDS_XCH)}; pg8::gemm_phase<EpiIn>(lds, g, S, E);
        p1_late_tiles(P, lds); }
    SEAM(1);
    if (IN(2)) { { u32x4 pre[3]; if (bx < 3072) p2_conv_load(P, bx, pre);
          for (int it = bx; it < 3072; it += G) p2_conv_item(P, lds, it, it + G < 3072 ? it + G : -1, pre); }
        STAMP(13);
        for (int it = bx; it < 256; it += G) p2_sample_item(P, lds, it); }
    SEAM(2);
    if (IN(3)) { for (int it = bx; it < 256; it += G) p3_item(P, lds, it); }
    SEAM(3);
    if (IN(4)) phase4(P);
    SEAM(4);
    if (IN(5)) { for (int it = bx; it < 256; it += G) p5_item(P, lds, it); }
    SEAM(5);
    if (IN(6)) { phase6_fix(P, G, bx);
        { pg8::Gemm g{(const bf16_t*)(P.ws + WS_MIX), (const bf16_t*)(P.ws + WS_WOUT), TPR, 1024, 2048, 2048, 2048}; pg8::StaticOrder S; S.init(TPR, 1024, G, bx);
          LAS float* sct = (LAS float*)(lds + LDS_XCH);
          { pg8::Unit u0; if (S.next(0, u0) && threadIdx.x < 256) { const float* gr = (const float*)(P.ws + WS_GRS) + (size_t)(u0.pm * 256 + threadIdx.x) * 2; const float r0 = gr[0], r1 = gr[1];
                sct[threadIdx.x] = r0 / r1; sct[256 + threadIdx.x] = r1; } }
          __syncthreads();
          EpiRes E{P.x_prompt, nullptr, (bf16_t*)(P.ws + WS_X1B)};
          pg8::gemm_phase<EpiRes, pg8::StaticOrder, true>(lds, g, S, E, sct); }
        { pg8::Gemm g{(const bf16_t*)(P.ws + WS_MIX) + (size_t)TPR * 2048, (const bf16_t*)(P.ws + WS_WOUT), 256, 1024, 256, 2048, 2048}; pg8::SplitOrder S{32, bx, 256};
          EpiSlab E{(float*)(P.ws + WS_SLAB)}; pg8::gemm_phase<EpiSlab>(lds, g, S, E); } }
    SEAM(6);
    if (IN(7)) rmsnorm_rows(P.out, (const bf16_t*)(P.ws + WS_X1B), P.norm_ffn_w, (bf16_t*)(P.ws + WS_A1), nullptr, (const float*)(P.ws + WS_SLAB), 8, P.x_sample);
    SEAM(7);
    if (IN(8)) { pg8::Gemm g{(const bf16_t*)(P.ws + WS_A1), (const bf16_t*)(P.ws + WS_WFFN), TPAD, NIN, 1024, 1024, 1024}; pg8::StaticOrder S; S.init(TPAD, NIN, G, bx);
        EpiFfnAct E{(bf16_t*)(P.ws + WS_UP), (float*)(P.ws + WS_SBGF), (float*)(P.ws + WS_SBGL), (float*)(P.ws + WS_SBUF), P.ffn_conv_w, P.ffn_conv_b, P.state_ffn, P.out + O_SFFN, (LAS float*)(lds + LDS_XCH)};
        pg8::gemm_phase<EpiFfnAct>(lds, g, S, E); }
    SEAM(8);
    if (IN(10)) { phase9_fix(P, G, bx);
        { pg8::Gemm g{(const bf16_t*)(P.ws + WS_UP), (const bf16_t*)(P.ws + WS_WDOWN), TPR, 1024, DFF, DFF, DFF}; pg8::StaticOrder S; S.init(TPR, 1024, G, bx);
          EpiRes E{nullptr, (const bf16_t*)(P.ws + WS_X1B), (bf16_t*)(P.ws + WS_A1)}; pg8::gemm_phase<EpiRes>(lds, g, S, E); }
        { pg8::Gemm g{(const bf16_t*)(P.ws + WS_UP) + (size_t)TPR * DFF, (const bf16_t*)(P.ws + WS_WDOWN), 256, 1024, 256, DFF, DFF}; pg8::SplitOrder S{44, bx, 256};
          EpiSlab E{(float*)(P.ws + WS_SLAB)}; pg8::gemm_phase<EpiSlab>(lds, g, S, E); } }
    SEAM(10);
    if (IN(11)) rmsnorm_rows(P.out, (const bf16_t*)(P.ws + WS_A1), P.norm_final_w, nullptr, P.out, (const float*)(P.ws + WS_SLAB), 11, nullptr);
    if (PROBE_MASK && bx == 0 && threadIdx.x == 0) {
        const unsigned long long tend = __builtin_amdgcn_s_memrealtime(); stamps[12] = tend; unsigned long long extra = 0;
        asm volatile("s_waitcnt vmcnt(0)" ::: "memory");
        for (int k = 0; k < 12; ++k) if ((PROBE_MASK >> k) & 1) extra += stamps[k + 1] - stamps[k];
        if (PROBE_MASK & 0x1000) extra += stamps[13] - stamps[2];
        if (PROBE_MASK & 0x2000) extra += stamps[15] - stamps[14];
        if (PROBE_MASK & 0x4000) extra += stamps[14] - stamps[5];
        if (PROBE_MASK & 0x8000) extra += stamps[16] - stamps[15];
        if (PROBE_MASK & 0x10000) extra += stamps[6] - stamps[16];
        while (__builtin_amdgcn_s_memrealtime() - tend < extra) __builtin_amdgcn_s_sleep(8);
    }
#undef IN
#undef SEAM
}

#ifndef N_LAUNCHES
#define N_LAUNCHES 1
#endif
extern "C" void kernel_launch(void* const* d_in, const int* in_sizes, int n_in, void* d_out, int out_size, void* d_ws, size_t ws_size, hipStream_t stream) {
    static int grid_blocks = 0;
    if (!grid_blocks) {
        int dev = 0, cus = 0, per_cu = 0;
        (void)hipGetDevice(&dev);
        (void)hipDeviceGetAttribute(&cus, hipDeviceAttributeMultiprocessorCount, dev);
        (void)hipFuncSetAttribute((const void*)fwd_megakernel, hipFuncAttributeMaxDynamicSharedMemorySize, LDS_BYTES);
        (void)hipOccupancyMaxActiveBlocksPerMultiprocessor(&per_cu, (const void*)fwd_megakernel, 512, LDS_BYTES);
        if (per_cu < 1) { fprintf(stderr, "occupancy query says %d blocks per CU\n", per_cu); per_cu = 1; }
        if (per_cu > 1) per_cu = 1;
        grid_blocks = cus * per_cu;
        if (grid_blocks > 256) grid_blocks = 256;
        if (grid_blocks < 256) { fprintf(stderr, "this kernel is built for a 256-CU device (resident capacity reported: %d workgroups); nothing launched\n", grid_blocks); grid_blocks = -1; }
        if (ws_size < WS_END) fprintf(stderr, "workspace too small: %zu < %zu\n", ws_size, (size_t)WS_END);
    }
    if (grid_blocks < 0) return;
    if (N_LAUNCHES == 1) (void)hipMemsetAsync((unsigned char*)d_ws + WS_BAR, 0, XCD_BAR_WORDS * 4, stream);
    Params p{};
    const float** pp = (const float**)&p;
    for (int i = 0; i < 22; ++i) pp[i] = (const float*)d_in[i];
    p.out = (float*)d_out; p.ws = (unsigned char*)d_ws;
    for (int li = 0; li < N_LAUNCHES; ++li) {
        p.ph_lo = (N_LAUNCHES == 1) ? 0 : li; p.ph_hi = (N_LAUNCHES == 1) ? NPHASE : li + 1;
        void* args[] = {&p};
        hipError_t e = hipLaunchCooperativeKernel((const void*)fwd_megakernel, dim3(grid_blocks), dim3(512), args, LDS_BYTES, stream);
        if (e != hipSuccess) fprintf(stderr, "cooperative launch failed: %s (grid %d)\n", hipGetErrorString(e), grid_blocks);
    }
}
```

```cpp
#include <hip/hip_runtime.h>
#include <cstdio>

#define PROBE_MASK 0
#define LAS __attribute__((address_space(3)))
typedef unsigned short bf16_t;
typedef short bf16x8 __attribute__((ext_vector_type(8)));
typedef float f32x4 __attribute__((ext_vector_type(4)));
typedef unsigned u32x4 __attribute__((ext_vector_type(4)));
typedef unsigned u32x2 __attribute__((ext_vector_type(2)));

constexpr int TPR = 16384, TSM = 128, TT = 16512, TPAD = 16640;
constexpr int NIN = 5632, DINP = 5648, XBC = 1536, DFF = 2816;
constexpr float EPS = 1e-5f;
constexpr int LDS_BYTES = 131072 + 16 + 4096;
constexpr int LDS_XCH = 131072 + 16;

constexpr size_t WS_WIN = 0;
constexpr size_t WS_WOUT = WS_WIN + (size_t)NIN * 1024 * 2;
constexpr size_t WS_WFFN = WS_WOUT + (size_t)1024 * 2048 * 2;
constexpr size_t WS_WDOWN = WS_WFFN + (size_t)NIN * 1024 * 2;
constexpr size_t WS_A1 = WS_WDOWN + (size_t)1024 * 2816 * 2;
constexpr size_t WS_DT = WS_A1 + (size_t)TPAD * 1024 * 2;
constexpr size_t WS_ACUM = WS_DT + (size_t)8 * 16 * 2048 * 4;
constexpr size_t WS_DTS = WS_ACUM + (size_t)8 * 16 * 2048 * 4;
constexpr size_t WS_RSTD = WS_DTS + (size_t)128 * 16 * 4;
constexpr size_t WS_BIG = WS_RSTD + (size_t)TPAD * 4;
constexpr size_t WS_XBC = WS_BIG;
constexpr size_t WS_MIX = WS_XBC + (size_t)TPAD * 1536 * 2;
constexpr size_t WS_UP = WS_BIG;
constexpr size_t WS_BAR = WS_MIX + (size_t)TPAD * 2048 * 2;
constexpr size_t WS_SLAB = WS_BAR + 16384;
constexpr size_t WS_SBGF = WS_SLAB + (size_t)11 * 128 * 1024 * 4;
constexpr size_t WS_SBGL = WS_SBGF + (size_t)65 * 2 * 2816 * 4;
constexpr size_t WS_SBUF = WS_SBGL + (size_t)65 * 2 * 2816 * 4;
constexpr size_t WS_SCUF = WS_SBUF + (size_t)65 * 2 * 2816 * 4;
constexpr size_t WS_SCUL = WS_SCUF + (size_t)65 * 2 * 1024 * 4;
constexpr size_t WS_SCGF = WS_SCUL + (size_t)65 * 2 * 1024 * 4;
constexpr size_t WS_X1B = WS_SCGF + (size_t)65 * 2 * 1024 * 4;
constexpr size_t WS_GRS = WS_X1B + (size_t)TPAD * 1024 * 2;
constexpr size_t WS_END = WS_GRS + (size_t)TPR * 2 * 4;
constexpr size_t OS_BN = 0;
constexpr size_t OS_BT = OS_BN + (size_t)8 * 2 * 2048 * 128 * 2;
constexpr size_t OS_CN = OS_BT + (size_t)8 * 2 * 2048 * 128 * 2;
constexpr size_t OS_ST = OS_CN + (size_t)8 * 2 * 2048 * 128 * 2;
constexpr size_t O_YS = 16777216, O_PSSM = 16908288, O_PSSDC = 17956864, O_PSC = 17993728, O_PFFN = 18010112;
constexpr size_t O_SSSM = 18055168, O_SSSDC = 34832384, O_SSC = 35422208, O_SFFN = 35684352;

typedef float f32x2_t __attribute__((ext_vector_type(2)));
typedef __bf16 bf16x2_t __attribute__((ext_vector_type(2)));
__device__ __forceinline__ unsigned cvt_pk_bf16(float lo, float hi) { const f32x2_t v = {lo, hi}; return __builtin_bit_cast(unsigned, __builtin_convertvector(v, bf16x2_t)); }
__device__ __forceinline__ float bf_lo(unsigned u) { return __uint_as_float(u << 16); }
__device__ __forceinline__ float bf_hi(unsigned u) { return __uint_as_float(u & 0xffff0000u); }
__device__ __forceinline__ bf16_t f2bf(float f) { return (bf16_t)(cvt_pk_bf16(f, 0.f) & 0xffffu); }
__device__ __forceinline__ float bf2f(bf16_t b) { return __uint_as_float(((unsigned)b) << 16); }
__device__ __forceinline__ float silu_f(float v) { return v * __builtin_amdgcn_rcpf(1.0f + __expf(-v)); }
__device__ __forceinline__ float softplus_f(float v) { return v > 20.f ? v : log1pf(__expf(v)); }
__device__ __forceinline__ void unpack8(const u32x4 u, float (&f)[8]) { f[0] = bf_lo(u.x); f[1] = bf_hi(u.x); f[2] = bf_lo(u.y); f[3] = bf_hi(u.y); f[4] = bf_lo(u.z); f[5] = bf_hi(u.z); f[6] = bf_lo(u.w); f[7] = bf_hi(u.w); }
__device__ __forceinline__ u32x4 pack8(const float (&f)[8]) { u32x4 u; u.x = cvt_pk_bf16(f[0], f[1]); u.y = cvt_pk_bf16(f[2], f[3]); u.z = cvt_pk_bf16(f[4], f[5]); u.w = cvt_pk_bf16(f[6], f[7]); return u; }
__device__ __forceinline__ void ld8f(const float* p, float (&f)[8]) { const f32x4 a = *(const f32x4*)p, b = *(const f32x4*)(p + 4); f[0] = a[0]; f[1] = a[1]; f[2] = a[2]; f[3] = a[3]; f[4] = b[0]; f[5] = b[1]; f[6] = b[2]; f[7] = b[3]; }
__device__ __forceinline__ void st8f(float* p, const float (&f)[8]) { *(f32x4*)p = (f32x4){f[0], f[1], f[2], f[3]}; *(f32x4*)(p + 4) = (f32x4){f[4], f[5], f[6], f[7]}; }


#define XB_TMO      128
#define XB_XCNT(j)  (256  + 64 * (j))
#define XB_XSUB(j)  (1280 + 64 * (j))
#define XB_XGEN(j)  (2304 + 64 * (j))
#define XB_TOP      3328
#define XB_TOPGEN   3392
#define XCD_BAR_WORDS 3456
#define XB_SPIN_CAP (1u << 18)
__device__ __forceinline__ unsigned xb_ld(unsigned* p)              { return __hip_atomic_load(p, __ATOMIC_RELAXED, __HIP_MEMORY_SCOPE_AGENT); }
__device__ __forceinline__ unsigned xb_add(unsigned* p, unsigned v) { return __hip_atomic_fetch_add(p, v, __ATOMIC_RELAXED, __HIP_MEMORY_SCOPE_AGENT); }
__device__ __forceinline__ unsigned xb_xcc_id() { return (unsigned)__builtin_amdgcn_s_getreg((3 << 11) | 20) & 0xFu; }
#define XB_SPIN(cond, bar) do { unsigned _sp = 0; while (cond) { __builtin_amdgcn_s_sleep(1); \
    if ((++_sp & 255u) == 0u) { if (xb_ld(&(bar)[XB_TMO])) break; if (_sp > XB_SPIN_CAP) { atomicAdd(&(bar)[XB_TMO], 1u); break; } } } } while (0)
struct XcdBarrier { unsigned* bar; unsigned x; volatile LAS unsigned* st; };
__device__ __forceinline__ XcdBarrier xcd_barrier_post(unsigned* bar, volatile LAS unsigned* st) {
    XcdBarrier b; b.bar = bar; b.x = xb_xcc_id(); b.st = st;
    if (threadIdx.x == 0) (void)xb_add(&bar[XB_XCNT(b.x)], 1u);
    return b;
}
__device__ __forceinline__ void xcd_barrier_complete(unsigned* bar, unsigned x, unsigned& nloc, unsigned& nx) {
    const unsigned G = gridDim.x * gridDim.y * gridDim.z;
    unsigned sum, cnt, mine, sp = 0u;
    for (;;) {
        sum = 0u; cnt = 0u; mine = 0u;
#pragma unroll
        for (unsigned j = 0; j < 16; ++j) { const unsigned c = xb_ld(&bar[XB_XCNT(j)]); sum += c; cnt += (c > 0u) ? 1u : 0u; mine = (j == x) ? c : mine; }
        if (sum == G) break;
        __builtin_amdgcn_s_sleep(1);
        if ((++sp & 255u) == 0u) { if (xb_ld(&bar[XB_TMO])) break; if (sp > XB_SPIN_CAP) { atomicAdd(&bar[XB_TMO], 1u); break; } }
    }
    nloc = mine > 0u ? mine : 1u; nx = cnt > 0u ? cnt : 1u;
}
__device__ __forceinline__ void xcd_barrier(const XcdBarrier& b) {
    asm volatile("s_waitcnt vmcnt(0)" ::: "memory");
    __syncthreads();
    if (threadIdx.x == 0) {
        unsigned* bar = b.bar;
        __builtin_amdgcn_s_waitcnt(0);
        unsigned nloc = b.st[0], nx = b.st[1];
        if (nloc == 0u) { xcd_barrier_complete(bar, b.x, nloc, nx); b.st[0] = nloc; b.st[1] = nx; }
        const unsigned old = xb_add(&bar[XB_XSUB(b.x)], 1u);
        const unsigned gen = old / nloc;
        if (old + 1u == (gen + 1u) * nloc) {
            __builtin_amdgcn_fence(__ATOMIC_RELEASE, "agent");
            asm volatile("s_waitcnt vmcnt(0)" ::: "memory");
            const unsigned og = xb_add(&bar[XB_TOP], 1u);
            const unsigned tg = og / nx;
            if (og + 1u == (tg + 1u) * nx) xb_add(&bar[XB_TOPGEN], 1u);
            else XB_SPIN(xb_ld(&bar[XB_TOPGEN]) == tg, bar);
            __builtin_amdgcn_fence(__ATOMIC_ACQUIRE, "agent");
            xb_add(&bar[XB_XGEN(b.x)], 1u);
            asm volatile("s_waitcnt vmcnt(0)" ::: "memory");
        } else {
            XB_SPIN(xb_ld(&bar[XB_XGEN(b.x)]) == gen, bar);
            __builtin_amdgcn_fence(__ATOMIC_ACQUIRE, "agent");
            asm volatile("s_waitcnt vmcnt(0)" ::: "memory");
        }
    }
    __syncthreads();
}

namespace pg8 {
constexpr int BM = 256, BK = 64, HALF = 128, HTB = HALF * BK * 2, NXCD = 8, WGM = 8;
__device__ __forceinline__ int lds_byte(int r, int c) { const int st = (r >> 4) * 2 + (c >> 5), rr = r & 15, cc = c & 31, ob = rr * 64 + cc * 2; return st * 1024 + (ob ^ (((ob >> 9) & 1) << 5)); }
__device__ __forceinline__ void stage_rc(int b, int& R, int& C) { const int st = b / 1024, sb = b % 1024, swz = sb ^ (((sb >> 9) & 1) << 5); R = (st >> 1) * 16 + swz / 64; C = (st & 1) * 32 + (swz % 64) / 2; }
__device__ __forceinline__ int perm32(int rho) { const int n = rho >> 4, i = rho & 15; return 8 * (i >> 2) + 4 * n + (i & 3); }
struct Unit { int pm, pn, ko; };
struct Gemm { const bf16_t* A; const bf16_t* Bt; int M, N, K, lda, ldb; };
struct StaticOrder {
    int nM, nN, nwg, G, c;
    __device__ void init(int M, int N, int G_, int c_) { nM = M / BM; nN = N / BM; nwg = nM * nN; G = G_; c = c_; }
    __device__ bool next(int i, Unit& u) const {
        const long L = (long)i * G + c; if (L >= nwg) return false;
        int wgid = (int)L; { const int q = nwg / NXCD, r = nwg % NXCD, xcd = wgid % NXCD, off = wgid / NXCD; wgid = (xcd < r ? xcd * (q + 1) : r * (q + 1) + (xcd - r) * q) + off; }
        const int nig = WGM * nN, gid = wgid / nig, fm = gid * WGM, gsz = (nM - fm) < WGM ? (nM - fm) : WGM;
        u.pm = fm + ((wgid % nig) % gsz); u.pn = (wgid % nig) / gsz; u.ko = 0; return true;
    }
};
struct SplitOrder {
    int nu, c, K;
    __device__ bool next(int i, Unit& u) const { if (i != 0 || c >= nu) return false; u.pm = 0; u.pn = c & 3; u.ko = (c >> 2) * K; return true; }
};
template <class Epi, class Sched, bool SCALE = false>
__device__ __forceinline__ void gemm_phase(LAS unsigned char* lds, const Gemm g, const Sched& S, const Epi& E, const LAS float* sctab = nullptr) {
    const int tid = threadIdx.x, wid = __builtin_amdgcn_readfirstlane(tid >> 6), lane = tid & 63, wr = wid >> 2, wc = wid & 3, fr = lane & 15, fq = lane >> 4;
    const int K = g.K, nt = K / BK;
    unsigned voffA[2], voffB[2];
#pragma unroll
    for (int i = 0; i < 2; ++i) { int R, C; stage_rc(tid * 16 + i * 8192, R, C); const int Rb = Epi::PERM ? ((R & ~31) + perm32(R & 31)) : R;
        voffA[i] = (unsigned)(R * g.lda + C) * 2u; voffB[i] = (unsigned)(Rb * g.ldb + C) * 2u; }
    const size_t kstep = (size_t)(BK * 2);
    const size_t hstepA = (size_t)HALF * g.lda * 2, hstepB = (size_t)HALF * g.ldb * 2;
    const size_t tstepA = 2 * hstepA, tstepB = 2 * hstepB;
    const unsigned ldsw = (unsigned)wid * 1024u;
    const int aoff = lds_byte(wr * 64 + fr, fq * 8), boff = lds_byte(wc * 32 + fr, fq * 8);
#define PG8_SA(b, h) (((b) * 2 + (h)) * HTB)
#define PG8_SB(b, h) ((4 + (b) * 2 + (h)) * HTB)
#define PG8_STAGE(bufoff, gbase, voff) do { _Pragma("unroll") for (int _i = 0; _i < 2; ++_i) \
        __builtin_amdgcn_global_load_lds((const unsigned*)((const char*)(gbase) + (voff)[_i]), (LAS unsigned*)(lds + (bufoff) + ldsw + _i * 8192), 16, 0, 0); } while (0)
#define PG8_LDA(dst, b, h) do { _Pragma("unroll") for (int m = 0; m < 4; ++m) _Pragma("unroll") for (int k = 0; k < 2; ++k) dst[m][k] = *(const LAS bf16x8*)(lds + PG8_SA(b, h) + aoff + m * 2048 + k * 1024); } while (0)
#define PG8_LDB(dst, b, h) do { _Pragma("unroll") for (int n = 0; n < 2; ++n) _Pragma("unroll") for (int k = 0; k < 2; ++k) dst[n][k] = *(const LAS bf16x8*)(lds + PG8_SB(b, h) + boff + n * 2048 + k * 1024); } while (0)
#define PG8_MMA(ai, bj, At, Bt) do { __builtin_amdgcn_s_setprio(1); _Pragma("unroll") for (int m = 0; m < 4; ++m) _Pragma("unroll") for (int n = 0; n < 2; ++n) _Pragma("unroll") for (int k = 0; k < 2; ++k) \
        acc[ai][bj][m][n] = __builtin_amdgcn_mfma_f32_16x16x32_bf16(Bt[n][k], At[m][k], acc[ai][bj][m][n], 0, 0, 0); __builtin_amdgcn_s_setprio(0); } while (0)
#define PG8_WAIT_V(n) asm volatile("s_waitcnt vmcnt(" #n ")" ::: "memory")
#define PG8_WAIT_L(n) asm volatile("s_waitcnt lgkmcnt(" #n ")" ::: "memory")
#define PG8_BAR __builtin_amdgcn_s_barrier()
#define PG8_SCHED __builtin_amdgcn_sched_barrier(0)
    Unit cur, nxt; int ui = 0;
    if (!S.next(0, cur)) return;
    f32x4 acc[2][2][4][2];
#pragma unroll
    for (int a = 0; a < 2; ++a)
#pragma unroll
        for (int b = 0; b < 2; ++b)
#pragma unroll
            for (int m = 0; m < 4; ++m)
#pragma unroll
                for (int n = 0; n < 2; ++n) acc[a][b][m][n] = (f32x4){0.f, 0.f, 0.f, 0.f};
    bf16x8 At[4][2], B0[2][2], B1[2][2];
    const char* cA = (const char*)g.A + (size_t)cur.pm * tstepA + (size_t)cur.ko * 2; const char* cB = (const char*)g.Bt + (size_t)cur.pn * tstepB + (size_t)cur.ko * 2;
    PG8_STAGE(PG8_SB(0, 0), cB, voffB); PG8_STAGE(PG8_SA(0, 0), cA, voffA); PG8_STAGE(PG8_SB(0, 1), cB + hstepB, voffB); PG8_STAGE(PG8_SA(0, 1), cA + hstepA, voffA);
    if (wr == 1) PG8_BAR;
    PG8_WAIT_V(4); PG8_BAR;
    PG8_STAGE(PG8_SB(1, 0), cB + kstep, voffB); PG8_STAGE(PG8_SA(1, 0), cA + kstep, voffA); PG8_STAGE(PG8_SB(1, 1), cB + hstepB + kstep, voffB);
    PG8_WAIT_V(6); PG8_BAR;
    for (;;) {
        const bool has_next = S.next(ui + 1, nxt);
        const char* nA = has_next ? (const char*)g.A + (size_t)nxt.pm * tstepA + (size_t)nxt.ko * 2 : cA; const char* nB = has_next ? (const char*)g.Bt + (size_t)nxt.pn * tstepB + (size_t)nxt.ko * 2 : cB;
        for (int t = 0; t < nt; t += 2) {
            const bool last = (t == nt - 2);
            const char* a1 = cA + (size_t)(t + 1) * kstep;
            const char* a2 = last ? nA : cA + (size_t)(t + 2) * kstep; const char* b2 = last ? nB : cB + (size_t)(t + 2) * kstep;
            const char* a3 = a2 + kstep; const char* b3 = b2 + kstep;
            if (SCALE && (t == 8 || t == 16)) {
                const LAS float* tb = sctab + (t == 8 ? 0 : 256) + wr * 64 + fr;
#pragma unroll
                for (int ai = 0; ai < 2; ++ai)
#pragma unroll
                    for (int m = 0; m < 4; ++m) { const float sv = tb[ai * 128 + m * 16];
#pragma unroll
                        for (int bj = 0; bj < 2; ++bj)
#pragma unroll
                            for (int n = 0; n < 2; ++n) acc[ai][bj][m][n] *= sv; }
                PG8_WAIT_L(0); PG8_SCHED;
            }
            PG8_LDB(B0, 0, 0); PG8_SCHED; PG8_LDA(At, 0, 0); PG8_STAGE(PG8_SA(1, 1), a1 + hstepA, voffA);
            PG8_WAIT_L(8); PG8_BAR; PG8_WAIT_L(0); PG8_MMA(0, 0, At, B0); PG8_BAR; PG8_SCHED;
            PG8_LDB(B1, 0, 1); PG8_STAGE(PG8_SB(0, 0), b2, voffB);
            PG8_BAR; PG8_WAIT_L(0); PG8_MMA(0, 1, At, B1); PG8_BAR;
            PG8_LDA(At, 0, 1); PG8_STAGE(PG8_SA(0, 0), a2, voffA);
            PG8_BAR; PG8_WAIT_L(0); PG8_MMA(1, 0, At, B0); PG8_BAR; PG8_SCHED;
            PG8_STAGE(PG8_SB(0, 1), b2 + hstepB, voffB);
            PG8_WAIT_V(6); PG8_BAR; PG8_MMA(1, 1, At, B1); PG8_BAR;
            PG8_LDB(B0, 1, 0); PG8_SCHED; PG8_LDA(At, 1, 0); PG8_STAGE(PG8_SA(0, 1), a2 + hstepA, voffA);
            PG8_WAIT_L(8); PG8_BAR; PG8_WAIT_L(0); PG8_MMA(0, 0, At, B0); PG8_BAR; PG8_SCHED;
            PG8_LDB(B1, 1, 1); PG8_STAGE(PG8_SB(1, 0), b3, voffB);
            PG8_BAR; PG8_WAIT_L(0); PG8_MMA(0, 1, At, B1); PG8_BAR;
            PG8_LDA(At, 1, 1); PG8_STAGE(PG8_SA(1, 0), a3, voffA);
            PG8_BAR; PG8_WAIT_L(0); PG8_MMA(1, 0, At, B0); PG8_BAR; PG8_SCHED;
            PG8_STAGE(PG8_SB(1, 1), b3 + hstepB, voffB);
            PG8_WAIT_V(6); PG8_BAR; PG8_MMA(1, 1, At, B1); PG8_BAR;
        }
        E(acc, cur, wr, wc, fr, fq);
        if (!has_next) break;
#pragma unroll
        for (int a = 0; a < 2; ++a)
#pragma unroll
            for (int b = 0; b < 2; ++b)
#pragma unroll
                for (int m = 0; m < 4; ++m)
#pragma unroll
                    for (int n = 0; n < 2; ++n) acc[a][b][m][n] = (f32x4){0.f, 0.f, 0.f, 0.f};
        cur = nxt; cA = nA; cB = nB; ++ui;
    }
    PG8_WAIT_V(0);
    if (wr == 0) PG8_BAR;
    PG8_BAR;
#undef PG8_SA
#undef PG8_SB
#undef PG8_STAGE
#undef PG8_LDA
#undef PG8_LDB
#undef PG8_MMA
#undef PG8_WAIT_V
#undef PG8_WAIT_L
#undef PG8_BAR
#undef PG8_SCHED
}
}

__device__ __forceinline__ float dpp_ror1(float v) { return __builtin_bit_cast(float, __builtin_amdgcn_update_dpp(0, __builtin_bit_cast(int, v), 0x121, 0xF, 0xF, true)); }
__device__ __forceinline__ float dpp_ror2(float v) { return __builtin_bit_cast(float, __builtin_amdgcn_update_dpp(0, __builtin_bit_cast(int, v), 0x122, 0xF, 0xF, true)); }
struct EpiIn {
    static constexpr bool PERM = true;
    bf16_t* mix; bf16_t* xbc; const float* rstd; float* uf; float* ul; float* gbf; const float* cw; const float* st; float* sout; LAS float* xch;
    __device__ __forceinline__ void operator()(const f32x4 (&acc)[2][2][4][2], const pg8::Unit& u, int wr, int wc, int fr_, int fq_) const {
        int fr = fr_, fq = fq_; asm volatile("" : "+v"(fr), "+v"(fq));
        const int row0 = u.pm * 256 + wr * 64 + fr;
        float rs[2][4];
#pragma unroll
        for (int ai = 0; ai < 2; ++ai)
#pragma unroll
            for (int m = 0; m < 4; ++m) rs[ai][m] = rstd[row0 + ai * 128 + m * 16];
        if (u.pn >= 16) {
            bf16_t* base = xbc + (u.pn - 16) * 256 + wc * 32 + 8 * fq;
#pragma unroll
            for (int ai = 0; ai < 2; ++ai)
#pragma unroll
                for (int m = 0; m < 4; ++m) { bf16_t* rp = base + (size_t)(row0 + ai * 128 + m * 16) * XBC;
#pragma unroll
                    for (int bj = 0; bj < 2; ++bj) { const f32x4 v0 = acc[ai][bj][m][0] * rs[ai][m], v1 = acc[ai][bj][m][1] * rs[ai][m];
                        u32x4 w; w.x = cvt_pk_bf16(v0[0], v0[1]); w.y = cvt_pk_bf16(v0[2], v0[3]); w.z = cvt_pk_bf16(v1[0], v1[1]); w.w = cvt_pk_bf16(v1[2], v1[3]);
                        *(u32x4*)(rp + bj * 128) = w; } }
            return;
        }
        const int cl = wc * 16 + 4 * fq, jj = u.pn * 64 + cl;
        const f32x4 w0 = *(const f32x4*)(cw + jj), w1 = *(const f32x4*)(cw + 1024 + jj), w2 = *(const f32x4*)(cw + 2048 + jj);
        if (u.pm == 64) {
#pragma unroll
            for (int m = 0; m < 4; ++m) { const int bs = wr * 64 + m * 16 + fr; const float r = rs[0][m];
                const f32x4 s0 = *(const f32x4*)(st + (size_t)(bs * 2) * 1024 + jj), s1 = *(const f32x4*)(st + (size_t)(bs * 2 + 1) * 1024 + jj);
                const f32x4 gb = acc[0][0][m][0] * r, uu = acc[0][0][m][1] * acc[0][1][m][0] * (r * r), zz = acc[0][1][m][1] * r;
                const f32x4 ys = gb * (s0 * w0 + s1 * w1 + uu * w2);
                *(f32x4*)(sout + (size_t)(bs * 2) * 1024 + jj) = s1; *(f32x4*)(sout + (size_t)(bs * 2 + 1) * 1024 + jj) = uu;
                bf16_t* rp = mix + (size_t)(TPR + bs) * 2048 + jj;
                u32x2 oz, oy; oz.x = cvt_pk_bf16(zz[0], zz[1]); oz.y = cvt_pk_bf16(zz[2], zz[3]); oy.x = cvt_pk_bf16(ys[0], ys[1]); oy.y = cvt_pk_bf16(ys[2], ys[3]);
                *(u32x2*)rp = oz; *(u32x2*)(rp + 1024) = oy; }
            return;
        }
        if (fr >= 14) {
#pragma unroll
            for (int ai = 0; ai < 2; ++ai) { const float r = rs[ai][3]; *(LAS f32x4*)(xch + ((2 * ai + wr) * 2 + (fr - 14)) * 64 + cl) = acc[ai][0][3][1] * acc[ai][1][3][0] * (r * r); }
            if (wr == 1) { const float r = rs[1][3]; *(f32x4*)(ul + (size_t)(u.pm * 2 + (fr - 14)) * 1024 + jj) = acc[1][0][3][1] * acc[1][1][3][0] * (r * r); }
        }
        if (fr < 2 && wr == 0) { const float r = rs[0][0];
            *(f32x4*)(uf + (size_t)(u.pm * 2 + fr) * 1024 + jj) = acc[0][0][0][1] * acc[0][1][0][0] * (r * r); *(f32x4*)(gbf + (size_t)(u.pm * 2 + fr) * 1024 + jj) = acc[0][0][0][0] * r; }
        asm volatile("s_waitcnt lgkmcnt(0)" ::: "memory"); __builtin_amdgcn_s_barrier(); __builtin_amdgcn_s_barrier(); asm volatile("" ::: "memory");
        const bool f1 = fr >= 1, f2 = fr >= 2;
        bf16_t* mrow = mix + (size_t)row0 * 2048 + jj;
#pragma unroll
        for (int ai = 0; ai < 2; ++ai) {
            const int k = 2 * ai + wr;
            f32x4 p1, p2;
            if (k > 0) { const f32x4 X0 = *(const LAS f32x4*)(xch + ((k - 1) * 2 + 0) * 64 + cl), X1 = *(const LAS f32x4*)(xch + ((k - 1) * 2 + 1) * 64 + cl);
                p1 = X1;
#pragma unroll
                for (int e = 0; e < 4; ++e) p2[e] = fr == 1 ? X1[e] : X0[e]; }
            else { p1 = (f32x4){0.f, 0.f, 0.f, 0.f}; p2 = p1; }
#pragma unroll
            for (int m = 0; m < 4; ++m) { const float r = rs[ai][m];
                const f32x4 gb = acc[ai][0][m][0] * r, uu = acc[ai][0][m][1] * acc[ai][1][m][0] * (r * r), zz = acc[ai][1][m][1] * r;
                float ys[4];
#pragma unroll
                for (int e = 0; e < 4; ++e) { const float r1 = dpp_ror1(uu[e]), r2 = dpp_ror2(uu[e]);
                    const float um1 = f1 ? r1 : p1[e], um2 = f2 ? r2 : p2[e];
                    ys[e] = gb[e] * (um2 * w0[e] + um1 * w1[e] + uu[e] * w2[e]);
                    p1[e] = r1; p2[e] = r2; }
                u32x2 oz, oy; oz.x = cvt_pk_bf16(zz[0], zz[1]); oz.y = cvt_pk_bf16(zz[2], zz[3]); oy.x = cvt_pk_bf16(ys[0], ys[1]); oy.y = cvt_pk_bf16(ys[2], ys[3]);
                bf16_t* rp = mrow + (size_t)(ai * 128 + m * 16) * 2048;
                *(u32x2*)rp = oz; *(u32x2*)(rp + 1024) = oy; }
            asm volatile("" ::: "memory");
        }
    }
};
struct EpiFfnAct {
    static constexpr bool PERM = true;
    bf16_t* act; float* gfirst; float* glast; float* ufirst; const float* cw; const float* cb; const float* st; float* sout; LAS float* xch;
    __device__ __forceinline__ void operator()(const f32x4 (&acc)[2][2][4][2], const pg8::Unit& u, int wr, int wc, int fr_, int fq_) const {
        int fr = fr_, fq = fq_; asm volatile("" : "+v"(fr), "+v"(fq));
        const int cl = wc * 32 + 8 * fq, cg = u.pn * 128 + cl;
        if (u.pm == 64) {
#pragma unroll
            for (int n = 0; n < 2; ++n) { const f32x4 w0 = *(const f32x4*)(cw + cg + 4 * n), w1 = *(const f32x4*)(cw + DFF + cg + 4 * n), w2 = *(const f32x4*)(cw + 2 * DFF + cg + 4 * n), bb = *(const f32x4*)(cb + cg + 4 * n);
#pragma unroll
                for (int m = 0; m < 4; ++m) { const int bs = wr * 64 + m * 16 + fr;
                    const f32x4 s0 = *(const f32x4*)(st + (size_t)(bs * 2) * DFF + cg + 4 * n), s1 = *(const f32x4*)(st + (size_t)(bs * 2 + 1) * DFF + cg + 4 * n);
                    const f32x4 g = acc[0][0][m][n], up = acc[0][1][m][n]; const f32x4 cv = s0 * w0 + s1 * w1 + g * w2 + bb;
                    u32x2 o; o.x = cvt_pk_bf16(silu_f(cv[0]) * up[0], silu_f(cv[1]) * up[1]); o.y = cvt_pk_bf16(silu_f(cv[2]) * up[2], silu_f(cv[3]) * up[3]);
                    *(f32x4*)(sout + (size_t)(bs * 2) * DFF + cg + 4 * n) = s1; *(f32x4*)(sout + (size_t)(bs * 2 + 1) * DFF + cg + 4 * n) = g;
                    *(u32x2*)(act + (size_t)(TPR + bs) * DFF + cg + 4 * n) = o; } }
            return;
        }
        if (fr >= 14) {
#pragma unroll
            for (int ai = 0; ai < 2; ++ai)
#pragma unroll
                for (int n = 0; n < 2; ++n) *(LAS f32x4*)(xch + ((2 * ai + wr) * 2 + (fr - 14)) * 128 + cl + 4 * n) = acc[ai][0][3][n];
            if (wr == 1) {
#pragma unroll
                for (int n = 0; n < 2; ++n) *(f32x4*)(glast + (size_t)(u.pm * 2 + (fr - 14)) * DFF + cg + 4 * n) = acc[1][0][3][n]; }
        }
        if (fr < 2 && wr == 0) {
#pragma unroll
            for (int n = 0; n < 2; ++n) { *(f32x4*)(gfirst + (size_t)(u.pm * 2 + fr) * DFF + cg + 4 * n) = acc[0][0][0][n]; *(f32x4*)(ufirst + (size_t)(u.pm * 2 + fr) * DFF + cg + 4 * n) = acc[0][1][0][n]; }
        }
        f32x4 w0[2], w1[2], w2[2], bb[2];
#pragma unroll
        for (int n = 0; n < 2; ++n) { w0[n] = *(const f32x4*)(cw + cg + 4 * n); w1[n] = *(const f32x4*)(cw + DFF + cg + 4 * n); w2[n] = *(const f32x4*)(cw + 2 * DFF + cg + 4 * n); bb[n] = *(const f32x4*)(cb + cg + 4 * n); }
        asm volatile("s_waitcnt lgkmcnt(0)" ::: "memory"); __builtin_amdgcn_s_barrier(); __builtin_amdgcn_s_barrier(); asm volatile("" ::: "memory");
        const bool f1 = fr >= 1, f2 = fr >= 2;
        bf16_t* arow = act + (size_t)(u.pm * 256 + wr * 64 + fr) * DFF + cg;
#pragma unroll
        for (int ai = 0; ai < 2; ++ai) {
            const int k = 2 * ai + wr;
            u32x2 o0[4];
#pragma unroll
            for (int n = 0; n < 2; ++n) {
                f32x4 p1, p2;
                if (k > 0) { const f32x4 X0 = *(const LAS f32x4*)(xch + ((k - 1) * 2 + 0) * 128 + cl + 4 * n), X1 = *(const LAS f32x4*)(xch + ((k - 1) * 2 + 1) * 128 + cl + 4 * n);
                    p1 = X1;
#pragma unroll
                    for (int e = 0; e < 4; ++e) p2[e] = fr == 1 ? X1[e] : X0[e]; }
                else { p1 = (f32x4){0.f, 0.f, 0.f, 0.f}; p2 = p1; }
#pragma unroll
                for (int m = 0; m < 4; ++m) { const f32x4 g = acc[ai][0][m][n], up = acc[ai][1][m][n]; float a[4];
#pragma unroll
                    for (int e = 0; e < 4; ++e) { const float r1 = dpp_ror1(g[e]), r2 = dpp_ror2(g[e]);
                        const float gm1 = f1 ? r1 : p1[e], gm2 = f2 ? r2 : p2[e];
                        a[e] = silu_f(gm2 * w0[n][e] + gm1 * w1[n][e] + g[e] * w2[n][e] + bb[n][e]) * up[e];
                        p1[e] = r1; p2[e] = r2; }
                    u32x2 o; o.x = cvt_pk_bf16(a[0], a[1]); o.y = cvt_pk_bf16(a[2], a[3]);
                    if (n == 0) o0[m] = o;
                    else { u32x4 w; w.x = o0[m].x; w.y = o0[m].y; w.z = o.x; w.w = o.y; *(u32x4*)(arow + (size_t)(ai * 128 + m * 16) * DFF) = w; } }
            }
            asm volatile("" ::: "memory");
        }
    }
};
struct EpiRes {
    static constexpr bool PERM = true;
    const float* bf; const bf16_t* b16; bf16_t* o16;
    __device__ __forceinline__ void operator()(const f32x4 (&acc)[2][2][4][2], const pg8::Unit& u, int wr, int wc, int fr_, int fq_) const {
        int fr = fr_, fq = fq_; asm volatile("" : "+v"(fr), "+v"(fq));
        const size_t off0 = (size_t)(u.pm * 256 + wr * 64 + fr) * 1024 + u.pn * 256 + wc * 32 + 8 * fq;
#pragma unroll
        for (int ai = 0; ai < 2; ++ai) {
            f32x4 bv[4][2][2];
            if (bf) {
#pragma unroll
                for (int m = 0; m < 4; ++m)
#pragma unroll
                    for (int bj = 0; bj < 2; ++bj)
#pragma unroll
                        for (int n = 0; n < 2; ++n) bv[m][bj][n] = *(const f32x4*)(bf + off0 + (size_t)(ai * 128 + m * 16) * 1024 + bj * 128 + 4 * n);
            } else {
                u32x4 br[4][2];
#pragma unroll
                for (int m = 0; m < 4; ++m)
#pragma unroll
                    for (int bj = 0; bj < 2; ++bj) br[m][bj] = *(const u32x4*)(b16 + off0 + (size_t)(ai * 128 + m * 16) * 1024 + bj * 128);
#pragma unroll
                for (int m = 0; m < 4; ++m)
#pragma unroll
                    for (int bj = 0; bj < 2; ++bj) { bv[m][bj][0] = (f32x4){bf_lo(br[m][bj].x), bf_hi(br[m][bj].x), bf_lo(br[m][bj].y), bf_hi(br[m][bj].y)};
                        bv[m][bj][1] = (f32x4){bf_lo(br[m][bj].z), bf_hi(br[m][bj].z), bf_lo(br[m][bj].w), bf_hi(br[m][bj].w)}; }
            }
#pragma unroll
            for (int m = 0; m < 4; ++m)
#pragma unroll
                for (int bj = 0; bj < 2; ++bj) { const f32x4 o0 = bv[m][bj][0] + acc[ai][bj][m][0], o1 = bv[m][bj][1] + acc[ai][bj][m][1];
                    u32x4 pk; pk.x = cvt_pk_bf16(o0[0], o0[1]); pk.y = cvt_pk_bf16(o0[2], o0[3]); pk.z = cvt_pk_bf16(o1[0], o1[1]); pk.w = cvt_pk_bf16(o1[2], o1[3]);
                    *(u32x4*)(o16 + off0 + (size_t)(ai * 128 + m * 16) * 1024 + bj * 128) = pk; }
            asm volatile("" ::: "memory");
        }
    }
};
struct EpiSlab {
    static constexpr bool PERM = false;
    float* slab;
    __device__ __forceinline__ void operator()(const f32x4 (&acc)[2][2][4][2], const pg8::Unit& u, int wr, int wc, int fr, int fq) const {
        const int col0 = u.pn * 256 + wc * 32 + 4 * fq;
        float* sb = slab + (size_t)(u.ko >> 8) * (128 * 1024);
#pragma unroll
        for (int m = 0; m < 4; ++m) { float* o = sb + (size_t)(wr * 64 + m * 16 + fr) * 1024 + col0;
#pragma unroll
            for (int bj = 0; bj < 2; ++bj)
#pragma unroll
                for (int n = 0; n < 2; ++n) *(f32x4*)(o + bj * 128 + n * 16) = acc[0][bj][m][n]; }
    }
};

struct Params {
    const float* x_prompt; const float* x_sample; const float* state_ssm; const float* state_ssd_conv; const float* state_sc; const float* state_ffn;
    const float* norm_mix_w; const float* w_in; const float* ssd_conv_w; const float* ssd_conv_b; const float* dt_bias; const float* a_log; const float* ssd_d; const float* ssd_norm_w;
    const float* sc_conv_w; const float* w_out; const float* norm_ffn_w; const float* w_ffn_in; const float* ffn_conv_w; const float* ffn_conv_b; const float* w_down; const float* norm_final_w;
    float* out; unsigned char* ws; int ph_lo, ph_hi;
};

__device__ __forceinline__ int map_in4(int jd) {
    const int T = jd >> 8, L = jd & 255;
    if (T >= 16) return 1024 + (T - 16) * 256 + L;
    const int bj = L >> 7, wc = (L >> 5) & 3, fq = (L >> 3) & 3, n = (L >> 2) & 1, jj = T * 64 + wc * 16 + fq * 4;
    return (bj == 0 ? (n == 0 ? 2576 : 3600) : (n == 0 ? 4624 : 0)) + jj;
}
__device__ __forceinline__ int map_in_old(int j0) {
    if (j0 < 2560) return j0;
    if (j0 < 3584) return 2576 + (j0 - 2560);
    const int k = (j0 - 3584) >> 8, w = (j0 - 3584) & 255;
    return w < 128 ? 3600 + k * 128 + w : 4624 + k * 128 + (w - 128);
}
__device__ __forceinline__ void p0_chunk(const Params& P, LAS unsigned char* lds, int ci) {
    const int tid = threadIdx.x, lane = tid & 63, wid = tid >> 6, r16 = lane & 15, q = lane >> 4;
    LAS bf16_t* wdt = (LAS bf16_t*)lds;
    LAS float* dts = (LAS float*)(lds + 33024);
    LAS float* segs = (LAS float*)(lds + 33024 + 8192);
    LAS float* nws = (LAS float*)(lds + 33024 + 8192 + 1024);
    *(LAS float*)(nws + tid) = P.norm_mix_w[tid]; *(LAS float*)(nws + 512 + tid) = P.norm_mix_w[512 + tid];
#pragma unroll
    for (int i = 0; i < 8; ++i) { const int k = (tid >> 2) + 128 * i, c4 = (tid & 3) * 4; const f32x4 v = *(const f32x4*)(P.w_in + (size_t)k * DINP + 2560 + c4);
        wdt[(c4 + 0) * 1032 + k] = f2bf(v[0]); wdt[(c4 + 1) * 1032 + k] = f2bf(v[1]); wdt[(c4 + 2) * 1032 + k] = f2bf(v[2]); wdt[(c4 + 3) * 1032 + k] = f2bf(v[3]); }
    __syncthreads();
    const int row = ci * 128 + wid * 16 + r16;
    const float* src = (row < TPR ? P.x_prompt + (size_t)row * 1024 : P.x_sample + (size_t)(row - TPR) * 1024) + 8 * q;
    bf16_t* dst = (bf16_t*)(P.ws + WS_A1) + (size_t)row * 1024 + 8 * q;
    const LAS float* nw = nws + 8 * q;
    f32x4 acc = (f32x4){0.f, 0.f, 0.f, 0.f};
    float ss = 0.f;
    f32x4 xa[2][8], xb[2][8];
#pragma unroll
    for (int u = 0; u < 8; ++u) { xa[0][u] = __builtin_nontemporal_load((const f32x4*)(src + 32 * u)); xb[0][u] = __builtin_nontemporal_load((const f32x4*)(src + 32 * u + 4)); }
#pragma unroll
    for (int bt = 0; bt < 4; ++bt) { const int s0 = 8 * bt;
        if (bt < 3) {
#pragma unroll
            for (int u = 0; u < 8; ++u) { xa[(bt + 1) & 1][u] = __builtin_nontemporal_load((const f32x4*)(src + 32 * (s0 + 8 + u))); xb[(bt + 1) & 1][u] = __builtin_nontemporal_load((const f32x4*)(src + 32 * (s0 + 8 + u) + 4)); } }
#pragma unroll
        for (int u = 0; u < 8; ++u) { const int sidx = s0 + u; const f32x4 wa = *(const LAS f32x4*)(nw + 32 * sidx), wb = *(const LAS f32x4*)(nw + 32 * sidx + 4);
            const f32x4 a = xa[bt & 1][u], b = xb[bt & 1][u];
            ss += a[0] * a[0] + a[1] * a[1] + a[2] * a[2] + a[3] * a[3] + b[0] * b[0] + b[1] * b[1] + b[2] * b[2] + b[3] * b[3];
            const f32x4 ya = a * wa, yb = b * wb;
            u32x4 pk; pk.x = cvt_pk_bf16(ya[0], ya[1]); pk.y = cvt_pk_bf16(ya[2], ya[3]); pk.z = cvt_pk_bf16(yb[0], yb[1]); pk.w = cvt_pk_bf16(yb[2], yb[3]);
            *(u32x4*)(dst + 32 * sidx) = pk;
            const bf16x8 bfr = *(const LAS bf16x8*)(wdt + r16 * 1032 + 32 * sidx + 8 * q);
            acc = __builtin_amdgcn_mfma_f32_16x16x32_bf16(__builtin_bit_cast(bf16x8, pk), bfr, acc, 0, 0, 0); }
    }
    ss += __shfl_xor(ss, 16); ss += __shfl_xor(ss, 32);
    const float rstd = rsqrtf(ss * (1.0f / 1024.0f) + EPS);
    if (q == 0) ((float*)(P.ws + WS_RSTD))[row] = rstd;
#pragma unroll
    for (int j = 0; j < 4; ++j) acc[j] *= __shfl(rstd, 4 * q + j);
    { const float bias = P.dt_bias[r16];
#pragma unroll
      for (int j = 0; j < 4; ++j) dts[(wid * 16 + 4 * q + j) * 16 + r16] = softplus_f(acc[j] + bias); }
    __syncthreads();
    if (ci < 128) {
        const int b = ci >> 4, c = ci & 15, h = tid & 15, seg = (tid >> 4) & 15;
        float d[8], cs[8];
        if (tid < 256) { const float a = -__expf(P.a_log[h]); float run = 0.f;
#pragma unroll
            for (int i = 0; i < 8; ++i) { d[i] = dts[(seg * 8 + i) * 16 + h]; run += d[i] * a; cs[i] = run; }
            segs[seg * 16 + h] = run; }
        __syncthreads();
        if (tid < 256) { float pre = 0.f;
#pragma unroll
            for (int s2 = 0; s2 < 16; ++s2) pre += (s2 < seg) ? segs[s2 * 16 + h] : 0.f;
#pragma unroll
            for (int i = 0; i < 8; ++i) cs[i] += pre;
            const size_t o = (size_t)(b * 16 + h) * 2048 + c * 128 + seg * 8;
            st8f((float*)(P.ws + WS_DT) + o, d); st8f((float*)(P.ws + WS_ACUM) + o, cs); }
    } else {
        float* dtsg = (float*)(P.ws + WS_DTS);
        for (int i = tid; i < 2048; i += 512) dtsg[i] = dts[i];
    }
    __syncthreads();
}
__device__ __forceinline__ void tile_decode(const Params& P, int t, const float*& src, bf16_t*& dst, int& K, int& Ns, int& k0, int& n0, int& c0) {
    int kt, nt;
    if (t < 1408) { src = P.w_in; dst = (bf16_t*)(P.ws + WS_WIN); K = 1024; Ns = DINP; kt = t / 88; nt = t % 88; c0 = -1; }
    else if (t < 1920) { t -= 1408; src = P.w_out; dst = (bf16_t*)(P.ws + WS_WOUT); K = 2048; Ns = 1024; kt = t >> 4; nt = t & 15; c0 = nt * 64; }
    else if (t < 3328) { t -= 1920; src = P.w_ffn_in; dst = (bf16_t*)(P.ws + WS_WFFN); K = 1024; Ns = NIN; kt = t / 88; nt = t % 88; { const int j0 = nt * 64, k = j0 >> 8, w = j0 & 255; c0 = w < 128 ? k * 128 + w : DFF + k * 128 + (w - 128); } }
    else { t -= 3328; src = P.w_down; dst = (bf16_t*)(P.ws + WS_WDOWN); K = 2816; Ns = 1024; kt = t >> 4; nt = t & 15; c0 = nt * 64; }
    k0 = kt * 64; n0 = nt * 64;
}
__device__ __forceinline__ void conv_tiles(const Params& P, LAS unsigned char* lds, int tb, int te, int stride) {
    const int tid = threadIdx.x;
    LAS float* tl = (LAS float*)lds;
    for (int t4 = tb; t4 < te; t4 += 4 * stride) {
        f32x4 v[4][2];
#pragma unroll
        for (int u = 0; u < 4; ++u) { const int t = t4 + u * stride; if (t < te) { const float* src; bf16_t* dst; int K, Ns, k0, n0, c0; tile_decode(P, t, src, dst, K, Ns, k0, n0, c0);
            const int col = c0 < 0 ? map_in4(n0 + (tid & 15) * 4) : c0 + (tid & 15) * 4;
#pragma unroll
            for (int i = 0; i < 2; ++i) v[u][i] = *(const f32x4*)(src + (size_t)(k0 + (tid >> 4) + 32 * i) * Ns + col); } }
#pragma unroll
        for (int u = 0; u < 4; ++u) { const int t = t4 + u * stride; if (t < te) {
#pragma unroll
            for (int i = 0; i < 2; ++i) { const int kr = (tid >> 4) + 32 * i, c4 = (tid & 15) * 4; LAS float* d = tl + u * 4160 + kr * 65 + c4; d[0] = v[u][i][0]; d[1] = v[u][i][1]; d[2] = v[u][i][2]; d[3] = v[u][i][3]; } } }
        __syncthreads();
#pragma unroll
        for (int u = 0; u < 4; ++u) { const int t = t4 + u * stride; if (t < te) { const float* src; bf16_t* dst; int K, Ns, k0, n0, c0; tile_decode(P, t, src, dst, K, Ns, k0, n0, c0);
            const int n = tid >> 3, k8 = (tid & 7) * 8; float f[8];
#pragma unroll
            for (int i = 0; i < 8; ++i) f[i] = tl[u * 4160 + (k8 + i) * 65 + n];
            *(u32x4*)(dst + (size_t)(n0 + n) * K + k0 + k8) = pack8(f); } }
        __syncthreads();
    }
}
__device__ __forceinline__ void phase0(const Params& P, LAS unsigned char* lds) {
    const int G = gridDim.x, bx = blockIdx.x, NCI = 129;
    for (int ci = bx; ci < NCI; ci += G) p0_chunk(P, lds, ci);
    if (G > NCI) { if (bx >= NCI) conv_tiles(P, lds, bx - NCI, 1408, G - NCI); }
    else conv_tiles(P, lds, bx, 1408, G);
}
__device__ __forceinline__ void p1_late_tiles(const Params& P, LAS unsigned char* lds) {
    const int G = gridDim.x, bx = blockIdx.x, nwg = (TPAD / 256) * (NIN / 256), nfull = nwg % G;
    if (nfull > 0 && nfull < G) { if (bx >= nfull) conv_tiles(P, lds, 1408 + bx - nfull, 4032, G - nfull); }
    else conv_tiles(P, lds, 1408 + bx, 4032, G);
}

__device__ __forceinline__ void p2_conv_load(const Params& P, int item, u32x4 (&pre)[3]) {
    const int tid = threadIdx.x;
    const int strip = item % 24, bc = item / 24, b = bc >> 4, c = bc & 15, t0 = c * 128;
    const int colg = strip < 16 ? strip * 64 : (strip < 20 ? 1024 + (strip - 16) * 64 : 1280 + (strip - 20) * 64);
    const bf16_t* xbc = (const bf16_t*)(P.ws + WS_XBC);
#pragma unroll
    for (int k = 0; k < 3; ++k) { const int i = tid + 512 * k; pre[k] = (u32x4){0u, 0u, 0u, 0u};
        if (i < 131 * 8) { const int rr = i >> 3, c8 = (i & 7) * 8, tl = t0 - 3 + rr; if (tl >= 0) pre[k] = *(const u32x4*)(xbc + (size_t)(b * 2048 + tl) * XBC + colg + c8); } }
}
__device__ __forceinline__ void p2_conv_item(const Params& P, LAS unsigned char* lds, int item, int next_item, u32x4 (&pre)[3]) {
    const int tid = threadIdx.x;
    const int strip = item % 24, bc = item / 24, b = bc >> 4, c = bc & 15, t0 = c * 128;
    const int colg = strip < 16 ? strip * 64 : (strip < 20 ? 1024 + (strip - 16) * 64 : 1280 + (strip - 20) * 64);
    LAS bf16_t* raw = (LAS bf16_t*)lds;
    LAS bf16_t* outn = (LAS bf16_t*)(lds + 16768);
#pragma unroll
    for (int k = 0; k < 3; ++k) { const int i = tid + 512 * k; if (i < 131 * 8) *(LAS u32x4*)(raw + (i >> 3) * 64 + (i & 7) * 8) = pre[k]; }
    __syncthreads();
    if (next_item >= 0) p2_conv_load(P, next_item, pre);
    const int col = tid & 63, rg = tid >> 6;
    const float w0 = P.ssd_conv_w[colg + col], w1 = P.ssd_conv_w[XBC + colg + col], w2 = P.ssd_conv_w[2 * XBC + colg + col], w3 = P.ssd_conv_w[3 * XBC + colg + col], bs = P.ssd_conv_b[colg + col];
    float o[16];
    { float x0 = bf2f(raw[(rg * 16 + 0) * 64 + col]), x1 = bf2f(raw[(rg * 16 + 1) * 64 + col]), x2 = bf2f(raw[(rg * 16 + 2) * 64 + col]);
#pragma unroll
      for (int i = 0; i < 16; ++i) { const float x3 = bf2f(raw[(rg * 16 + i + 3) * 64 + col]); o[i] = silu_f(x0 * w0 + x1 * w1 + x2 * w2 + x3 * w3 + bs); x0 = x1; x1 = x2; x2 = x3; } }
    u32x4 pk0, pk1;
    pk0.x = cvt_pk_bf16(o[0], o[1]); pk0.y = cvt_pk_bf16(o[2], o[3]); pk0.z = cvt_pk_bf16(o[4], o[5]); pk0.w = cvt_pk_bf16(o[6], o[7]);
    pk1.x = cvt_pk_bf16(o[8], o[9]); pk1.y = cvt_pk_bf16(o[10], o[11]); pk1.z = cvt_pk_bf16(o[12], o[13]); pk1.w = cvt_pk_bf16(o[14], o[15]);
    LAS unsigned char* outT = lds + 16768 + 16384;
    if (strip < 20) { *(LAS u32x4*)(outT + col * 272 + rg * 32) = pk0; *(LAS u32x4*)(outT + col * 272 + rg * 32 + 16) = pk1; }
    if (strip >= 16) {
#pragma unroll
        for (int i = 0; i < 16; ++i) outn[(rg * 16 + i) * 64 + col] = f2bf(o[i]); }
    __syncthreads();
    if (strip < 20) {
        bf16_t* dT = strip < 16 ? (bf16_t*)(P.ws + WS_A1) + ((size_t)(b * 16 + strip) * 64) * 2048 + t0
                                : (bf16_t*)((unsigned char*)P.out + OS_BT) + ((size_t)(b * 2 + ((strip - 16) >> 1)) * 128 + ((strip - 16) & 1) * 64) * 2048 + t0;
        for (int i = tid; i < 1024; i += 512) { const int rr = i >> 4, c16 = i & 15; *(u32x4*)(dT + (size_t)rr * 2048 + c16 * 8) = *(const LAS u32x4*)(outT + rr * 272 + c16 * 16); }
    }
    if (strip >= 16) {
        const int sb = (strip - 16) & 3, g = sb >> 1, n0 = (sb & 1) * 64;
        bf16_t* nat = (bf16_t*)((unsigned char*)P.out + (strip < 20 ? OS_BN : OS_CN)) + ((size_t)(b * 2 + g) * 2048 + t0) * 128 + n0;
        for (int i = tid; i < 1024; i += 512) { const int rr = i >> 3, c8 = (i & 7) * 8; *(u32x4*)(nat + (size_t)rr * 128 + c8) = *(const LAS u32x4*)(outn + rr * 64 + c8); }
    }
    if (c == 15 && tid < 192) { const int rr = tid >> 6; P.out[O_PSSDC + (size_t)(b * 3 + rr) * XBC + colg + col] = bf2f(raw[(128 + rr) * 64 + col]); }
    __syncthreads();
}
__device__ __forceinline__ void p2_state_load(const Params& P, int item, int i0, f32x4 (&hv)[16]) {
    const int lane = threadIdx.x & 63, wid = threadIdx.x >> 6, bs = item >> 1, g = item & 1;
    const float* hin = P.state_ssm + ((size_t)(bs * 16 + g * 8 + wid) * 64 + (lane >> 5)) * 128 + 4 * (lane & 31);
#pragma unroll
    for (int i = 0; i < 16; ++i) hv[i] = __builtin_nontemporal_load((const f32x4*)(hin + (size_t)(i0 + i) * 256));
}
__device__ __forceinline__ void p2_sample_item(const Params& P, LAS unsigned char* lds, int item) {
    const int tid = threadIdx.x, lane = tid & 63, wid = tid >> 6;
    const int bs = item >> 1, g = item & 1, row = TPR + bs;
    LAS float* sx = (LAS float*)lds;
    const int half = lane >> 5, l32 = lane & 31;
    float* hout = P.out + O_SSSM + ((size_t)(bs * 16 + g * 8 + wid) * 64 + half) * 128 + 4 * l32;
    f32x4 hva[16]; p2_state_load(P, item, 0, hva);
    LAS float* ssqs = sx + 768;
    const bf16_t* xbc = (const bf16_t*)(P.ws + WS_XBC) + (size_t)row * XBC;
    bf16_t* mix = (bf16_t*)(P.ws + WS_MIX) + (size_t)row * 2048;
    for (int i = tid; i < 768; i += 512) {
        const int j = i < 512 ? g * 512 + i : (i < 640 ? 1024 + g * 128 + (i - 512) : 1280 + g * 128 + (i - 640));
        const float* st = P.state_ssd_conv + (size_t)bs * 3 * XBC + j;
        const float s0 = st[0], s1 = st[XBC], s2 = st[2 * XBC], xr = bf2f(xbc[j]);
        const float v = s0 * P.ssd_conv_w[j] + s1 * P.ssd_conv_w[XBC + j] + s2 * P.ssd_conv_w[2 * XBC + j] + xr * P.ssd_conv_w[3 * XBC + j] + P.ssd_conv_b[j];
        sx[i] = silu_f(v);
        float* so = P.out + O_SSSDC + (size_t)bs * 3 * XBC + j; so[0] = s1; so[XBC] = s2; so[2 * XBC] = xr;
    }
    __syncthreads();
    const int h = g * 8 + wid;
    const float dt = ((const float*)(P.ws + WS_DTS))[bs * 16 + h], a = -__expf(P.a_log[h]), dA = __expf(dt * a);
    const f32x4 Bv = *(const LAS f32x4*)(sx + 512 + 4 * l32), Cv = *(const LAS f32x4*)(sx + 640 + 4 * l32);
    float v[32];
#pragma unroll
    for (int i0 = 0; i0 < 32; i0 += 16) {
        f32x4 hv[16];
        if (i0 == 0) {
#pragma unroll
            for (int i = 0; i < 16; ++i) hv[i] = hva[i]; }
        else p2_state_load(P, item, 16, hv);
#pragma unroll
        for (int i = 0; i < 16; ++i) { const float xd = dt * sx[wid * 64 + 2 * (i0 + i) + half]; const f32x4 hn = dA * hv[i] + xd * Bv;
            __builtin_nontemporal_store(hn, (f32x4*)(hout + (size_t)(i0 + i) * 256));
            v[i0 + i] = hn[0] * Cv[0] + hn[1] * Cv[1] + hn[2] * Cv[2] + hn[3] * Cv[3]; }
    }
#pragma unroll
    for (int m = 16; m >= 1; m >>= 1) {
#pragma unroll
        for (int i = 0; i < m; ++i) { const bool up = (l32 & m) != 0; const float keep = up ? v[i + m] : v[i], send = up ? v[i] : v[i + m]; v[i] = keep + __shfl_xor(send, m); } }
    const int pl = 2 * l32 + half;
    const float ymine = v[0];
    const float xsv = sx[wid * 64 + pl];
    float y = ymine + P.ssd_d[h] * xsv;
    y *= silu_f(bf2f(mix[h * 64 + pl]));
    float sq = y * y;
    sq += __shfl_xor(sq, 1); sq += __shfl_xor(sq, 2); sq += __shfl_xor(sq, 4); sq += __shfl_xor(sq, 8); sq += __shfl_xor(sq, 16); sq += __shfl_xor(sq, 32);
    if (lane == 0) ssqs[wid] = sq;
    __syncthreads();
    float tot = 0.f;
#pragma unroll
    for (int i = 0; i < 8; ++i) tot += ssqs[i];
    const float rstd = rsqrtf(tot * (1.0f / 512.0f) + EPS);
    mix[h * 64 + pl] = f2bf(y * rstd * P.ssd_norm_w[h * 64 + pl]);
    __syncthreads();
}

__device__ __forceinline__ void p3_item(const Params& P, LAS unsigned char* lds, int item) {
    const int tid = threadIdx.x, lane = tid & 63, wid = tid >> 6, r16 = lane & 15, q = lane >> 4;
    const int b = item >> 5, c = (item >> 1) & 15, g = item & 1, h = g * 8 + wid, t0 = c * 128;
    LAS float* wsc = (LAS float*)lds + wid * 128;
    LAS unsigned char* btl = lds + 4096;
    const bf16_t* BTp = (const bf16_t*)((const unsigned char*)P.out + OS_BT) + ((size_t)(b * 2 + g) * 128) * 2048 + t0;
    u32x4 btr[4];
#pragma unroll
    for (int k = 0; k < 4; ++k) { const int i = tid + 512 * k; btr[k] = *(const u32x4*)(BTp + (size_t)(i >> 4) * 2048 + (i & 15) * 8); }
    const float* dtp = (const float*)(P.ws + WS_DT) + (size_t)(b * 16 + h) * 2048 + t0;
    const float* acp = (const float*)(P.ws + WS_ACUM) + (size_t)(b * 16 + h) * 2048 + t0;
    const float alast = acp[127];
    wsc[lane] = dtp[lane] * __expf(alast - acp[lane]); wsc[lane + 64] = dtp[lane + 64] * __expf(alast - acp[lane + 64]);
#pragma unroll
    for (int k = 0; k < 4; ++k) { const int i = tid + 512 * k; *(LAS u32x4*)(btl + (i >> 4) * 272 + (i & 15) * 16) = btr[k]; }
    __syncthreads();
    const bf16_t* xsT = (const bf16_t*)(P.ws + WS_A1) + ((size_t)(b * 16 + h) * 64) * 2048 + t0;
    f32x4 acc[8][4];
#pragma unroll
    for (int i = 0; i < 8; ++i)
#pragma unroll
        for (int j = 0; j < 4; ++j) acc[i][j] = (f32x4){0.f, 0.f, 0.f, 0.f};
#pragma unroll 2
    for (int kk = 0; kk < 4; ++kk) { const int s0 = 32 * kk + 8 * q;
        float sc[8]; { const f32x4 a = *(const LAS f32x4*)(wsc + s0), b2 = *(const LAS f32x4*)(wsc + s0 + 4); sc[0] = a[0]; sc[1] = a[1]; sc[2] = a[2]; sc[3] = a[3]; sc[4] = b2[0]; sc[5] = b2[1]; sc[6] = b2[2]; sc[7] = b2[3]; }
        bf16x8 bfr[4];
#pragma unroll
        for (int pt = 0; pt < 4; ++pt) { const u32x4 rawv = *(const u32x4*)(xsT + (size_t)(pt * 16 + r16) * 2048 + s0); float f[8]; unpack8(rawv, f);
#pragma unroll
            for (int j = 0; j < 8; ++j) f[j] *= sc[j];
            bfr[pt] = __builtin_bit_cast(bf16x8, pack8(f)); }
#pragma unroll
        for (int nt = 0; nt < 8; ++nt) { const bf16x8 afr = *(const LAS bf16x8*)(btl + (nt * 16 + r16) * 272 + s0 * 2);
#pragma unroll
            for (int pt = 0; pt < 4; ++pt) acc[nt][pt] = __builtin_amdgcn_mfma_f32_16x16x32_bf16(afr, bfr[pt], acc[nt][pt], 0, 0, 0); }
    }
    bf16_t* stp = (bf16_t*)((unsigned char*)P.out + OS_ST) + (((size_t)(b * 16 + c) * 16 + h) * 64) * 128;
#pragma unroll
    for (int nt = 0; nt < 8; ++nt)
#pragma unroll
        for (int pt = 0; pt < 4; ++pt) { u32x2 w; w.x = cvt_pk_bf16(acc[nt][pt][0], acc[nt][pt][1]); w.y = cvt_pk_bf16(acc[nt][pt][2], acc[nt][pt][3]);
            *(u32x2*)(stp + (size_t)(((nt * 4 + pt) * 4 + q) * 16 + r16) * 4) = w; }
    __syncthreads();
}

__device__ __forceinline__ void phase4(const Params& P) {
    const int tid = threadIdx.x, G = gridDim.x, bx = blockIdx.x;
    for (int idx = bx * 512 + tid; idx < 262144; idx += G * 512) {
        const int n4 = idx & 31, pp = (idx >> 5) & 63, h = (idx >> 11) & 15, b = idx >> 15;
        const float* acp = (const float*)(P.ws + WS_ACUM) + (size_t)(b * 16 + h) * 2048;
        f32x4 hs = (f32x4){0.f, 0.f, 0.f, 0.f};
        u32x2* ptr0 = (u32x2*)((bf16_t*)((unsigned char*)P.out + OS_ST) + ((((size_t)(b * 16) * 16 + h) * 64 + pp) * 128 + n4 * 4));
        u32x2 sv[16]; float dec[16];
#pragma unroll
        for (int c = 0; c < 16; ++c) { sv[c] = ptr0[(size_t)c * 32768]; dec[c] = acp[c * 128 + 127]; }
#pragma unroll
        for (int c = 0; c < 16; ++c) { u32x2 w; w.x = cvt_pk_bf16(hs[0], hs[1]); w.y = cvt_pk_bf16(hs[2], hs[3]); ptr0[(size_t)c * 32768] = w;
            const float d = __expf(dec[c]); const u32x2 sc = sv[c];
            hs[0] = d * hs[0] + bf_lo(sc.x); hs[1] = d * hs[1] + bf_hi(sc.x); hs[2] = d * hs[2] + bf_lo(sc.y); hs[3] = d * hs[3] + bf_hi(sc.y); }
        { const int e = idx & 2047, er = e & 15, eq = (e >> 4) & 3, ept = (e >> 6) & 3, ent = e >> 8;
          *(f32x4*)(P.out + O_PSSM + ((size_t)(b * 16 + h) * 64 + ept * 16 + er) * 128 + ent * 16 + 4 * eq) = hs; }
    }
}

__device__ __forceinline__ void p5_stage_load(const bf16_t* Hp, const bf16_t* xsT, u32x4 (&sr)[4]) {
    const int tid = threadIdx.x;
#pragma unroll
    for (int k = 0; k < 2; ++k) { const int i = tid + 512 * k, row = i >> 4, c16 = i & 15;
        sr[k] = *(const u32x4*)(Hp + (size_t)row * 128 + c16 * 8); sr[2 + k] = *(const u32x4*)(xsT + (size_t)row * 2048 + c16 * 8); }
}
__device__ __forceinline__ void p5_stage_write(LAS unsigned char* buf, const u32x4 (&sr)[4]) {
    const int tid = threadIdx.x;
#pragma unroll
    for (int k = 0; k < 2; ++k) { const int i = tid + 512 * k, row = i >> 4, c16 = i & 15;
        { const int e = 2 * i, er = e & 15, eq = (e >> 4) & 3, ept = (e >> 6) & 3, ent = e >> 8;
          LAS unsigned char* d = buf + (ept * 16 + er) * 272 + (ent * 16 + 4 * eq) * 2; u32x2 lo, hi; lo.x = sr[k].x; lo.y = sr[k].y; hi.x = sr[k].z; hi.y = sr[k].w;
          *(LAS u32x2*)d = lo; *(LAS u32x2*)(d + 272) = hi; }
        *(LAS u32x4*)(buf + 17408 + row * 272 + c16 * 16) = sr[2 + k]; }
}
__device__ __forceinline__ void p5_item(const Params& P, LAS unsigned char* lds, int item) {
    const int tid = threadIdx.x, lane = tid & 63, w = __builtin_amdgcn_readfirstlane(tid >> 6), r16 = lane & 15, q = lane >> 4;
    const int b = item >> 5, c = (item >> 1) & 15, g = item & 1, t0 = c * 128, l0 = 16 * w;
    LAS float* acs = (LAS float*)lds;
    LAS float* dtl = acs + 1024;
    LAS unsigned char* sbuf = lds + 8192;
    LAS float* nwl = (LAS float*)(lds + 8192 + 69632);
    nwl[tid] = P.ssd_norm_w[g * 512 + tid];
    const bf16_t* Hbase = (const bf16_t*)((const unsigned char*)P.out + OS_ST) + (((size_t)(b * 16 + c) * 16 + g * 8) * 64) * 128;
    const bf16_t* Xbase = (const bf16_t*)(P.ws + WS_A1) + ((size_t)(b * 16 + g * 8) * 64) * 2048 + t0;
    u32x4 sr[4];
    p5_stage_load(Hbase, Xbase, sr);
    const bf16_t* Bn = (const bf16_t*)((const unsigned char*)P.out + OS_BN) + ((size_t)(b * 2 + g) * 2048 + t0) * 128;
    u32x4 bnr[4];
#pragma unroll
    for (int k = 0; k < 4; ++k) { const int i = tid + 512 * k; bnr[k] = *(const u32x4*)(Bn + (size_t)(i >> 4) * 128 + (i & 15) * 8); }
    if (tid < 256) { const size_t o = (size_t)(b * 16 + g * 8 + (tid >> 5)) * 2048 + t0 + (tid & 31) * 4;
      *(LAS f32x4*)(acs + tid * 4) = *(const f32x4*)((const float*)(P.ws + WS_ACUM) + o); *(LAS f32x4*)(dtl + tid * 4) = *(const f32x4*)((const float*)(P.ws + WS_DT) + o); }
    const bf16_t* Cn = (const bf16_t*)((const unsigned char*)P.out + OS_CN) + ((size_t)(b * 2 + g) * 2048 + t0) * 128;
    bf16x8 cfr[4];
#pragma unroll
    for (int kk = 0; kk < 4; ++kk) cfr[kk] = *(const bf16x8*)(Cn + (size_t)(l0 + r16) * 128 + 32 * kk + 8 * q);
    LAS unsigned char* bnl = sbuf + 34816;
#pragma unroll
    for (int k = 0; k < 4; ++k) { const int i = tid + 512 * k; *(LAS u32x4*)(bnl + (i >> 4) * 272 + (i & 15) * 16) = bnr[k]; }
    p5_stage_write(sbuf, sr);
    __syncthreads();
    f32x4 GT[8];
#pragma unroll
    for (int j = 0; j < 8; ++j) GT[j] = (f32x4){0.f, 0.f, 0.f, 0.f};
#pragma unroll
    for (int j = 0; j < 8; ++j) if (j <= w) {
#pragma unroll
        for (int kk = 0; kk < 4; ++kk) { const bf16x8 afr = *(const LAS bf16x8*)(bnl + (16 * j + r16) * 272 + 64 * kk + 16 * q); GT[j] = __builtin_amdgcn_mfma_f32_16x16x32_bf16(afr, cfr[kk], GT[j], 0, 0, 0); } }
    __syncthreads();
    const int lidx = l0 + r16;
    bf16_t* mixrow = (bf16_t*)(P.ws + WS_MIX) + (size_t)(b * 2048 + t0 + lidx) * 2048;
    float ssq = 0.f;
    if (PROBE_MASK && blockIdx.x == 0 && tid == 0) ((unsigned long long*)(P.ws + WS_BAR + 14336))[14] = __builtin_amdgcn_s_memrealtime();
#pragma unroll 1
    for (int r = 0; r < 8; ++r) {
        const int h = g * 8 + r;
        if (r < 7) p5_stage_load(Hbase + (size_t)(r + 1) * 8192, Xbase + (size_t)(r + 1) * 131072, sr);
        u32x2 zz[4];
#pragma unroll
        for (int pt = 0; pt < 4; ++pt) zz[pt] = *(const u32x2*)(mixrow + h * 64 + pt * 16 + 4 * q);
        const LAS unsigned char* Hb = sbuf + (r & 1) * 34816 + r16 * 272 + 16 * q;
        const LAS unsigned char* Xb = sbuf + (r & 1) * 34816 + 17408 + r16 * 272 + 8 * q;
        const float acl = acs[r * 128 + lidx], Dh = P.ssd_d[h];
        f32x4 acc[4];
#pragma unroll
        for (int pt = 0; pt < 4; ++pt) acc[pt] = (f32x4){0.f, 0.f, 0.f, 0.f};
#pragma unroll
        for (int kk = 0; kk < 4; ++kk)
#pragma unroll
            for (int pt = 0; pt < 4; ++pt) { const bf16x8 afr = *(const LAS bf16x8*)(Hb + pt * 4352 + kk * 64); acc[pt] = __builtin_amdgcn_mfma_f32_16x16x32_bf16(afr, cfr[kk], acc[pt], 0, 0, 0); }
        { const float el = __expf(acl);
#pragma unroll
          for (int pt = 0; pt < 4; ++pt) acc[pt] *= el; }
#pragma unroll
        for (int kk = 0; kk < 4; ++kk) if (2 * kk <= w) {
            const f32x4 asa = *(const LAS f32x4*)(acs + r * 128 + 32 * kk + 4 * q), dta = *(const LAS f32x4*)(dtl + r * 128 + 32 * kk + 4 * q);
            const f32x4 asb = *(const LAS f32x4*)(acs + r * 128 + 32 * kk + 16 + 4 * q), dtb = *(const LAS f32x4*)(dtl + r * 128 + 32 * kk + 16 + 4 * q);
            float m[8];
#pragma unroll
            for (int j = 0; j < 4; ++j) { const int s = 32 * kk + 4 * q + j; float v = GT[2 * kk][j] * __expf(fminf(acl - asa[j], 0.f)) * dta[j]; v = s > lidx ? 0.f : v; v = s == lidx ? v + Dh : v; m[j] = v; }
#pragma unroll
            for (int j = 0; j < 4; ++j) { const int s = 32 * kk + 16 + 4 * q + j; float v = GT[2 * kk + 1][j] * __expf(fminf(acl - asb[j], 0.f)) * dtb[j]; v = s > lidx ? 0.f : v; v = s == lidx ? v + Dh : v; m[4 + j] = v; }
            const bf16x8 bfr = __builtin_bit_cast(bf16x8, pack8(m));
#pragma unroll
            for (int pt = 0; pt < 4; ++pt) { const u32x2 lo = *(const LAS u32x2*)(Xb + pt * 4352 + kk * 64), hi = *(const LAS u32x2*)(Xb + pt * 4352 + kk * 64 + 32);
                u32x4 av; av.x = lo.x; av.y = lo.y; av.z = hi.x; av.w = hi.y;
                acc[pt] = __builtin_amdgcn_mfma_f32_16x16x32_bf16(__builtin_bit_cast(bf16x8, av), bfr, acc[pt], 0, 0, 0); }
        }
#pragma unroll
        for (int pt = 0; pt < 4; ++pt) {
            const float y0 = acc[pt][0] * silu_f(bf_lo(zz[pt].x)), y1 = acc[pt][1] * silu_f(bf_hi(zz[pt].x)), y2 = acc[pt][2] * silu_f(bf_lo(zz[pt].y)), y3 = acc[pt][3] * silu_f(bf_hi(zz[pt].y));
            ssq += y0 * y0 + y1 * y1 + y2 * y2 + y3 * y3;
            const f32x4 nw = *(const LAS f32x4*)(nwl + r * 64 + pt * 16 + 4 * q);
            u32x2 o; o.x = cvt_pk_bf16(y0 * nw[0], y1 * nw[1]); o.y = cvt_pk_bf16(y2 * nw[2], y3 * nw[3]); *(u32x2*)(mixrow + h * 64 + pt * 16 + 4 * q) = o; }
        if (r < 7) p5_stage_write(sbuf + ((r + 1) & 1) * 34816, sr);
        __syncthreads();
    }
    if (PROBE_MASK && blockIdx.x == 0 && tid == 0) ((unsigned long long*)(P.ws + WS_BAR + 14336))[15] = __builtin_amdgcn_s_memrealtime();
    ssq += __shfl_xor(ssq, 16); ssq += __shfl_xor(ssq, 32);
    const float rstd = rsqrtf(ssq * (1.0f / 512.0f) + EPS);
    if (q == 0) ((float*)(P.ws + WS_GRS))[(size_t)(b * 2048 + t0 + lidx) * 2 + g] = rstd;
    __syncthreads();
    if (PROBE_MASK && blockIdx.x == 0 && tid == 0) ((unsigned long long*)(P.ws + WS_BAR + 14336))[16] = __builtin_amdgcn_s_memrealtime();
}

__device__ __forceinline__ void rmsnorm_rows(float* srcf, const bf16_t* src16, const float* w, bf16_t* dstb, float* dstf, const float* slab, int nslab, const float* xs_base) {
    const int tid = threadIdx.x, lane = tid & 63, wid = tid >> 6;
    f32x4 wv[4];
#pragma unroll
    for (int i = 0; i < 4; ++i) wv[i] = *(const f32x4*)(w + lane * 4 + i * 256);
    for (int row = blockIdx.x * 8 + wid; row < TT; row += gridDim.x * 8) {
        f32x4 v[4];
        if (row < TPR) {
            u32x2 r[4];
#pragma unroll
            for (int i = 0; i < 4; ++i) r[i] = *(const u32x2*)(src16 + (size_t)row * 1024 + lane * 4 + i * 256);
#pragma unroll
            for (int i = 0; i < 4; ++i) v[i] = (f32x4){bf_lo(r[i].x), bf_hi(r[i].x), bf_lo(r[i].y), bf_hi(r[i].y)};
        } else {
            const float* s = (xs_base ? xs_base + (size_t)(row - TPR) * 1024 : srcf + (size_t)row * 1024) + lane * 4;
#pragma unroll
            for (int i = 0; i < 4; ++i) v[i] = *(const f32x4*)(s + i * 256);
            for (int k = 0; k < nslab; ++k) { const float* sp = slab + ((size_t)k * 128 + (row - TPR)) * 1024 + lane * 4;
#pragma unroll
                for (int i = 0; i < 4; ++i) v[i] += *(const f32x4*)(sp + i * 256); }
            if (xs_base) {
#pragma unroll
                for (int i = 0; i < 4; ++i) *(f32x4*)(srcf + (size_t)row * 1024 + lane * 4 + i * 256) = v[i]; }
        }
        float ss = 0.f;
#pragma unroll
        for (int i = 0; i < 4; ++i) ss += v[i][0] * v[i][0] + v[i][1] * v[i][1] + v[i][2] * v[i][2] + v[i][3] * v[i][3];
        ss += __shfl_xor(ss, 1); ss += __shfl_xor(ss, 2); ss += __shfl_xor(ss, 4); ss += __shfl_xor(ss, 8); ss += __shfl_xor(ss, 16); ss += __shfl_xor(ss, 32);
        const float rstd = rsqrtf(ss * (1.0f / 1024.0f) + EPS);
#pragma unroll
        for (int i = 0; i < 4; ++i) { const f32x4 o = v[i] * rstd * wv[i];
            if (dstb) { u32x2 pk; pk.x = cvt_pk_bf16(o[0], o[1]); pk.y = cvt_pk_bf16(o[2], o[3]); *(u32x2*)(dstb + (size_t)row * 1024 + lane * 4 + i * 256) = pk; }
            else __builtin_nontemporal_store(o, (f32x4*)(dstf + (size_t)row * 1024 + lane * 4 + i * 256)); }
    }
}

__device__ __forceinline__ void phase9_fix(const Params& P, int G, int bx) {
    const int tid = threadIdx.x;
    bf16_t* act = (bf16_t*)(P.ws + WS_UP);
    const float* gf = (const float*)(P.ws + WS_SBGF); const float* gl = (const float*)(P.ws + WS_SBGL); const float* uf = (const float*)(P.ws + WS_SBUF);
    pg8::StaticOrder S; S.init(TPR, 1024, G, bx); pg8::Unit u;
    for (int i = 0; S.next(i, u); ++i) {
        const int pm = u.pm;
        if ((pm & 7) == 0) continue;
        for (int idx = tid; idx < 704; idx += 512) { const int c4 = idx * 4;
            const f32x4 w0 = *(const f32x4*)(P.ffn_conv_w + c4), w1 = *(const f32x4*)(P.ffn_conv_w + DFF + c4), w2 = *(const f32x4*)(P.ffn_conv_w + 2 * DFF + c4), bb = *(const f32x4*)(P.ffn_conv_b + c4);
            const f32x4 gl0 = *(const f32x4*)(gl + (size_t)((pm - 1) * 2) * DFF + c4), gl1 = *(const f32x4*)(gl + (size_t)((pm - 1) * 2 + 1) * DFF + c4);
            const f32x4 gf0 = *(const f32x4*)(gf + (size_t)(pm * 2) * DFF + c4), gf1 = *(const f32x4*)(gf + (size_t)(pm * 2 + 1) * DFF + c4);
            const f32x4 u0 = *(const f32x4*)(uf + (size_t)(pm * 2) * DFF + c4), u1 = *(const f32x4*)(uf + (size_t)(pm * 2 + 1) * DFF + c4);
            const f32x4 c0 = gl0 * w0 + gl1 * w1 + gf0 * w2 + bb, c1 = gl1 * w0 + gf0 * w1 + gf1 * w2 + bb;
            u32x2 o0, o1;
            o0.x = cvt_pk_bf16(silu_f(c0[0]) * u0[0], silu_f(c0[1]) * u0[1]); o0.y = cvt_pk_bf16(silu_f(c0[2]) * u0[2], silu_f(c0[3]) * u0[3]);
            o1.x = cvt_pk_bf16(silu_f(c1[0]) * u1[0], silu_f(c1[1]) * u1[1]); o1.y = cvt_pk_bf16(silu_f(c1[2]) * u1[2], silu_f(c1[3]) * u1[3]);
            *(u32x2*)(act + (size_t)(pm * 256) * DFF + c4) = o0; *(u32x2*)(act + (size_t)(pm * 256 + 1) * DFF + c4) = o1; }
    }
    for (int idx = bx * 512 + tid; idx < 8 * 2 * 704; idx += G * 512) {
        const int b = idx / 1408, r = (idx / 704) & 1, c4 = (idx % 704) * 4;
        *(f32x4*)(P.out + O_PFFN + (size_t)(b * 2 + r) * DFF + c4) = *(const f32x4*)(gl + (size_t)((8 * b + 7) * 2 + r) * DFF + c4);
    }
    asm volatile("s_waitcnt vmcnt(0)" ::: "memory");
    __syncthreads();
}

__device__ __forceinline__ void phase6_fix(const Params& P, int G, int bx) {
    const int tid = threadIdx.x;
    bf16_t* mix = (bf16_t*)(P.ws + WS_MIX);
    const float* uf = (const float*)(P.ws + WS_SCUF); const float* ul = (const float*)(P.ws + WS_SCUL); const float* gbf = (const float*)(P.ws + WS_SCGF);
    pg8::StaticOrder S; S.init(TPR, 1024, G, bx); pg8::Unit u;
    for (int i = 0; S.next(i, u); ++i) {
        const int pm = u.pm;
        if ((pm & 7) == 0 || tid >= 256) continue;
        const int c4 = tid * 4;
        const f32x4 w0 = *(const f32x4*)(P.sc_conv_w + c4), w1 = *(const f32x4*)(P.sc_conv_w + 1024 + c4), w2 = *(const f32x4*)(P.sc_conv_w + 2048 + c4);
        const f32x4 ul0 = *(const f32x4*)(ul + (size_t)((pm - 1) * 2) * 1024 + c4), ul1 = *(const f32x4*)(ul + (size_t)((pm - 1) * 2 + 1) * 1024 + c4);
        const f32x4 uf0 = *(const f32x4*)(uf + (size_t)(pm * 2) * 1024 + c4), uf1 = *(const f32x4*)(uf + (size_t)(pm * 2 + 1) * 1024 + c4);
        const f32x4 g0 = *(const f32x4*)(gbf + (size_t)(pm * 2) * 1024 + c4), g1 = *(const f32x4*)(gbf + (size_t)(pm * 2 + 1) * 1024 + c4);
        const f32x4 y0 = g0 * (ul0 * w0 + ul1 * w1 + uf0 * w2), y1 = g1 * (ul1 * w0 + uf0 * w1 + uf1 * w2);
        u32x2 o0, o1; o0.x = cvt_pk_bf16(y0[0], y0[1]); o0.y = cvt_pk_bf16(y0[2], y0[3]); o1.x = cvt_pk_bf16(y1[0], y1[1]); o1.y = cvt_pk_bf16(y1[2], y1[3]);
        *(u32x2*)(mix + (size_t)(pm * 256) * 2048 + 1024 + c4) = o0; *(u32x2*)(mix + (size_t)(pm * 256 + 1) * 2048 + 1024 + c4) = o1;
    }
    for (int idx = bx * 512 + tid; idx < 8 * 2 * 256; idx += G * 512) {
        const int b = idx >> 9, r = (idx >> 8) & 1, c4 = (idx & 255) * 4;
        *(f32x4*)(P.out + O_PSC + (size_t)(b * 2 + r) * 1024 + c4) = *(const f32x4*)(ul + (size_t)((8 * b + 7) * 2 + r) * 1024 + c4);
    }
    asm volatile("s_waitcnt vmcnt(0)" ::: "memory");
    __syncthreads();
}

constexpr int NPHASE = 12;
static_assert(WS_END <= (size_t)256 * 1024 * 1024, "workspace map exceeds the guaranteed 256 MiB");
static_assert(WS_UP + (size_t)TPAD * 2816 * 2 <= WS_BAR, "act overlays only the dead xBC / MIX region");
__global__ void __launch_bounds__(512, 2) fwd_megakernel(Params P) {
    extern __shared__ __attribute__((aligned(16))) unsigned char lds_raw[];
    LAS unsigned char* lds = (LAS unsigned char*)lds_raw;
    volatile LAS unsigned* stw = (volatile LAS unsigned*)(lds + 131072);
    if (threadIdx.x < 4) stw[threadIdx.x] = 0u;
    __syncthreads();
    const XcdBarrier bar = xcd_barrier_post((unsigned*)(P.ws + WS_BAR), stw);
    const int lo = P.ph_lo, hi = P.ph_hi, G = gridDim.x, bx = blockIdx.x;
#define IN(k) (lo <= (k) && (k) < hi)
    unsigned long long* stamps = (unsigned long long*)(P.ws + WS_BAR + 14336);
#define STAMP(k) do { if (PROBE_MASK && bx == 0 && threadIdx.x == 0) stamps[k] = __builtin_amdgcn_s_memrealtime(); } while (0)
    STAMP(0);
#define SEAM(k) do { if (IN(k) && IN((k) + 1)) xcd_barrier(bar); STAMP((k) + 1); } while (0)
    if (IN(0)) phase0(P, lds);
    SEAM(0);
    if (IN(1)) { pg8::Gemm g{(const bf16_t*)(P.ws + WS_A1), (const bf16_t*)(P.ws + WS_WIN), TPAD, NIN, 1024, 1024, 1024}; pg8::StaticOrder S; S.init(TPAD, NIN, G, bx);
        EpiIn E{(bf16_t*)(P.ws + WS_MIX), (bf16_t*)(P.ws + WS_XBC), (const float*)(P.ws + WS_RSTD), (float*)(P.ws + WS_SCUF), (float*)(P.ws + WS_SCUL), (float*)(P.ws + WS_SCGF), P.sc_conv_w, P.state_sc, P.out + O_SSC, (LAS float*)(lds + LDS_XCH)}; pg8::gemm_phase<EpiIn>(lds, g, S, E);
        p1_late_tiles(P, lds); }
    SEAM(1);
    if (IN(2)) { { u32x4 pre[3]; if (bx < 3072) p2_conv_load(P, bx, pre);
          for (int it = bx; it < 3072; it += G) p2_conv_item(P, lds, it, it + G < 3072 ? it + G : -1, pre); }
        STAMP(13);
        for (int it = bx; it < 256; it += G) p2_sample_item(P, lds, it); }
    SEAM(2);
    if (IN(3)) { for (int it = bx; it < 256; it += G) p3_item(P, lds, it); }
    SEAM(3);
    if (IN(4)) phase4(P);
    SEAM(4);
    if (IN(5)) { for (int it = bx; it < 256; it += G) p5_item(P, lds, it); }
    SEAM(5);
    if (IN(6)) { phase6_fix(P, G, bx);
        { pg8::Gemm g{(const bf16_t*)(P.ws + WS_MIX), (const bf16_t*)(P.ws + WS_WOUT), TPR, 1024, 2048, 2048, 2048}; pg8::StaticOrder S; S.init(TPR, 1024, G, bx);
          LAS float* sct = (LAS float*)(lds + LDS_XCH);
          { pg8::Unit u0; if (S.next(0, u0) && threadIdx.x < 256) { const float* gr = (const float*)(P.ws + WS_GRS) + (size_t)(u0.pm * 256 + threadIdx.x) * 2; const float r0 = gr[0], r1 = gr[1];
                sct[threadIdx.x] = r0 / r1; sct[256 + threadIdx.x] = r1; } }
          __syncthreads();
          EpiRes E{P.x_prompt, nullptr, (bf16_t*)(P.ws + WS_X1B)};
          pg8::gemm_phase<EpiRes, pg8::StaticOrder, true>(lds, g, S, E, sct); }
        { pg8::Gemm g{(const bf16_t*)(P.ws + WS_MIX) + (size_t)TPR * 2048, (const bf16_t*)(P.ws + WS_WOUT), 256, 1024, 256, 2048, 2048}; pg8::SplitOrder S{32, bx, 256};
          EpiSlab E{(float*)(P.ws + WS_SLAB)}; pg8::gemm_phase<EpiSlab>(lds, g, S, E); } }
    SEAM(6);
    if (IN(7)) rmsnorm_rows(P.out, (const bf16_t*)(P.ws + WS_X1B), P.norm_ffn_w, (bf16_t*)(P.ws + WS_A1), nullptr, (const float*)(P.ws + WS_SLAB), 8, P.x_sample);
    SEAM(7);
    if (IN(8)) { pg8::Gemm g{(const bf16_t*)(P.ws + WS_A1), (const bf16_t*)(P.ws + WS_WFFN), TPAD, NIN, 1024, 1024, 1024}; pg8::StaticOrder S; S.init(TPAD, NIN, G, bx);
        EpiFfnAct E{(bf16_t*)(P.ws + WS_UP), (float*)(P.ws + WS_SBGF), (float*)(P.ws + WS_SBGL), (float*)(P.ws + WS_SBUF), P.ffn_conv_w, P.ffn_conv_b, P.state_ffn, P.out + O_SFFN, (LAS float*)(lds + LDS_XCH)};
        pg8::gemm_phase<EpiFfnAct>(lds, g, S, E); }
    SEAM(8);
    if (IN(10)) { phase9_fix(P, G, bx);
        { pg8::Gemm g{(const bf16_t*)(P.ws + WS_UP), (const bf16_t*)(P.ws + WS_WDOWN), TPR, 1024, DFF, DFF, DFF}; pg8::StaticOrder S; S.init(TPR, 1024, G, bx);
          EpiRes E{nullptr, (const bf16_t*)(P.ws + WS_X1B), (bf16_t*)(P.ws + WS_A1)}; pg8::gemm_phase<EpiRes>(lds, g, S, E); }
        { pg8::Gemm g{(const bf16_t*)(P.ws + WS_UP) + (size_t)TPR * DFF, (const bf16_t*)(P.ws + WS_WDOWN), 256, 1024, 256, DFF, DFF}; pg8::SplitOrder S{44, bx, 256};
          EpiSlab E{(float*)(P.ws + WS_SLAB)}; pg8::gemm_phase<EpiSlab>(lds, g, S, E); } }
    SEAM(10);
    if (IN(11)) rmsnorm_rows(P.out, (const bf16_t*)(P.ws + WS_A1), P.norm_final_w, nullptr, P.out, (const float*)(P.ws + WS_SLAB), 11, nullptr);
    if (PROBE_MASK && bx == 0 && threadIdx.x == 0) {
        const unsigned long long tend = __builtin_amdgcn_s_memrealtime(); stamps[12] = tend; unsigned long long extra = 0;
        asm volatile("s_waitcnt vmcnt(0)" ::: "memory");
        for (int k = 0; k < 12; ++k) if ((PROBE_MASK >> k) & 1) extra += stamps[k + 1] - stamps[k];
        if (PROBE_MASK & 0x1000) extra += stamps[13] - stamps[2];
        if (PROBE_MASK & 0x2000) extra += stamps[15] - stamps[14];
        if (PROBE_MASK & 0x4000) extra += stamps[14] - stamps[5];
        if (PROBE_MASK & 0x8000) extra += stamps[16] - stamps[15];
        if (PROBE_MASK & 0x10000) extra += stamps[6] - stamps[16];
        while (__builtin_amdgcn_s_memrealtime() - tend < extra) __builtin_amdgcn_s_sleep(8);
    }
#undef IN
#undef SEAM
}

#ifndef N_LAUNCHES
#define N_LAUNCHES 1
#endif
extern "C" void kernel_launch(void* const* d_in, const int* in_sizes, int n_in, void* d_out, int out_size, void* d_ws, size_t ws_size, hipStream_t stream) {
    static int grid_blocks = 0;
    if (!grid_blocks) {
        int dev = 0, cus = 0, per_cu = 0;
        (void)hipGetDevice(&dev);
        (void)hipDeviceGetAttribute(&cus, hipDeviceAttributeMultiprocessorCount, dev);
        (void)hipFuncSetAttribute((const void*)fwd_megakernel, hipFuncAttributeMaxDynamicSharedMemorySize, LDS_BYTES);
        (void)hipOccupancyMaxActiveBlocksPerMultiprocessor(&per_cu, (const void*)fwd_megakernel, 512, LDS_BYTES);
        if (per_cu < 1) { fprintf(stderr, "occupancy query says %d blocks per CU\n", per_cu); per_cu = 1; }
        if (per_cu > 1) per_cu = 1;
        grid_blocks = cus * per_cu;
        if (grid_blocks > 256) grid_blocks = 256;
        if (grid_blocks < 256) { fprintf(stderr, "this kernel is built for a 256-CU device (resident capacity reported: %d workgroups); nothing launched\n", grid_blocks); grid_blocks = -1; }
        if (ws_size < WS_END) fprintf(stderr, "workspace too small: %zu < %zu\n", ws_size, (size_t)WS_END);
    }
    if (grid_blocks < 0) return;
    if (N_LAUNCHES == 1) (void)hipMemsetAsync((unsigned char*)d_ws + WS_BAR, 0, XCD_BAR_WORDS * 4, stream);
    Params p{};
    const float** pp = (const float**)&p;
    for (int i = 0; i < 22; ++i) pp[i] = (const float*)d_in[i];
    p.out = (float*)d_out; p.ws = (unsigned char*)d_ws;
    for (int li = 0; li < N_LAUNCHES; ++li) {
        p.ph_lo = (N_LAUNCHES == 1) ? 0 : li; p.ph_hi = (N_LAUNCHES == 1) ? NPHASE : li + 1;
        void* args[] = {&p};
        hipError_t e = hipLaunchCooperativeKernel((const void*)fwd_megakernel, dim3(grid_blocks), dim3(512), args, LDS_BYTES, stream);
        if (e != hipSuccess) fprintf(stderr, "cooperative launch failed: %s (grid %d)\n", hipGetErrorString(e), grid_blocks);
    }
}
```
